# Optimizing an MI355X kernel written in HIP

```python
import math
import jax
import jax.numpy as jnp
from jax import lax
import numpy as np

D_MODEL = 1024
BATCH = 8
SEQ = 4096
DEPTH = 4

CTX_LEN = 256
GRID_W = 64
EPS = 1e-6
ROPE_THETA = 10000.0
BLOCK = 128
N_MOD = 6

CONV_WIDTH = 512
CONV_K = 3
SWA_HEADS = 8
SWA_KV_HEADS = 2
SWA_HEAD_DIM = 64
WINDOW = 128
MLA_HEADS = 8
MLA_Q_RANK = 256
MLA_KV_RANK = 128
MLA_NOPE = 64
MLA_ROPE = 32
MLA_V = 64
DIFF_HEADS = 4
DIFF_DIM = 64
DIFF_V = 2 * DIFF_DIM
FF_DENSE = 2816
N_EXPERTS = 8
TOP_K = 2
FF_EXPERT = 3584
MOE_BLOCK = 512

EVEN_Q_WIDTHS = (CONV_WIDTH, CONV_WIDTH, CONV_WIDTH, SWA_HEADS * SWA_HEAD_DIM)
EVEN_KV_WIDTHS = (SWA_KV_HEADS * SWA_HEAD_DIM, SWA_KV_HEADS * SWA_HEAD_DIM)
EVEN_Q_COLS = sum(EVEN_Q_WIDTHS)
EVEN_IN = EVEN_Q_COLS + sum(EVEN_KV_WIDTHS)
EVEN_MIX = CONV_WIDTH + SWA_HEADS * SWA_HEAD_DIM
ODD_Q_WIDTHS = (MLA_Q_RANK, DIFF_HEADS * 2 * DIFF_DIM)
ODD_KV_WIDTHS = (MLA_KV_RANK, MLA_ROPE, DIFF_HEADS * 2 * DIFF_DIM, DIFF_HEADS * DIFF_V)
ODD_Q_COLS = sum(ODD_Q_WIDTHS)
ODD_IN = ODD_Q_COLS + sum(ODD_KV_WIDTHS)
ODD_MIX = MLA_HEADS * MLA_V + DIFF_HEADS * DIFF_V

kernel_name = 'hybrid_flow_backbone'


def rms_norm(x, g):
    xf = x.astype(jnp.float32)
    y = xf * lax.rsqrt(jnp.mean(xf * xf, axis=-1, keepdims=True) + EPS)
    return (y * g.astype(jnp.float32)).astype(x.dtype)


def modulate(h, shift, scale):
    return h * (1 + scale) + shift


def split_cols(p, widths):
    idx, acc = [], 0
    for w in widths[:-1]:
        acc += w
        idx.append(acc)
    return jnp.split(p, idx, axis=-1)


def axial_rope_tables(rows, cols, rot_dim):
    axis_dim = rot_dim // 2
    inv_freq = 1.0 / (ROPE_THETA ** (jnp.arange(0, axis_dim, 2, dtype=jnp.float32) / axis_dim))
    ang_r = rows.astype(jnp.float32)[:, None] * inv_freq[None, :]
    ang_c = cols.astype(jnp.float32)[:, None] * inv_freq[None, :]
    return (jnp.cos(ang_r), jnp.sin(ang_r), jnp.cos(ang_c), jnp.sin(ang_c))


def _rotate(x, cos, sin):
    n = x.shape[-1] // 2
    shape = (cos.shape[0],) + (1,) * (x.ndim - 3) + (n,)
    cs, sn = cos.reshape(shape), sin.reshape(shape)
    x1, x2 = x[..., :n], x[..., n:]
    return jnp.concatenate([x1 * cs - x2 * sn, x2 * cs + x1 * sn], axis=-1)


def axial_rope(x, tabs):
    cr, sr, cc, sc = tabs
    h = x.shape[-1] // 2
    xf = x.astype(jnp.float32)
    out = jnp.concatenate([_rotate(xf[..., :h], cr, sr), _rotate(xf[..., h:], cc, sc)], axis=-1)
    return out.astype(x.dtype)


def short_conv(u, w):
    up = jnp.pad(u, ((0, 0), (1, 1), (0, 0)))
    return up[:, :-2] * w[0] + up[:, 1:-1] * w[1] + up[:, 2:] * w[2]


def banded_window_attn(q, k, v, k_ctx, v_ctx, sink):
    Bn, S, H, d = q.shape
    G = k.shape[2]
    R = H // G
    nb = S // BLOCK
    scale = d ** -0.5

    def band(t):
        tp = jnp.pad(t, ((0, 0), (BLOCK, BLOCK), (0, 0), (0, 0))).reshape(Bn, nb + 2, BLOCK, G, d)
        return jnp.moveaxis(jnp.concatenate([tp[:, :-2], tp[:, 1:-1], tp[:, 2:]], axis=2), 1, 0)

    qb = jnp.moveaxis(q.reshape(Bn, nb, BLOCK, G, R, d), 1, 0)
    kb, vb = band(k), band(v)
    rel = jnp.arange(3 * BLOCK)[None, :] - BLOCK - jnp.arange(BLOCK)[:, None]
    sink_l = sink.reshape(1, G, R, 1, 1).astype(jnp.float32)
    n_win = 3 * BLOCK
    n_ctx = k_ctx.shape[1]

    def one_block(args):
        n, qn, kn, vn = args
        k_pos = n * BLOCK - BLOCK + jnp.arange(3 * BLOCK)
        ok = (jnp.abs(rel) <= WINDOW) & (k_pos >= 0)[None, :] & (k_pos < S)[None, :]
        s_win = jnp.einsum('bqgrd,bkgd->bgrqk', qn, kn).astype(jnp.float32) * scale
        s_win = jnp.where(ok, s_win, -jnp.inf)
        s_ctx = jnp.einsum('bqgrd,bcgd->bgrqc', qn, k_ctx).astype(jnp.float32) * scale
        s_snk = jnp.broadcast_to(sink_l, s_win.shape[:-1] + (1,))
        p = jax.nn.softmax(jnp.concatenate([s_win, s_ctx, s_snk], axis=-1), axis=-1)
        p_win = p[..., :n_win].astype(vn.dtype)
        p_ctx = p[..., n_win:n_win + n_ctx].astype(vn.dtype)
        return jnp.einsum('bgrqk,bkgd->bqgrd', p_win, vn) + jnp.einsum('bgrqc,bcgd->bqgrd', p_ctx, v_ctx)

    o = lax.map(one_block, (jnp.arange(nb), qb, kb, vb))
    return jnp.moveaxis(o, 0, 1).reshape(Bn, S, H * d)


def sink_gqa_attn(q, k, v, sink):
    Bn, L, H, d = q.shape
    G = k.shape[2]
    R = H // G
    s = jnp.einsum('blgrd,bmgd->bgrlm', q.reshape(Bn, L, G, R, d), k).astype(jnp.float32) * (d ** -0.5)
    s_snk = jnp.broadcast_to(sink.reshape(1, G, R, 1, 1).astype(jnp.float32), s.shape[:-1] + (1,))
    p = jax.nn.softmax(jnp.concatenate([s, s_snk], axis=-1), axis=-1)[..., :-1]
    o = jnp.einsum('bgrlm,bmgd->blgrd', p.astype(v.dtype), v)
    return o.reshape(Bn, L, H * d)


def softmax_attn(q, k, v, scale):
    s = jnp.einsum('bqhd,bkhd->bhqk', q, k).astype(jnp.float32) * scale
    p = jax.nn.softmax(s, axis=-1).astype(v.dtype)
    return jnp.einsum('bhqk,bkhd->bqhd', p, v)


def diff_softmax_attn(q, k, v, lam, scale):
    s = jnp.einsum('bqhcd,bkhcd->bhcqk', q, k).astype(jnp.float32) * scale
    p = jax.nn.softmax(s, axis=-1)
    pd = p[:, :, 0] - lam * p[:, :, 1]
    return jnp.einsum('bhqk,bkhd->bqhd', pd.astype(v.dtype), v)


def sweep_query_blocks(fn, q):
    Bn, S = q.shape[:2]
    nb = S // BLOCK
    qb = jnp.moveaxis(q.reshape((Bn, nb, BLOCK) + q.shape[2:]), 1, 0)
    o = jnp.moveaxis(lax.map(fn, qb), 0, 1)
    return o.reshape((Bn, S) + o.shape[3:])


def diff_lambda_init(layer):
    return 0.8 - 0.6 * math.exp(-0.3 * layer)


def conv_window_mixer(h_lat, h_ctx, w_in, conv_w, sink, w_out, rope, need_ctx):
    Bn, S, _ = h_lat.shape
    L = h_ctx.shape[1]
    H, G, d = SWA_HEADS, SWA_KV_HEADS, SWA_HEAD_DIM
    p = h_lat @ w_in
    b_gate, c_gate, u, q = split_cols(p[..., :EVEN_Q_COLS], EVEN_Q_WIDTHS)
    k, v = split_cols(p[..., EVEN_Q_COLS:], EVEN_KV_WIDTHS)
    k_c, v_c = split_cols(h_ctx @ w_in[:, EVEN_Q_COLS:], EVEN_KV_WIDTHS)
    k_c = k_c.reshape(Bn, L, G, d)
    v_c = v_c.reshape(Bn, L, G, d)
    conv_out = b_gate * short_conv(c_gate * u, conv_w)
    q = axial_rope(q.reshape(Bn, S, H, d), rope)
    k = axial_rope(k.reshape(Bn, S, G, d), rope)
    attn = banded_window_attn(q, k, v.reshape(Bn, S, G, d), k_c, v_c, sink)
    y_lat = jnp.concatenate([conv_out, attn], axis=-1) @ w_out
    y_ctx = None
    if need_ctx:
        b_c, c_c, u_c, q_c = split_cols(h_ctx @ w_in[:, :EVEN_Q_COLS], EVEN_Q_WIDTHS)
        conv_c = b_c * short_conv(c_c * u_c, conv_w)
        attn_c = sink_gqa_attn(q_c.reshape(Bn, L, H, d), k_c, v_c, sink)
        y_ctx = jnp.concatenate([conv_c, attn_c], axis=-1) @ w_out
    return y_lat, y_ctx


def mla_diff_mixer(h_lat, h_ctx, w_in, q_norm_g, kv_norm_g, w_q_up, w_kv_up, lam_p, subln_g, w_out,
                   rope_mla, rope_diff, lam_init, need_ctx):
    Bn, S, _ = h_lat.shape
    L = h_ctx.shape[1]
    lp = lam_p.astype(jnp.float32)
    lam = jnp.exp(jnp.sum(lp[0] * lp[1])) - jnp.exp(jnp.sum(lp[2] * lp[3])) + lam_init
    mla_scale = (MLA_NOPE + MLA_ROPE) ** -0.5
    diff_scale = DIFF_DIM ** -0.5

    def mla_query(q_down, rope):
        n = q_down.shape[1]
        q = (rms_norm(q_down, q_norm_g) @ w_q_up).reshape(Bn, n, MLA_HEADS, MLA_NOPE + MLA_ROPE)
        q_pe = q[..., MLA_NOPE:] if rope is None else axial_rope(q[..., MLA_NOPE:], rope)
        return jnp.concatenate([q[..., :MLA_NOPE], q_pe], axis=-1)

    def mla_key_value(kv_down, k_pe, rope):
        n = kv_down.shape[1]
        kv = (rms_norm(kv_down, kv_norm_g) @ w_kv_up).reshape(Bn, n, MLA_HEADS, MLA_NOPE + MLA_V)
        k_pe = k_pe[:, :, None, :]
        if rope is not None:
            k_pe = axial_rope(k_pe, rope)
        k = jnp.concatenate([kv[..., :MLA_NOPE], jnp.broadcast_to(k_pe, (Bn, n, MLA_HEADS, MLA_ROPE))], axis=-1)
        return k, kv[..., MLA_NOPE:]

    def diff_qk(t, rope):
        t = t.reshape(Bn, t.shape[1], DIFF_HEADS, 2, DIFF_DIM)
        return t if rope is None else axial_rope(t, rope)

    def merge(o_m, o_d):
        n = o_m.shape[1]
        o_d = rms_norm(o_d, subln_g) * (1.0 - lam_init)
        return jnp.concatenate([o_m.reshape(Bn, n, -1), o_d.reshape(Bn, n, -1)], axis=-1) @ w_out

    p = h_lat @ w_in
    mq_down, dq = split_cols(p[..., :ODD_Q_COLS], ODD_Q_WIDTHS)
    kv_down, k_pe, dk, dv = split_cols(p[..., ODD_Q_COLS:], ODD_KV_WIDTHS)
    kv_down_c, k_pe_c, dk_c, dv_c = split_cols(h_ctx @ w_in[:, ODD_Q_COLS:], ODD_KV_WIDTHS)
    mk_lat, mv_lat = mla_key_value(kv_down, k_pe, rope_mla)
    mk_c, mv_c = mla_key_value(kv_down_c, k_pe_c, None)
    mk_all = jnp.concatenate([mk_lat, mk_c], axis=1)
    mv_all = jnp.concatenate([mv_lat, mv_c], axis=1)
    dk_c = diff_qk(dk_c, None)
    dv_c = dv_c.reshape(Bn, L, DIFF_HEADS, DIFF_V)
    dk_all = jnp.concatenate([diff_qk(dk, rope_diff), dk_c], axis=1)
    dv_all = jnp.concatenate([dv.reshape(Bn, S, DIFF_HEADS, DIFF_V), dv_c], axis=1)
    o_m = sweep_query_blocks(lambda qb: softmax_attn(qb, mk_all, mv_all, mla_scale), mla_query(mq_down, rope_mla))
    o_d = sweep_query_blocks(lambda qb: diff_softmax_attn(qb, dk_all, dv_all, lam, diff_scale), diff_qk(dq, rope_diff))
    y_lat = merge(o_m, o_d)
    y_ctx = None
    if need_ctx:
        mq_c, dq_c = split_cols(h_ctx @ w_in[:, :ODD_Q_COLS], ODD_Q_WIDTHS)
        o_mc = softmax_attn(mla_query(mq_c, None), mk_c, mv_c, mla_scale)
        o_dc = diff_softmax_attn(diff_qk(dq_c, None), dk_c, dv_c, lam, diff_scale)
        y_ctx = merge(o_mc, o_dc)
    return y_lat, y_ctx


def swiglu(h, w_gate_up, w_down):
    g, u = jnp.split(h @ w_gate_up, 2, axis=-1)
    return (jax.nn.silu(g) * u) @ w_down


def moe_swiglu(h, w_router, w_gate_up, w_down):
    T, D = h.shape
    logits = (h @ w_router).astype(jnp.float32)
    top_logit, top_e = lax.top_k(logits, TOP_K)
    weights = jax.nn.softmax(top_logit, axis=-1)
    A = T * TOP_K
    flat_e = top_e.reshape(A)
    order = jnp.argsort(flat_e)
    sorted_e = flat_e[order]
    sorted_tok = order // TOP_K
    counts = jnp.bincount(flat_e, length=N_EXPERTS)
    starts = jnp.cumsum(counts) - counts
    padded = (counts + MOE_BLOCK - 1) // MOE_BLOCK * MOE_BLOCK
    ends = jnp.cumsum(padded)
    pstarts = ends - padded
    dest = pstarts[sorted_e] + jnp.arange(A) - starts[sorted_e]
    n_blocks = -(-(A + N_EXPERTS * (MOE_BLOCK - 1)) // MOE_BLOCK)
    buf = jnp.zeros((n_blocks * MOE_BLOCK, D), h.dtype).at[dest].set(h[sorted_tok])
    block_e = jnp.clip(jnp.searchsorted(ends, jnp.arange(n_blocks) * MOE_BLOCK, side='right'), 0, N_EXPERTS - 1)

    def expert_block(args):
        rows, e = args
        g, u = jnp.split(rows @ w_gate_up[e], 2, axis=-1)
        return (jax.nn.silu(g) * u) @ w_down[e]

    out = lax.map(expert_block, (buf.reshape(n_blocks, MOE_BLOCK, D), block_e)).reshape(n_blocks * MOE_BLOCK, D)
    y = out[dest] * weights.reshape(A)[order][:, None].astype(h.dtype)
    return jax.ops.segment_sum(y, sorted_tok, num_segments=T)


def setup_inputs(seed: int = 0) -> dict:
    key = jax.random.key(seed)
    ks = jax.random.split(key, 24)
    n_even = (DEPTH + 1) // 2
    n_odd = DEPTH // 2
    f32 = jnp.float32

    def nrm(k, shape, fan_in, gain=1.0):
        return jax.random.normal(k, shape, f32) * (gain * fan_in ** -0.5)

    def gain(k, shape):
        return 1.0 + 0.05 * jax.random.normal(k, shape, f32)

    return {
        'x': jax.random.normal(ks[0], (BATCH, SEQ, D_MODEL), f32),
        'c': jax.random.normal(ks[1], (BATCH, D_MODEL), f32),
        'ctx': jax.random.normal(ks[2], (BATCH, CTX_LEN, D_MODEL), f32),
        'c_ctx': jax.random.normal(ks[3], (D_MODEL,), f32),
        'w_mod': nrm(ks[4], (DEPTH, D_MODEL, N_MOD * D_MODEL), D_MODEL, 0.5),
        'b_mod': 0.02 * jax.random.normal(ks[5], (DEPTH, N_MOD * D_MODEL), f32),
        'norm_g': gain(ks[6], (DEPTH, 4, D_MODEL)),
        'w_in_even': nrm(ks[7], (n_even, D_MODEL, EVEN_IN), D_MODEL),
        'conv_w': nrm(ks[8], (n_even, CONV_K, CONV_WIDTH), CONV_K),
        'sink': 0.5 * jax.random.normal(ks[9], (n_even, SWA_HEADS), f32),
        'w_out_even': nrm(ks[10], (n_even, EVEN_MIX, D_MODEL), EVEN_MIX),
        'w_in_odd': nrm(ks[11], (n_odd, D_MODEL, ODD_IN), D_MODEL),
        'mla_q_norm_g': gain(ks[12], (n_odd, MLA_Q_RANK)),
        'mla_kv_norm_g': gain(ks[13], (n_odd, MLA_KV_RANK)),
        'w_q_up': nrm(ks[14], (n_odd, MLA_Q_RANK, MLA_HEADS * (MLA_NOPE + MLA_ROPE)), MLA_Q_RANK),
        'w_kv_up': nrm(ks[15], (n_odd, MLA_KV_RANK, MLA_HEADS * (MLA_NOPE + MLA_V)), MLA_KV_RANK),
        'diff_lambda': 0.1 * jax.random.normal(ks[16], (n_odd, 4, DIFF_DIM), f32),
        'diff_subln_g': gain(ks[17], (n_odd, DIFF_V)),
        'w_out_odd': nrm(ks[18], (n_odd, ODD_MIX, D_MODEL), ODD_MIX),
        'w_ff_gu': nrm(ks[19], (n_even, D_MODEL, 2 * FF_DENSE), D_MODEL),
        'w_ff_down': nrm(ks[20], (n_even, FF_DENSE, D_MODEL), FF_DENSE),
        'w_router': nrm(ks[21], (n_odd, D_MODEL, N_EXPERTS), D_MODEL),
        'w_exp_gu': nrm(ks[22], (n_odd, N_EXPERTS, D_MODEL, 2 * FF_EXPERT), D_MODEL),
        'w_exp_down': nrm(ks[23], (n_odd, N_EXPERTS, FF_EXPERT, D_MODEL), FF_EXPERT),
    }


def reference(x, c, ctx, c_ctx, w_mod, b_mod, norm_g, w_in_even, conv_w, sink, w_out_even,
              w_in_odd, mla_q_norm_g, mla_kv_norm_g, w_q_up, w_kv_up, diff_lambda, diff_subln_g,
              w_out_odd, w_ff_gu, w_ff_down, w_router, w_exp_gu, w_exp_down):
    Bn, S, D = x.shape
    L = ctx.shape[1]
    ROWS = S // GRID_W
    rows = jnp.repeat(jnp.arange(ROWS), GRID_W)
    cols = jnp.tile(jnp.arange(GRID_W), ROWS)
    rope64 = axial_rope_tables(rows, cols, SWA_HEAD_DIM)
    rope32 = axial_rope_tables(rows, cols, MLA_ROPE)
    x_ctx = ctx
    for layer in range(DEPTH):
        need_ctx = layer < DEPTH - 1
        i = layer // 2
        m_lat = jnp.split((jax.nn.silu(c) @ w_mod[layer] + b_mod[layer])[:, None, :], N_MOD, axis=-1)
        m_ctx = jnp.split(jax.nn.silu(c_ctx) @ w_mod[layer] + b_mod[layer], N_MOD, axis=-1)
        g = norm_g[layer]
        h_lat = modulate(rms_norm(x, g[0]), m_lat[0], m_lat[1])
        h_ctx = modulate(rms_norm(x_ctx, g[0]), m_ctx[0], m_ctx[1])
        if layer % 2 == 0:
            y_lat, y_ctx = conv_window_mixer(h_lat, h_ctx, w_in_even[i], conv_w[i], sink[i], w_out_even[i],
                                             rope64, need_ctx)
        else:
            y_lat, y_ctx = mla_diff_mixer(h_lat, h_ctx, w_in_odd[i], mla_q_norm_g[i], mla_kv_norm_g[i],
                                          w_q_up[i], w_kv_up[i], diff_lambda[i], diff_subln_g[i], w_out_odd[i],
                                          rope32, rope64, diff_lambda_init(layer), need_ctx)
        x = x + m_lat[2] * rms_norm(y_lat, g[1])
        f_in = modulate(rms_norm(x, g[2]), m_lat[3], m_lat[4]).reshape(Bn * S, D)
        if need_ctx:
            x_ctx = x_ctx + m_ctx[2] * rms_norm(y_ctx, g[1])
            f_ctx = modulate(rms_norm(x_ctx, g[2]), m_ctx[3], m_ctx[4]).reshape(Bn * L, D)
            f_in = jnp.concatenate([f_in, f_ctx], axis=0)
        if layer % 2 == 0:
            f = swiglu(f_in, w_ff_gu[i], w_ff_down[i])
        else:
            f = moe_swiglu(f_in, w_router[i], w_exp_gu[i], w_exp_down[i])
        x = x + m_lat[5] * rms_norm(f[:Bn * S].reshape(Bn, S, D), g[3])
        if need_ctx:
            x_ctx = x_ctx + m_ctx[5] * rms_norm(f[Bn * S:].reshape(Bn, L, D), g[3])
    return x
```

```cpp
#include <hip/hip_runtime.h>
#include <cstdio>
#include <cstdint>
#include <cstddef>

#ifndef FFN_DOWN_FP8
#define FFN_DOWN_FP8 1
#endif
#ifndef MK_MULTI_LAUNCH
#define MK_MULTI_LAUNCH 0
#endif

#define LAS __attribute__((address_space(3)))
typedef unsigned short bf16_t;
typedef short bf16x8 __attribute__((ext_vector_type(8)));
typedef short s16x4 __attribute__((ext_vector_type(4)));
typedef float f32x4 __attribute__((ext_vector_type(4)));
typedef float f32x2 __attribute__((ext_vector_type(2)));
typedef float f32x16 __attribute__((ext_vector_type(16)));
typedef unsigned u32x4 __attribute__((ext_vector_type(4)));
typedef unsigned u32x2 __attribute__((ext_vector_type(2)));

constexpr int DM = 1024, NB = 8, SEQ = 4096, CTXL = 256;
constexpr int MLAT = NB * SEQ, MCTX = NB * CTXL, MTOT = MLAT + MCTX;
constexpr int EVEN_IN = 2304, ODD_INP = 2048  , FFD = 2816, FFE = 3584, NEXP = 8;
constexpr int MG_ROWS = 2 * MTOT + NEXP * 256;
constexpr float EPSN = 1e-6f;
constexpr float LOG2E = 1.4426950408889634f;
constexpr int NTHREADS = 512, NWAVES = 8;
constexpr int LDS_BYTES = 147456;
constexpr int ROWS_PER_BLOCK = MTOT / 256;

constexpr size_t al256(size_t x) { return (x + 255) & ~(size_t)255; }
constexpr size_t OFF_CTL   = 0;
constexpr size_t CTL_BYTES = 65536;
constexpr size_t OFF_MOD   = OFF_CTL + CTL_BYTES;
constexpr size_t OFF_TAB   = al256(OFF_MOD + (size_t)4 * 9 * 6144 * 4);
constexpr size_t OFF_SLOT  = al256(OFF_TAB + 16384);
constexpr size_t OFF_TOK   = al256(OFF_SLOT + (size_t)MTOT * 16);
constexpr size_t OFF_TWT   = al256(OFF_TOK + (size_t)NEXP * MTOT * 4);
constexpr size_t OFF_GWT   = al256(OFF_TWT + (size_t)NEXP * MTOT * 4);
constexpr size_t OFF_GSC   = al256(OFF_GWT + (size_t)NEXP * MTOT * 4);
constexpr size_t OFF_FSC   = al256(OFF_GSC + (size_t)MG_ROWS * 4);
constexpr size_t OFF_WSCD  = al256(OFF_FSC + (size_t)MTOT * 4);
constexpr size_t OFF_WSCE  = al256(OFF_WSCD + (size_t)2 * 2 * FFD * 4);
constexpr size_t OFF_WSCI  = al256(OFF_WSCE + (size_t)16 * 2 * FFE * 4);
constexpr size_t OFF_WINE  = al256(OFF_WSCI + (size_t)(2 * EVEN_IN + 2 * ODD_INP) * 4);
constexpr size_t SZ_WINE   = (size_t)EVEN_IN * 1024 * 2;
constexpr size_t OFF_WOUTE = OFF_WINE + 2 * SZ_WINE;
constexpr size_t SZ_WOUT   = (size_t)1024 * 1024 * 2;
constexpr size_t OFF_WINO  = OFF_WOUTE + 2 * SZ_WOUT;
constexpr size_t SZ_WINO   = (size_t)ODD_INP * 1024 * 2;
constexpr size_t OFF_WQUP  = OFF_WINO + 2 * SZ_WINO;
constexpr size_t SZ_WQUP   = (size_t)768 * 256 * 2;
constexpr size_t OFF_WKVUP = OFF_WQUP + 2 * SZ_WQUP;
constexpr size_t SZ_WKVUP  = (size_t)1024 * 256 * 2;
constexpr size_t OFF_WOUTO = OFF_WKVUP + 2 * SZ_WKVUP;
constexpr size_t OFF_WGU   = OFF_WOUTO + 2 * SZ_WOUT;
constexpr size_t SZ_WGU    = (size_t)2 * FFD * 1024 * 2;
constexpr size_t OFF_WDN   = OFF_WGU + 2 * SZ_WGU;
constexpr size_t SZ_WDN    = (size_t)1024 * FFD * 2;
constexpr size_t OFF_WEGU  = OFF_WDN + 2 * SZ_WDN;
constexpr size_t SZ_WEGU   = (size_t)2 * FFE * 1024 * 2;
constexpr size_t OFF_WEDN  = OFF_WEGU + 16 * SZ_WEGU;
constexpr size_t SZ_WEDN   = (size_t)1024 * FFE * 2;
constexpr size_t OFF_XS    = al256(OFF_WEDN + 16 * SZ_WEDN);
constexpr size_t OFF_ABUF  = OFF_XS + (size_t)MTOT * 1024 * 4;
constexpr size_t OFF_U     = OFF_ABUF + (size_t)MTOT * 1024 * 2;
constexpr size_t SZ_U      = (size_t)MG_ROWS * FFE * 2;
constexpr size_t U_P_E   = 0;
constexpr size_t U_MIX_E = U_P_E + (size_t)MTOT * EVEN_IN * 2;
constexpr size_t U_Y_E   = U_MIX_E + (size_t)MTOT * 1024 * 2;
constexpr size_t U_ACT_E = 0;
constexpr size_t U_P_O   = 0;
constexpr size_t U_NRM_O = U_P_O + (size_t)MTOT * ODD_INP * 2;
constexpr size_t U_KVN_O = U_NRM_O + (size_t)MTOT * 256 * 2;
constexpr size_t U_SSQ_O = U_NRM_O;
constexpr size_t U_QF_O  = U_KVN_O + (size_t)MTOT * 256 * 2;
constexpr size_t U_KVF_O = U_QF_O + (size_t)MTOT * 768 * 2;
constexpr size_t U_MIX_O = U_KVF_O + (size_t)MTOT * 1024 * 2;
static_assert(U_MIX_O + (size_t)MTOT * 1024 * 2 <= SZ_U, "odd-layer map fits the union region");
static_assert(U_Y_E + (size_t)MTOT * 1024 * 4 <= SZ_U, "even-layer map fits the union region");
static_assert((size_t)MTOT * FFD * 2 <= U_Y_E, "dense act must not overlap F");
constexpr int    CAPR      = MTOT;
constexpr size_t OFF_GBUF  = OFF_U + SZ_U;
constexpr size_t OFF_EOUT  = OFF_GBUF + (size_t)NEXP * CAPR * 1024;
constexpr size_t WS_END    = OFF_EOUT + (size_t)MG_ROWS * 1024 * 2;

constexpr int CW_MOECNT = 4096;

struct Params { const float* in[24]; float* out; unsigned char* ws; };

__device__ __forceinline__ unsigned pk_bf16(float lo, float hi) { typedef __bf16 b2 __attribute__((ext_vector_type(2))); f32x2 v = {lo, hi}; b2 b = __builtin_convertvector(v, b2); return __builtin_bit_cast(unsigned, b); }
__device__ __forceinline__ float bf_lo(unsigned w) { return __uint_as_float(w << 16); }
__device__ __forceinline__ float bf_hi(unsigned w) { return __uint_as_float(w & 0xffff0000u); }
__device__ __forceinline__ float clamp448(float x) { return __builtin_fminf(__builtin_fmaxf(x, -448.0f), 448.0f); }
__device__ __forceinline__ unsigned pk_fp8x4(float a, float b, float c, float d) {
    int v = __builtin_amdgcn_cvt_pk_fp8_f32(clamp448(a), clamp448(b), 0, false); v = __builtin_amdgcn_cvt_pk_fp8_f32(clamp448(c), clamp448(d), v, true); return (unsigned)v; }
__device__ __forceinline__ unsigned pk_i8x4(float a, float b, float c, float d) {
    const int ia = (int)__builtin_rintf(a), ib = (int)__builtin_rintf(b), ic = (int)__builtin_rintf(c), id = (int)__builtin_rintf(d);
    return (unsigned)(ia & 0xff) | ((unsigned)(ib & 0xff) << 8) | ((unsigned)(ic & 0xff) << 16) | ((unsigned)id << 24); }
template <int CTRL> __device__ __forceinline__ float dppf(float v) { return __builtin_bit_cast(float, __builtin_amdgcn_update_dpp(0, __builtin_bit_cast(int, v), CTRL, 0xF, 0xF, true)); }
__device__ __forceinline__ float wave_max(float v) {
    v = fmaxf(v, dppf<0xB1>(v)); v = fmaxf(v, dppf<0x4E>(v)); v = fmaxf(v, dppf<0x141>(v)); v = fmaxf(v, dppf<0x140>(v));
    { const auto rr = __builtin_amdgcn_permlane16_swap(__float_as_uint(v), __float_as_uint(v), false, false); v = fmaxf(__uint_as_float(rr[0]), __uint_as_float(rr[1])); }
    { const auto rr = __builtin_amdgcn_permlane32_swap(__float_as_uint(v), __float_as_uint(v), false, false); v = fmaxf(__uint_as_float(rr[0]), __uint_as_float(rr[1])); }
    return v; }
__device__ __forceinline__ float wave_sum(float v) {
    v += dppf<0xB1>(v); v += dppf<0x4E>(v); v += dppf<0x141>(v); v += dppf<0x140>(v);
    { const auto rr = __builtin_amdgcn_permlane16_swap(__float_as_uint(v), __float_as_uint(v), false, false); v = __uint_as_float(rr[0]) + __uint_as_float(rr[1]); }
    { const auto rr = __builtin_amdgcn_permlane32_swap(__float_as_uint(v), __float_as_uint(v), false, false); v = __uint_as_float(rr[0]) + __uint_as_float(rr[1]); }
    return v; }
__device__ __forceinline__ float fast_exp2(float x) { return __builtin_amdgcn_exp2f(x); }
__device__ __forceinline__ float fast_rcp(float x) { return __builtin_amdgcn_rcpf(x); }
__device__ __forceinline__ float silu_f(float g) { return g * fast_rcp(1.0f + fast_exp2(-g * LOG2E)); }
__device__ __forceinline__ int lane_id() { int l; asm volatile("v_mbcnt_lo_u32_b32 %0, -1, 0\n\tv_mbcnt_hi_u32_b32 %0, -1, %0" : "=v"(l)); return l; }
__device__ __forceinline__ int opaque_tid(int wv) { int t = (wv << 6) | lane_id(); asm volatile("" : "+v"(t)); return t; }
__device__ __forceinline__ int crow(int r, int hi) { return (r & 3) + 8 * (r >> 2) + 4 * hi; }

#define XB_TMO      128
#define XB_XCNT(j)  (256  + 64 * (j))
#define XB_XSUB(j)  (1280 + 64 * (j))
#define XB_XGEN(j)  (2304 + 64 * (j))
#define XB_TOP      3328
#define XB_TOPGEN   3392
#define XCD_BAR_WORDS 3456
#define XB_SPIN_CAP (1u << 22)
__device__ __forceinline__ unsigned xb_ld(unsigned* p)              { return __hip_atomic_load(p, __ATOMIC_RELAXED, __HIP_MEMORY_SCOPE_AGENT); }
__device__ __forceinline__ unsigned xb_add(unsigned* p, unsigned v) { return __hip_atomic_fetch_add(p, v, __ATOMIC_RELAXED, __HIP_MEMORY_SCOPE_AGENT); }
__device__ __forceinline__ unsigned xb_xcc_id() { return (unsigned)__builtin_amdgcn_s_getreg((3 << 11) | 20) & 0xFu; }
#define XB_SPIN(cond, bar) do { unsigned _sp = 0; while (cond) { __builtin_amdgcn_s_sleep(1); \
    if ((++_sp & 255u) == 0u) { if (xb_ld(&(bar)[XB_TMO])) break; if (_sp > XB_SPIN_CAP) { atomicAdd(&(bar)[XB_TMO], 1u); break; } } } } while (0)
struct XcdBarrier { unsigned* bar; unsigned x; volatile LAS unsigned* st; int wv; };
__device__ __forceinline__ XcdBarrier xcd_barrier_post(unsigned* bar, volatile LAS unsigned* st, int wv) {
    XcdBarrier b; b.bar = bar; b.x = xb_xcc_id(); b.st = st; b.wv = wv;
    if (wv == 0 && lane_id() == 0) (void)xb_add(&bar[XB_XCNT(b.x)], 1u);
    return b;
}
__device__ __forceinline__ void xcd_barrier_complete(unsigned* bar, unsigned x, unsigned& nloc, unsigned& nx) {
    const unsigned G = gridDim.x * gridDim.y * gridDim.z;
    unsigned sum, cnt, mine, sp = 0u;
    for (;;) {
        sum = 0u; cnt = 0u; mine = 0u;
#pragma unroll
        for (unsigned j = 0; j < 16; ++j) { const unsigned c = xb_ld(&bar[XB_XCNT(j)]); sum += c; cnt += (c > 0u) ? 1u : 0u; mine = (j == x) ? c : mine; }
        if (sum == G) break;
        __builtin_amdgcn_s_sleep(1);
        if ((++sp & 255u) == 0u) { if (xb_ld(&bar[XB_TMO])) break; if (sp > XB_SPIN_CAP) { atomicAdd(&bar[XB_TMO], 1u); break; } }
    }
    nloc = mine > 0u ? mine : 1u; nx = cnt > 0u ? cnt : 1u;
}
__device__ __forceinline__ void xcd_barrier(const XcdBarrier& b) {
    asm volatile("s_waitcnt vmcnt(0)" ::: "memory");
    __syncthreads();
    if (b.wv == 0 && lane_id() == 0) {
        unsigned* bar = b.bar;
        __builtin_amdgcn_s_waitcnt(0);
        unsigned nloc = b.st[0], nx = b.st[1];
        if (nloc == 0u) { xcd_barrier_complete(bar, b.x, nloc, nx); b.st[0] = nloc; b.st[1] = nx; }
        const unsigned old = xb_add(&bar[XB_XSUB(b.x)], 1u);
        const unsigned gen = old / nloc;
        if (old + 1u == (gen + 1u) * nloc) {
            __builtin_amdgcn_fence(__ATOMIC_RELEASE, "agent");
            asm volatile("s_waitcnt vmcnt(0)" ::: "memory");
            const unsigned og = xb_add(&bar[XB_TOP], 1u);
            const unsigned tg = og / nx;
            if (og + 1u == (tg + 1u) * nx) xb_add(&bar[XB_TOPGEN], 1u);
            else XB_SPIN(xb_ld(&bar[XB_TOPGEN]) == tg, bar);
            __builtin_amdgcn_fence(__ATOMIC_ACQUIRE, "agent");
            xb_add(&bar[XB_XGEN(b.x)], 1u);
            asm volatile("s_waitcnt vmcnt(0)" ::: "memory");
        } else {
            XB_SPIN(xb_ld(&bar[XB_XGEN(b.x)]) == gen, bar);
            __builtin_amdgcn_fence(__ATOMIC_ACQUIRE, "agent");
            asm volatile("s_waitcnt vmcnt(0)" ::: "memory");
        }
    }
    __syncthreads();
}

namespace pg8 {
constexpr int BM = 256, BK = 64, HALF = 128, HTB = HALF * BK * 2, STAGE_BYTES = 8 * HTB, NXCD = 8, WGM = 8;
__host__ __device__ __forceinline__ int lds_byte(int r, int c) { const int st = (r >> 4) * 2 + (c >> 5), rr = r & 15, cc = c & 31, ob = rr * 64 + cc * 2; return st * 1024 + (ob ^ (((ob >> 9) & 1) << 5)); }
__host__ __device__ __forceinline__ void stage_rc(int b, int& R, int& C) { const int st = b / 1024, sb = b % 1024, swz = sb ^ (((sb >> 9) & 1) << 5); R = (st >> 1) * 16 + swz / 64; C = (st & 1) * 32 + (swz % 64) / 2; }
__host__ __device__ __forceinline__ int perm32(int rho) { const int n = rho >> 4, i = rho & 15; return 8 * (i >> 2) + 4 * n + (i & 3); }
typedef int v8i32 __attribute__((ext_vector_type(8))); typedef int v4i32 __attribute__((ext_vector_type(4)));
__device__ __forceinline__ v8i32 cat8(bf16x8 a, bf16x8 b) { const v4i32 x = __builtin_bit_cast(v4i32, a), y = __builtin_bit_cast(v4i32, b); return (v8i32){x[0], x[1], x[2], x[3], y[0], y[1], y[2], y[3]}; }
struct Unit { int pm, pn, pa, ro; };
struct Gemm { const void* A; const void* Bt; int lda, K; };
struct StaticOrder {
    int nM, nN, nwg, G, c;
    __device__ void init(int nM_, int nN_, int G_, int c_) { nM = nM_; nN = nN_; nwg = nM * nN; G = G_; c = c_; }
    __device__ __forceinline__ bool next(int i, Unit& u) const {
        const long L = (long)i * G + c; if (L >= nwg) return false;
        int wgid = (int)L; { const int q = nwg / NXCD, r = nwg % NXCD, xcd = wgid % NXCD, off = wgid / NXCD; wgid = (xcd < r ? xcd * (q + 1) : r * (q + 1) + (xcd - r) * q) + off; }
        const int nig = WGM * nN, gid = wgid / nig, fm = gid * WGM, gsz = (nM - fm) < WGM ? (nM - fm) : WGM;
        u.pm = fm + ((wgid % nig) % gsz); u.pn = (wgid % nig) / gsz; u.pa = u.pm; u.ro = 0; return true;
    }
};
struct MoeOrder {
    StaticOrder so; int ts[9]; bool gatherA;
    __device__ __forceinline__ bool next(int i, Unit& u) const {
        if (!so.next(i, u)) return false;
        int e = 0;
#pragma unroll
        for (int j = 1; j < 8; ++j) e += (u.pm >= ts[j]) ? 1 : 0;
        int te = 0;
#pragma unroll
        for (int j = 0; j < 8; ++j) te = (j == e) ? ts[j] : te;
        u.pn += e * so.nN; u.pa = gatherA ? e * (CAPR / 256) + (u.pm - te) : u.pm; u.ro = e * MTOT - te * 256; return true;
    }
};

template <int FMT, class Epi, class Sched>
__device__ __forceinline__ void gemm_phase(LAS unsigned char* lds, const Gemm g, const Sched& S, const Epi& E, const int wv) {
    const int tid = opaque_tid(wv), wid = __builtin_amdgcn_readfirstlane(tid >> 6), lane = tid & 63, wr = wid >> 2, wc = wid & 3, fr = lane & 15, fq = lane >> 4;
    constexpr int ESZ = FMT == 2 ? 2 : 1;
    int K_ = g.K, lda_ = g.lda; asm volatile("" : "+s"(K_), "+s"(lda_));
    const int K = K_ * ESZ, nt = K / (BK * 2), lda = lda_ * ESZ;
    unsigned voffA[2], voffB[2];
#pragma unroll
    for (int i = 0; i < 2; ++i) { int R, C; stage_rc(tid * 16 + i * 8192, R, C); const int Rb = Epi::PERM ? ((R & ~31) + perm32(R & 31)) : R;
        voffA[i] = (unsigned)(R * lda + C * 2); voffB[i] = (unsigned)(Rb * K + C * 2); }
    const size_t kstep = (size_t)(BK * 2);
    const size_t hstepA = (size_t)HALF * lda, hstepB = (size_t)HALF * K;
    const size_t tstepA = 2 * hstepA, tstepB = 2 * hstepB;
    const unsigned ldsw = (unsigned)wid * 1024u;
    const int aoff = lds_byte(wr * 64 + fr, fq * 8), boff = lds_byte(wc * 32 + fr, fq * 8);
#define PG8_SA(b, h) (((b) * 2 + (h)) * HTB)
#define PG8_SB(b, h) ((4 + (b) * 2 + (h)) * HTB)
#define PG8_STAGE(bufoff, gbase, voff) do { _Pragma("unroll") for (int _i = 0; _i < 2; ++_i) \
        __builtin_amdgcn_global_load_lds((const unsigned*)((const char*)(gbase) + (voff)[_i]), (LAS unsigned*)(lds + (bufoff) + ldsw + _i * 8192), 16, 0, 0); } while (0)
#define PG8_LD8(addr) __builtin_shufflevector(*(const LAS v4i32*)(addr), *(const LAS v4i32*)((addr) + 1024), 0, 1, 2, 3, 4, 5, 6, 7)
#define PG8_LDA(dst, b, h) do { _Pragma("unroll") for (int m = 0; m < 4; ++m) dst[m] = PG8_LD8(lds + PG8_SA(b, h) + aoff + m * 2048); } while (0)
#define PG8_LDB(dst, b, h) do { _Pragma("unroll") for (int n = 0; n < 2; ++n) dst[n] = PG8_LD8(lds + PG8_SB(b, h) + boff + n * 2048); } while (0)
#define PG8_LO(v) __builtin_bit_cast(bf16x8, __builtin_shufflevector(v, v, 0, 1, 2, 3))
#define PG8_HI(v) __builtin_bit_cast(bf16x8, __builtin_shufflevector(v, v, 4, 5, 6, 7))
#define PG8_MMA(ai, bj, At, Bt) do { __builtin_amdgcn_s_setprio(1); \
        if constexpr (FMT == 3) { _Pragma("unroll") for (int m = 0; m < 4; ++m) _Pragma("unroll") for (int n = 0; n < 2; ++n) { \
            v4i32 c_ = __builtin_bit_cast(v4i32, acc[ai][bj][m][n]); \
            c_ = __builtin_amdgcn_mfma_i32_16x16x64_i8(__builtin_shufflevector(Bt[n], Bt[n], 0, 1, 2, 3), __builtin_shufflevector(At[m], At[m], 0, 1, 2, 3), c_, 0, 0, 0); \
            c_ = __builtin_amdgcn_mfma_i32_16x16x64_i8(__builtin_shufflevector(Bt[n], Bt[n], 4, 5, 6, 7), __builtin_shufflevector(At[m], At[m], 4, 5, 6, 7), c_, 0, 0, 0); \
            acc[ai][bj][m][n] = __builtin_bit_cast(f32x4, c_); } } \
        else if constexpr (FMT == 2) { _Pragma("unroll") for (int m = 0; m < 4; ++m) _Pragma("unroll") for (int n = 0; n < 2; ++n) { \
            acc[ai][bj][m][n] = __builtin_amdgcn_mfma_f32_16x16x32_bf16(PG8_LO(Bt[n]), PG8_LO(At[m]), acc[ai][bj][m][n], 0, 0, 0); \
            acc[ai][bj][m][n] = __builtin_amdgcn_mfma_f32_16x16x32_bf16(PG8_HI(Bt[n]), PG8_HI(At[m]), acc[ai][bj][m][n], 0, 0, 0); } } \
        else { asm volatile("s_nop 1\n\t" \
            "v_mfma_f32_16x16x128_f8f6f4 %0, %8, %10, %0\n\t" "v_mfma_f32_16x16x128_f8f6f4 %1, %9, %10, %1\n\t" \
            "v_mfma_f32_16x16x128_f8f6f4 %2, %8, %11, %2\n\t" "v_mfma_f32_16x16x128_f8f6f4 %3, %9, %11, %3\n\t" \
            "v_mfma_f32_16x16x128_f8f6f4 %4, %8, %12, %4\n\t" "v_mfma_f32_16x16x128_f8f6f4 %5, %9, %12, %5\n\t" \
            "v_mfma_f32_16x16x128_f8f6f4 %6, %8, %13, %6\n\t" "v_mfma_f32_16x16x128_f8f6f4 %7, %9, %13, %7\n\t" \
            "s_nop 11" \
            : "+v"(acc[ai][bj][0][0]), "+v"(acc[ai][bj][0][1]), "+v"(acc[ai][bj][1][0]), "+v"(acc[ai][bj][1][1]), "+v"(acc[ai][bj][2][0]), "+v"(acc[ai][bj][2][1]), "+v"(acc[ai][bj][3][0]), "+v"(acc[ai][bj][3][1]) \
            : "v"(Bt[0]), "v"(Bt[1]), "v"(At[0]), "v"(At[1]), "v"(At[2]), "v"(At[3]), "v"(scl8)); } \
        __builtin_amdgcn_s_setprio(0); } while (0)
#define PG8_WAIT_V(n) asm volatile("s_waitcnt vmcnt(" #n ")" ::: "memory")
#define PG8_WAIT_L(n) asm volatile("s_waitcnt lgkmcnt(" #n ")" ::: "memory")
#define PG8_BAR __builtin_amdgcn_s_barrier()
#define PG8_SCHED __builtin_amdgcn_sched_barrier(0)
    Unit cur, nxt; int ui = 0;
    if (!S.next(0, cur)) return;
    f32x4 acc[2][2][4][2];
#pragma unroll
    for (int a = 0; a < 2; ++a)
#pragma unroll
        for (int b = 0; b < 2; ++b)
#pragma unroll
            for (int m = 0; m < 4; ++m)
#pragma unroll
                for (int n = 0; n < 2; ++n) acc[a][b][m][n] = (f32x4){0.f, 0.f, 0.f, 0.f};
    v8i32 At[4], B0[2], B1[2];
    const int scl8 = 0x7F7F7F7F;
    const char* cA = (const char*)g.A + (size_t)cur.pa * tstepA; const char* cB = (const char*)g.Bt + (size_t)cur.pn * tstepB;
    PG8_STAGE(PG8_SB(0, 0), cB, voffB); PG8_STAGE(PG8_SB(0, 1), cB + hstepB, voffB); PG8_STAGE(PG8_SA(0, 0), cA, voffA); PG8_STAGE(PG8_SA(0, 1), cA + hstepA, voffA);
    if (wr == 1) PG8_BAR;
    PG8_WAIT_V(2); PG8_BAR;
    PG8_STAGE(PG8_SB(1, 0), cB + kstep, voffB); PG8_STAGE(PG8_SA(1, 0), cA + kstep, voffA); PG8_STAGE(PG8_SB(1, 1), cB + hstepB + kstep, voffB);
    PG8_WAIT_V(6); PG8_BAR;
    for (;;) {
        const bool has_next = S.next(ui + 1, nxt);
        const char* nA = has_next ? (const char*)g.A + (size_t)nxt.pa * tstepA : cA; const char* nB = has_next ? (const char*)g.Bt + (size_t)nxt.pn * tstepB : cB;
#pragma unroll 1
        for (int t = 0; t < nt; t += 2) {
            const bool last = (t == nt - 2);
            const char* a1 = cA + (size_t)(t + 1) * kstep;
            const char* a2 = last ? nA : cA + (size_t)(t + 2) * kstep; const char* b2 = last ? nB : cB + (size_t)(t + 2) * kstep;
            const char* a3 = a2 + kstep; const char* b3 = b2 + kstep;
            PG8_LDB(B0, 0, 0); PG8_LDB(B1, 0, 1); PG8_SCHED; PG8_LDA(At, 0, 0); PG8_STAGE(PG8_SA(1, 1), a1 + hstepA, voffA);
            PG8_WAIT_V(8); PG8_WAIT_L(0); PG8_BAR; PG8_MMA(0, 0, At, B0); PG8_MMA(0, 1, At, B1); PG8_BAR; PG8_SCHED;
            PG8_LDA(At, 0, 1); PG8_STAGE(PG8_SB(0, 0), b2, voffB); PG8_STAGE(PG8_SB(0, 1), b2 + hstepB, voffB); PG8_STAGE(PG8_SA(0, 0), a2, voffA);
            PG8_WAIT_V(8); PG8_WAIT_L(0); PG8_BAR; PG8_MMA(1, 0, At, B0); PG8_MMA(1, 1, At, B1); PG8_BAR; PG8_SCHED;
            PG8_LDB(B0, 1, 0); PG8_LDB(B1, 1, 1); PG8_SCHED; PG8_LDA(At, 1, 0); PG8_STAGE(PG8_SA(0, 1), a2 + hstepA, voffA);
            PG8_WAIT_V(8); PG8_WAIT_L(0); PG8_BAR; PG8_MMA(0, 0, At, B0); PG8_MMA(0, 1, At, B1); PG8_BAR; PG8_SCHED;
            PG8_LDA(At, 1, 1); PG8_STAGE(PG8_SB(1, 0), b3, voffB); PG8_STAGE(PG8_SB(1, 1), b3 + hstepB, voffB); PG8_STAGE(PG8_SA(1, 0), a3, voffA);
            PG8_WAIT_V(8); PG8_WAIT_L(0); PG8_BAR; PG8_MMA(1, 0, At, B0); PG8_MMA(1, 1, At, B1); PG8_BAR; PG8_SCHED;
        }
        if (wr == 0) PG8_BAR;
        E(acc, cur, wr, wc, fr, fq);
        if (!has_next) break;
#pragma unroll
        for (int a = 0; a < 2; ++a)
#pragma unroll
            for (int b = 0; b < 2; ++b)
#pragma unroll
                for (int m = 0; m < 4; ++m)
#pragma unroll
                    for (int n = 0; n < 2; ++n) acc[a][b][m][n] = (f32x4){0.f, 0.f, 0.f, 0.f};
        cur = nxt; cA = nA; cB = nB; ++ui;
        if (wr == 1) PG8_BAR;
    }
    PG8_WAIT_V(0);
    PG8_BAR;
#undef PG8_SA
#undef PG8_SB
#undef PG8_STAGE
#undef PG8_LDA
#undef PG8_LD8
#undef PG8_LO
#undef PG8_HI
#undef PG8_LDB
#undef PG8_MMA
#undef PG8_WAIT_V
#undef PG8_WAIT_L
#undef PG8_BAR
#undef PG8_SCHED
}

struct EpiBf16S {
    static constexpr bool PERM = true;
    bf16_t* O; int ldc; int ncol_tiles; const float* rowscale; float scale;
    __device__ __forceinline__ void operator()(const f32x4 (&acc)[2][2][4][2], const Unit& u, int wr, int wc, int fr, int fq) const {
        const int row0 = u.pm * BM + wr * 64 + fr, col0 = (u.pn % ncol_tiles) * BM + wc * 32 + 8 * fq;
        float rsv[2][4];
#pragma unroll
        for (int ai = 0; ai < 2; ++ai)
#pragma unroll
            for (int m = 0; m < 4; ++m) rsv[ai][m] = rowscale ? rowscale[(ptrdiff_t)u.ro + row0 + ai * HALF + m * 16] * scale : scale;
#pragma unroll
        for (int ai = 0; ai < 2; ++ai)
#pragma unroll
            for (int m = 0; m < 4; ++m) { const int row = row0 + ai * HALF + m * 16; bf16_t* rowp = O + (size_t)row * ldc + col0; const float rs = rsv[ai][m];
#pragma unroll
                for (int bj = 0; bj < 2; ++bj) { const f32x4 v0 = acc[ai][bj][m][0] * rs, v1 = acc[ai][bj][m][1] * rs;
                    u32x4 w; w.x = pk_bf16(v0[0], v0[1]); w.y = pk_bf16(v0[2], v0[3]); w.z = pk_bf16(v1[0], v1[1]); w.w = pk_bf16(v1[2], v1[3]);
                    *(u32x4*)(rowp + bj * HALF) = w; } }
    }
};
struct EpiBf16 {
    static constexpr bool PERM = true;
    bf16_t* O; int ldc;
    __device__ __forceinline__ void operator()(const f32x4 (&acc)[2][2][4][2], const Unit& u, int wr, int wc, int fr, int fq) const {
        const int row0 = u.pm * BM + wr * 64 + fr, col0 = u.pn * BM + wc * 32 + 8 * fq;
#pragma unroll
        for (int ai = 0; ai < 2; ++ai)
#pragma unroll
            for (int m = 0; m < 4; ++m) { bf16_t* rowp = O + (size_t)(row0 + ai * HALF + m * 16) * ldc + col0;
#pragma unroll
                for (int bj = 0; bj < 2; ++bj) { const f32x4 v0 = acc[ai][bj][m][0], v1 = acc[ai][bj][m][1];
                    u32x4 w; w.x = pk_bf16(v0[0], v0[1]); w.y = pk_bf16(v0[2], v0[3]); w.z = pk_bf16(v1[0], v1[1]); w.w = pk_bf16(v1[2], v1[3]);
                    *(u32x4*)(rowp + bj * HALF) = w; } }
    }
};
template <int NS> struct EpiBf16N {
    static constexpr bool PERM = true;
    bf16_t* O; int ldc; const float* ssq; float invn;
    __device__ __forceinline__ void operator()(const f32x4 (&acc)[2][2][4][2], const Unit& u, int wr, int wc, int fr, int fq) const {
        const int row0 = u.pm * BM + wr * 64 + fr, col0 = u.pn * BM + wc * 32 + 8 * fq;
        float rsv[2][4];
#pragma unroll
        for (int ai = 0; ai < 2; ++ai)
#pragma unroll
            for (int m = 0; m < 4; ++m) { const float* sp = ssq + (size_t)(row0 + ai * HALF + m * 16) * 16; const f32x4 a = *(const f32x4*)sp; float t = (a[0] + a[1]) + (a[2] + a[3]);
                if (NS == 8) { const f32x4 b = *(const f32x4*)(sp + 4); t += (b[0] + b[1]) + (b[2] + b[3]); }
                rsv[ai][m] = rsqrtf(t * invn + EPSN); }
#pragma unroll
        for (int ai = 0; ai < 2; ++ai)
#pragma unroll
            for (int m = 0; m < 4; ++m) { bf16_t* rowp = O + (size_t)(row0 + ai * HALF + m * 16) * ldc + col0; const float rs = rsv[ai][m];
#pragma unroll
                for (int bj = 0; bj < 2; ++bj) { const f32x4 v0 = acc[ai][bj][m][0] * rs, v1 = acc[ai][bj][m][1] * rs;
                    u32x4 w; w.x = pk_bf16(v0[0], v0[1]); w.y = pk_bf16(v0[2], v0[3]); w.z = pk_bf16(v1[0], v1[1]); w.w = pk_bf16(v1[2], v1[3]);
                    *(u32x4*)(rowp + bj * HALF) = w; } }
    }
};
template <bool OUT8> struct EpiSwiGLU {
    static constexpr bool PERM = true;
    unsigned char* O; int ldc; int ncol_tiles; const float* rowscale; const float* colscale;
    __device__ __forceinline__ void operator()(const f32x4 (&acc)[2][2][4][2], const Unit& u, int wr, int wc, int fr, int fq) const {
        const int row0 = u.pm * BM + wr * 64 + fr, col0 = (u.pn % ncol_tiles) * HALF + wc * 32 + 8 * fq;
        const float cg = colscale[(size_t)u.pn * BM + wc * 32], cu = colscale[(size_t)u.pn * BM + HALF + wc * 32];
        const float cgl = cg * (-LOG2E), cgu = cg * cu;
        float rsv[2][4];
#pragma unroll
        for (int ai = 0; ai < 2; ++ai)
#pragma unroll
            for (int m = 0; m < 4; ++m) rsv[ai][m] = rowscale[(ptrdiff_t)u.ro + row0 + ai * HALF + m * 16];
#pragma unroll
        for (int ai = 0; ai < 2; ++ai)
#pragma unroll
            for (int m = 0; m < 4; ++m) { const int row = row0 + ai * HALF + m * 16; unsigned char* rowp = O + ((size_t)row * ldc + col0) * (OUT8 ? 1 : 2);
                const float rs = rsv[ai][m], kt = rs * cgl, iko = fast_rcp((rs * rs) * cgu);
                const v4i32 ig0 = __builtin_bit_cast(v4i32, acc[ai][0][m][0]), ig1 = __builtin_bit_cast(v4i32, acc[ai][0][m][1]), iu0 = __builtin_bit_cast(v4i32, acc[ai][1][m][0]), iu1 = __builtin_bit_cast(v4i32, acc[ai][1][m][1]);
                f32x2 g[4], uu[4], e[4], a[4];
#pragma unroll
                for (int k = 0; k < 2; ++k) { g[k] = (f32x2){(float)ig0[2 * k], (float)ig0[2 * k + 1]}; g[2 + k] = (f32x2){(float)ig1[2 * k], (float)ig1[2 * k + 1]}; uu[k] = (f32x2){(float)iu0[2 * k], (float)iu0[2 * k + 1]}; uu[2 + k] = (f32x2){(float)iu1[2 * k], (float)iu1[2 * k + 1]}; }
#pragma unroll
                for (int k = 0; k < 4; ++k) e[k] = g[k] * kt;
#pragma unroll
                for (int k = 0; k < 4; ++k) { e[k].x = fast_exp2(e[k].x); e[k].y = fast_exp2(e[k].y); }
#pragma unroll
                for (int k = 0; k < 4; ++k) a[k] = g[k] * uu[k];
#pragma unroll
                for (int k = 0; k < 4; ++k) e[k] = e[k] * iko + iko;
#pragma unroll
                for (int k = 0; k < 4; ++k) { e[k].x = fast_rcp(e[k].x); e[k].y = fast_rcp(e[k].y); }
#pragma unroll
                for (int k = 0; k < 4; ++k) a[k] = a[k] * e[k];
                if (OUT8) { u32x2 w; w.x = pk_fp8x4(a[0].x, a[0].y, a[1].x, a[1].y); w.y = pk_fp8x4(a[2].x, a[2].y, a[3].x, a[3].y); *(u32x2*)rowp = w; }
                else { u32x4 w; w.x = pk_bf16(a[0].x, a[0].y); w.y = pk_bf16(a[1].x, a[1].y); w.z = pk_bf16(a[2].x, a[2].y); w.w = pk_bf16(a[3].x, a[3].y); *(u32x4*)rowp = w; } }
    }
};
template <int MODE> struct EpiRope {
    static constexpr bool PERM = false;
    bf16_t* O; int ldc; const float* tab;
    const float* rowscale; const float* colscale;
    float* ssq;
    __device__ __forceinline__ static int kind(int gi) {
        if (MODE == 0) return (gi >= 48 && gi < 68) ? 1 + (gi & 1) : 0;
        if (MODE == 1) return gi == 12 ? 3 : ((gi >= 16 && gi < 48) ? 1 + (gi & 1) : 0);
        return (gi == 2 || gi == 5 || gi == 8 || gi == 11 || gi == 14 || gi == 17 || gi == 20 || gi == 23) ? 3 : 0;
    }
    __device__ __forceinline__ void operator()(const f32x4 (&acc)[2][2][4][2], const Unit& u, int wr, int wc, int fr, int fq) const {
        const int row0 = u.pm * BM + wr * 64 + fr;
        const bool lat = u.pm < (MLAT / BM);
        float rsv[2][4];
#pragma unroll
        for (int ai = 0; ai < 2; ++ai)
#pragma unroll
            for (int m = 0; m < 4; ++m) rsv[ai][m] = rowscale[(ptrdiff_t)u.ro + row0 + ai * HALF + m * 16];
#pragma unroll
        for (int bj = 0; bj < 2; ++bj) {
            const int gi = u.pn * 8 + bj * 4 + wc; const int kd = lat ? kind(gi) : 0;
            const int col0 = gi * 32 + 4 * fq;
            const f32x4 cs1 = *(const f32x4*)(colscale + col0), cs2 = *(const f32x4*)(colscale + col0 + 16);
#pragma unroll
            for (int ai = 0; ai < 2; ++ai)
#pragma unroll
                for (int m = 0; m < 4; ++m) {
                    const int row = row0 + ai * HALF + m * 16; bf16_t* rowp = O + (size_t)row * ldc + col0;
                    const float rsc = rsv[ai][m]; const v4i32 i1 = __builtin_bit_cast(v4i32, acc[ai][bj][m][0]), i2 = __builtin_bit_cast(v4i32, acc[ai][bj][m][1]);
                    f32x4 x1, x2;
#pragma unroll
                    for (int k = 0; k < 4; ++k) { x1[k] = (float)i1[k] * (rsc * cs1[k]); x2[k] = (float)i2[k] * (rsc * cs2[k]); }
                    if (kd != 0) {
                        const int s = row & (SEQ - 1), gr = s >> 6, gc = s & 63;
                        f32x4 cs, sn;
                        if (kd == 3) { const int pos = fq < 2 ? gr : gc; cs = *(const f32x4*)(tab + 2048 + pos * 8 + 4 * (fq & 1)); sn = *(const f32x4*)(tab + 2048 + 512 + pos * 8 + 4 * (fq & 1)); }
                        else { const int pos = kd == 1 ? gr : gc; cs = *(const f32x4*)(tab + pos * 16 + 4 * fq); sn = *(const f32x4*)(tab + 1024 + pos * 16 + 4 * fq); }
                        const f32x4 o1 = x1 * cs - x2 * sn, o2 = x2 * cs + x1 * sn; x1 = o1; x2 = o2;
                    }
                    u32x2 w0, w1; w0.x = pk_bf16(x1[0], x1[1]); w0.y = pk_bf16(x1[2], x1[3]); w1.x = pk_bf16(x2[0], x2[1]); w1.y = pk_bf16(x2[2], x2[3]);
                    if (MODE == 1 && (u.pn == 0 || (u.pn == 1 && bj == 0))) {
                        float ss = bf_lo(w0.x) * bf_lo(w0.x) + bf_hi(w0.x) * bf_hi(w0.x) + bf_lo(w0.y) * bf_lo(w0.y) + bf_hi(w0.y) * bf_hi(w0.y) + bf_lo(w1.x) * bf_lo(w1.x) + bf_hi(w1.x) * bf_hi(w1.x) + bf_lo(w1.y) * bf_lo(w1.y) + bf_hi(w1.y) * bf_hi(w1.y);
                        { const auto rr = __builtin_amdgcn_permlane16_swap(__float_as_uint(ss), __float_as_uint(ss), false, false); ss = __uint_as_float(rr[0]) + __uint_as_float(rr[1]); }
                        { const auto rr = __builtin_amdgcn_permlane32_swap(__float_as_uint(ss), __float_as_uint(ss), false, false); ss = __uint_as_float(rr[0]) + __uint_as_float(rr[1]); }
                        if (fq == 0) ssq[(size_t)row * 16 + (u.pn == 0 ? bj * 4 + wc : 8 + wc)] = ss;
                    }
                    { const auto r = __builtin_amdgcn_permlane16_swap(w0.x, w1.x, false, false); w0.x = r[0]; w1.x = r[1]; }
                    { const auto r = __builtin_amdgcn_permlane16_swap(w0.y, w1.y, false, false); w0.y = r[0]; w1.y = r[1]; }
                    *(u32x4*)(rowp + ((fq & 1) ? 12 : 0)) = (u32x4){w0.x, w0.y, w1.x, w1.y};
                    asm volatile("" ::: "memory");
                }
        }
    }
};
}

__device__ __forceinline__ unsigned char* fresh_ws() {
    static_assert(offsetof(Params, ws) == 200, "Params layout");
    unsigned long long w; const unsigned long long ka = (unsigned long long)__builtin_amdgcn_kernarg_segment_ptr();
    asm volatile("s_load_dwordx2 %0, %1, 0xc8\n\ts_waitcnt lgkmcnt(0)" : "=s"(w) : "s"(ka) : "memory");
    return (unsigned char*)(__attribute__((address_space(1))) unsigned char*)w;
}
__device__ __forceinline__ int rope_orig(int p) { return p < 8 ? p : (p < 16 ? 16 + (p - 8) : (p < 24 ? 8 + (p - 16) : p)); }

struct ConvJob { const float* src; bf16_t* dst; const float* scale; int Ksrc, Nsrc, Kdst, nb, kb, map, f8; };
constexpr float W8_SCALE = 64.0f;
constexpr int CJ_NMAT[10]  = {0, 2, 0, 2, 2, 2, 0, 2, 0, 16};
constexpr int CJ_NB[10]    = {18, 8, 16, 6, 8, 8, 44, 8, 56, 8};
constexpr int CJ_KB[10]    = {16, 16, 16, 4, 4, 16, 16, FFN_DOWN_FP8 ? 22 : 44, 16, FFN_DOWN_FP8 ? 28 : 56};
__device__ __forceinline__ int conv_tiles(int j) { return CJ_NMAT[j] * CJ_NB[j] * CJ_KB[j]; }
constexpr int conv_tiles_total() { int s = 0; for (int j = 0; j < 10; ++j) s += CJ_NMAT[j] * CJ_NB[j] * CJ_KB[j]; return s; }
__device__ __forceinline__ int conv_map(int map, int n) {
    switch (map) {
    case 0: return n;
    case 1:
        if (n < 256) return n; if (n < 384) return 768 + (n - 256); if (n < 416) return 896 + rope_orig(n - 384); if (n < 512) return -1;
        if (n < 1024) return 256 + (n - 512); if (n < 1536) return 928 + (n - 1024); return 1440 + (n - 1536);
    case 2: { const int h = n / 96, j = n % 96; return j < 64 ? n : h * 96 + 64 + rope_orig(j - 64); }
    case 3: { const int t = n >> 8, r = n & 255; return r < 128 ? t * 128 + r : FFD + t * 128 + (r - 128); }
    default: { const int t = n >> 8, r = n & 255; return r < 128 ? t * 128 + r : FFE + t * 128 + (r - 128); }
    }
}
__device__ __forceinline__ ConvJob conv_job(const Params& p, unsigned char* ws, int j, int mat) {
    ConvJob c; c.scale = nullptr; c.map = 0; c.nb = CJ_NB[j]; c.kb = CJ_KB[j]; c.f8 = FFN_DOWN_FP8 && (j == 7 || j == 9);
    switch (j) {
    case 0: c.src = p.in[7] + (size_t)mat * 1024 * EVEN_IN; c.dst = (bf16_t*)(ws + OFF_WINE + mat * SZ_WINE); c.Ksrc = 1024; c.Nsrc = EVEN_IN; c.Kdst = 1024; break;
    case 1: c.src = p.in[10] + (size_t)mat * 1024 * 1024; c.dst = (bf16_t*)(ws + OFF_WOUTE + mat * SZ_WOUT); c.Ksrc = 1024; c.Nsrc = 1024; c.Kdst = 1024; break;
    case 2: c.src = p.in[11] + (size_t)mat * 1024 * 1952; c.dst = (bf16_t*)(ws + OFF_WINO + mat * SZ_WINO); c.Ksrc = 1024; c.Nsrc = 1952; c.Kdst = 1024; c.map = 1; break;
    case 3: c.src = p.in[14] + (size_t)mat * 256 * 768; c.dst = (bf16_t*)(ws + OFF_WQUP + mat * SZ_WQUP); c.Ksrc = 256; c.Nsrc = 768; c.Kdst = 256; c.map = 2; c.scale = p.in[12] + mat * 256; break;
    case 4: c.src = p.in[15] + (size_t)mat * 128 * 1024; c.dst = (bf16_t*)(ws + OFF_WKVUP + mat * SZ_WKVUP); c.Ksrc = 128; c.Nsrc = 1024; c.Kdst = 256; c.scale = p.in[13] + mat * 128; break;
    case 5: c.src = p.in[18] + (size_t)mat * 1024 * 1024; c.dst = (bf16_t*)(ws + OFF_WOUTO + mat * SZ_WOUT); c.Ksrc = 1024; c.Nsrc = 1024; c.Kdst = 1024; break;
    case 6: c.src = p.in[19] + (size_t)mat * 1024 * 2 * FFD; c.dst = (bf16_t*)(ws + OFF_WGU + mat * SZ_WGU); c.Ksrc = 1024; c.Nsrc = 2 * FFD; c.Kdst = 1024; c.map = 3; break;
    case 7: c.src = p.in[20] + (size_t)mat * FFD * 1024; c.dst = (bf16_t*)(ws + OFF_WDN + mat * SZ_WDN); c.Ksrc = FFD; c.Nsrc = 1024; c.Kdst = FFD; break;
    case 8: c.src = p.in[22] + (size_t)mat * 1024 * 2 * FFE; c.dst = (bf16_t*)(ws + OFF_WEGU + mat * (SZ_WEGU / 2)); c.Ksrc = 1024; c.Nsrc = 2 * FFE; c.Kdst = 1024; c.map = 4; break;
    default: c.src = p.in[23] + (size_t)mat * FFE * 1024; c.dst = (bf16_t*)(ws + OFF_WEDN + mat * (SZ_WEDN / (FFN_DOWN_FP8 ? 2 : 1))); c.Ksrc = FFE; c.Nsrc = 1024; c.Kdst = FFE; break;
    }
    return c;
}

constexpr int CV_NU_D = 2 * (2 * FFD / 64), CV_NU_IE = 2 * (EVEN_IN / 64), CV_NU_IO = 2 * (ODD_INP / 64), CV_NU_E = 16 * (2 * FFE / 64), CV_NU_PRO = CV_NU_D + CV_NU_IE + CV_NU_IO, CV_NU = CV_NU_PRO + CV_NU_E;
constexpr int TAIL_U_SPLIT = 560, TAIL_T_SPLIT = 1100;
constexpr int CV_NT = conv_tiles_total(), CV_NT_E = CJ_NMAT[9] * CJ_NB[9] * CJ_KB[9], CV_NT_PRO = CV_NT - CV_NT_E;
__device__ __forceinline__ void conv_units(const Params& p, LAS unsigned char* lds, const int tid, int lo, int hi, int first, int stride) {
    unsigned char* ws = fresh_ws();
    __syncthreads();
    {
        constexpr int WP = 2052;
        LAS unsigned char* wl = lds;
        LAS float* cmx = (LAS float*)(lds + 64 * WP);
        constexpr int NU_D = CV_NU_D, NU_E = CV_NU_E, NU_IE = CV_NU_IE, NU_IO = CV_NU_IO;
        const int cq = tid & 15, rg = tid >> 4, wvn = tid >> 6, col = tid >> 3, piece = tid & 7;
        struct U8 { const float* sp; unsigned char* dst; float* wsc; int Nsrc, ok, blk; };
        auto decode = [&](int u) -> U8 {
            const int cat = u < NU_D ? 0 : (u < NU_D + NU_IE ? 2 : (u < NU_D + NU_IE + NU_IO ? 3 : 1));
            const int uu = u - (cat == 0 ? 0 : (cat == 2 ? NU_D : (cat == 3 ? NU_D + NU_IE : NU_D + NU_IE + NU_IO)));
            const int Ndst = cat == 0 ? 2 * FFD : (cat == 1 ? 2 * FFE : (cat == 2 ? EVEN_IN : ODD_INP)), nbp = Ndst / 64, mat = uu / nbp, nbi = uu % nbp;
            U8 U; U.Nsrc = cat == 3 ? 1952 : Ndst;
            const float* src = (cat == 0 ? p.in[19] : (cat == 1 ? p.in[22] : (cat == 2 ? p.in[7] : p.in[11]))) + (size_t)mat * 1024 * U.Nsrc;
            unsigned char* dstb = cat == 0 ? ws + OFF_WGU + (size_t)mat * SZ_WGU : (cat == 1 ? ws + OFF_WEGU + (size_t)mat * (SZ_WEGU / 2) : (cat == 2 ? ws + OFF_WINE + (size_t)mat * SZ_WINE : ws + OFF_WINO + (size_t)mat * SZ_WINO));
            float* wscb = (cat == 0 ? (float*)(ws + OFF_WSCD) : (cat == 1 ? (float*)(ws + OFF_WSCE) : (cat == 2 ? (float*)(ws + OFF_WSCI) : (float*)(ws + OFF_WSCI) + 2 * EVEN_IN))) + (size_t)mat * Ndst;
            const int cmap = cat == 0 ? 3 : (cat == 1 ? 4 : (cat == 2 ? 0 : 1));
            const int sc = conv_map(cmap, nbi * 64 + cq * 4);
            U.blk = cat < 2; U.ok = sc >= 0; U.sp = src + (size_t)rg * U.Nsrc + (sc >= 0 ? sc : 0); U.dst = dstb + (size_t)(nbi * 64) * 1024; U.wsc = wscb + nbi * 64; return U; };
        auto ldg = [&](const float*& ptr, size_t step, int ok, f32x4 (&v)[8]) {
#pragma unroll
            for (int i = 0; i < 8; ++i) { v[i] = ok ? __builtin_nontemporal_load((const f32x4*)ptr) : (f32x4){0.f, 0.f, 0.f, 0.f}; ptr += step; } };
        auto consume = [&](int q, const f32x4 (&v)[8], f32x4& cm) {
#pragma unroll
            for (int i = 0; i < 8; ++i) { cm = __builtin_elementwise_max(cm, __builtin_elementwise_abs(v[i]));
                const unsigned w0 = pk_bf16(v[i][0], v[i][1]), w1 = pk_bf16(v[i][2], v[i][3]);
                LAS unsigned short* bp = (LAS unsigned short*)(wl + (cq * 4) * WP + ((q * 8 + i) * 32 + rg) * 2);
                bp[0] = (unsigned short)w0; bp[WP / 2] = (unsigned short)(w0 >> 16); bp[WP] = (unsigned short)w1; bp[3 * (WP / 2)] = (unsigned short)(w1 >> 16); } };
        int u = lo + first;
        if (u < hi) {
            U8 U = decode(u);
            f32x4 q0[8], q1[8], q2[8], q3[8];
            const float* lp = U.sp; size_t lstep = (size_t)32 * U.Nsrc; int lok = U.ok;
            ldg(lp, lstep, lok, q0); ldg(lp, lstep, lok, q1);
#pragma unroll 1
            for (;;) {
                const int un = u + stride; const bool hn = un < hi;
                U8 Un = U; if (hn) Un = decode(un);
                f32x4 cm = (f32x4){0.f, 0.f, 0.f, 0.f};
                ldg(lp, lstep, lok, q2); consume(0, q0, cm);
                ldg(lp, lstep, lok, q3); consume(1, q1, cm);
                lp = Un.sp; lstep = (size_t)32 * Un.Nsrc; lok = Un.ok;
                if (hn) ldg(lp, lstep, lok, q0);
                consume(2, q2, cm);
                if (hn) ldg(lp, lstep, lok, q1);
                consume(3, q3, cm);
#pragma unroll
                for (int c = 0; c < 4; ++c) { float v = cm[c];
                    { const auto rr = __builtin_amdgcn_permlane16_swap(__float_as_uint(v), __float_as_uint(v), false, false); v = fmaxf(__uint_as_float(rr[0]), __uint_as_float(rr[1])); }
                    { const auto rr = __builtin_amdgcn_permlane32_swap(__float_as_uint(v), __float_as_uint(v), false, false); v = fmaxf(__uint_as_float(rr[0]), __uint_as_float(rr[1])); }
                    cm[c] = v; }
                if ((tid & 63) < 16) *(LAS f32x4*)(cmx + wvn * 64 + cq * 4) = cm;
                __syncthreads();
                float mx = 0.f;
#pragma unroll
                for (int w = 0; w < 8; ++w) mx = fmaxf(mx, cmx[w * 64 + col]);
                if (U.blk) {
                    mx = wave_max(mx); if ((tid & 63) == 0) cmx[512 + wvn] = mx; __syncthreads();
#pragma unroll
                    for (int w = 0; w < 8; ++w) mx = fmaxf(mx, cmx[512 + w]);
                }
                mx = mx > 0.f ? mx : 1.0f;
                const float inv = 127.0f / mx;
                if (piece == 0) U.wsc[col] = mx * (1.0f / 127.0f);
#pragma unroll 2
                for (int it = 0; it < 8; ++it) {
                    const int k0 = it * 128 + piece * 16;
                    const LAS unsigned* rp = (const LAS unsigned*)(wl + col * WP + k0 * 2);
                    unsigned w[8];
#pragma unroll
                    for (int j = 0; j < 8; ++j) w[j] = rp[j];
                    u32x4 o;
#pragma unroll
                    for (int j = 0; j < 4; ++j) o[j] = pk_i8x4(bf_lo(w[2 * j]) * inv, bf_hi(w[2 * j]) * inv, bf_lo(w[2 * j + 1]) * inv, bf_hi(w[2 * j + 1]) * inv);
                    *(u32x4*)(U.dst + (size_t)col * 1024 + k0) = o;
                }
                __syncthreads();
                if (!hn) break;
                U = Un; u = un;
            }
        }
    }
    __syncthreads();
}

__device__ __forceinline__ void conv_tiles_run(const Params& p, LAS unsigned char* lds, const int tid, int lo, int hi, int first, int stride) {
    unsigned char* ws = fresh_ws();
    const int ng = tid & 31, kgq = tid >> 5;
    const int orow = tid >> 2, oq = tid & 3;
    {
        __syncthreads();
        struct TileRef { ConvJob c; int nbi, kbi; };
        auto decode = [&](int t) -> TileRef {
            int j = 0, rem = t;
#pragma unroll 1
            for (; j < 9; ++j) { const int n = conv_tiles(j); if (rem < n) break; rem -= n; }
            const int per = CJ_NB[j] * CJ_KB[j], mat = rem / per, r2 = rem % per;
            TileRef T; T.c = conv_job(p, ws, j, mat); T.kbi = r2 / T.c.nb; T.nbi = r2 % T.c.nb; return T; };
        auto issue = [&](const TileRef& T, f32x4 (&v)[8], float (&ks)[8]) {
            const int n0 = T.nbi * 128 + ng * 4, k0 = T.kbi * (T.c.f8 ? 128 : 64) + kgq * 4, sc = conv_map(T.c.map, n0);
#pragma unroll
            for (int r = 0; r < 8; ++r) { const int k = k0 + (r >> 2) * 64 + (r & 3);
                if ((r < 4 || T.c.f8) && sc >= 0 && k < T.c.Ksrc) { v[r] = __builtin_nontemporal_load((const f32x4*)(T.c.src + (size_t)k * T.c.Nsrc + sc)); ks[r] = T.c.scale ? T.c.scale[k] : 1.0f; } else { v[r] = (f32x4){0.f, 0.f, 0.f, 0.f}; ks[r] = 0.f; } } };
        auto finish = [&](const TileRef& T, const f32x4 (&v)[8], const float (&ks)[8], int buf) {
            LAS unsigned char* tl = lds + buf * 32768;
            if (T.c.f8) {
#pragma unroll
                for (int h = 0; h < 2; ++h)
#pragma unroll
                    for (int cc = 0; cc < 4; ++cc) *(LAS unsigned*)(tl + (ng * 4 + cc) * 144 + h * 64 + kgq * 4) = pk_fp8x4(v[4 * h][cc] * (ks[4 * h] * W8_SCALE), v[4 * h + 1][cc] * (ks[4 * h + 1] * W8_SCALE), v[4 * h + 2][cc] * (ks[4 * h + 2] * W8_SCALE), v[4 * h + 3][cc] * (ks[4 * h + 3] * W8_SCALE));
                __syncthreads();
                unsigned char* dp = (unsigned char*)T.c.dst + (size_t)(T.nbi * 128 + orow) * T.c.Kdst + T.kbi * 128 + oq * 32;
                *(u32x4*)dp = *(const LAS u32x4*)(tl + orow * 144 + oq * 32); *(u32x4*)(dp + 16) = *(const LAS u32x4*)(tl + orow * 144 + oq * 32 + 16);
            } else {
#pragma unroll
                for (int cc = 0; cc < 4; ++cc) { u32x2 w; w.x = pk_bf16(v[0][cc] * ks[0], v[1][cc] * ks[1]); w.y = pk_bf16(v[2][cc] * ks[2], v[3][cc] * ks[3]); *(LAS u32x2*)(tl + (ng * 4 + cc) * 144 + kgq * 8) = w; }
                __syncthreads();
                bf16_t* dp = T.c.dst + (size_t)(T.nbi * 128 + orow) * T.c.Kdst + T.kbi * 64 + oq * 16;
                *(u32x4*)dp = *(const LAS u32x4*)(tl + orow * 144 + oq * 32); *(u32x4*)(dp + 8) = *(const LAS u32x4*)(tl + orow * 144 + oq * 32 + 16);
            } };
        int t = lo + first;
        if (t < hi) {
            TileRef TA = decode(t), TB = TA; f32x4 va[8], vb[8]; float sa[8], sb[8];
            issue(TA, va, sa);
#pragma unroll 1
            for (;;) {
                int tn = t + stride; bool hn = tn < hi;
                if (hn) { TB = decode(tn); issue(TB, vb, sb); }
                finish(TA, va, sa, 0);
                if (!hn) break;
                t = tn; tn = t + stride; hn = tn < hi;
                if (hn) { TA = decode(tn); issue(TA, va, sa); }
                finish(TB, vb, sb, 1);
                if (!hn) break;
                t = tn;
            }
        }
    }
    __syncthreads();
}

__device__ __forceinline__ void phase_prologue(const Params& p, const int wv, LAS unsigned char* lds) {
    const int tid = opaque_tid(wv);
    unsigned char* ws = p.ws;
    if (blockIdx.x == 0) {
        float* tab = (float*)(ws + OFF_TAB);
        for (int i = tid; i < 1024; i += NTHREADS) { const int pos = i >> 4, f = i & 15; const float inv = 1.0f / powf(10000.0f, (float)(2 * f) / 32.0f); const float ang = (float)pos * inv; tab[i] = cosf(ang); tab[1024 + i] = sinf(ang); }
        for (int i = tid; i < 512; i += NTHREADS) { const int pos = i >> 3, f = i & 7; const float inv = 1.0f / powf(10000.0f, (float)(2 * f) / 16.0f); const float ang = (float)pos * inv; tab[2048 + i] = cosf(ang); tab[2048 + 512 + i] = sinf(ang); }
    }
    {
        LAS float* sv = (LAS float*)lds;
        LAS float* red = (LAS float*)(lds + 36864);
        for (int i = tid; i < 9 * 1024; i += NTHREADS) { const int r = i >> 10, k = i & 1023; const float c = r < 8 ? p.in[1][r * 1024 + k] : p.in[3][k]; sv[i] = c / (1.0f + expf(-c)); }
        __syncthreads();
        for (int u = blockIdx.x; u < 384; u += gridDim.x) {
            const int layer = u / 96, cg = u % 96, cq = tid & 15, kg = tid >> 4;
            f32x4 acc[9];
#pragma unroll
            for (int r = 0; r < 9; ++r) acc[r] = (f32x4){0.f, 0.f, 0.f, 0.f};
            const float* wp = p.in[4] + ((size_t)layer * 1024 + kg * 32) * 6144 + cg * 64 + cq * 4;
#pragma unroll 8
            for (int kk = 0; kk < 32; ++kk) {
                const f32x4 w = __builtin_nontemporal_load((const f32x4*)(wp + (size_t)kk * 6144));
#pragma unroll
                for (int r = 0; r < 9; ++r) acc[r] += w * sv[r * 1024 + kg * 32 + kk];
            }
#pragma unroll
            for (int r = 0; r < 9; ++r) *(LAS f32x4*)(red + (kg * 9 + r) * 64 + cq * 4) = acc[r];
            __syncthreads();
            float* mod = (float*)(ws + OFF_MOD);
            for (int i = tid; i < 9 * 64; i += NTHREADS) { const int r = i >> 6, cc = i & 63; float sacc = 0.f;
#pragma unroll
                for (int g = 0; g < 32; ++g) sacc += red[(g * 9 + r) * 64 + cc];
                mod[((size_t)layer * 9 + r) * 6144 + cg * 64 + cc] = sacc + p.in[5][layer * 6144 + cg * 64 + cc]; }
            __syncthreads();
        }
    }
    conv_units(p, lds, tid, 0, CV_NU_PRO, (int)((blockIdx.x + (gridDim.x >> 1)) % gridDim.x), (int)gridDim.x);
    conv_tiles_run(p, lds, tid, 0, CV_NT_PRO, (int)(gridDim.x - 1 - blockIdx.x), (int)gridDim.x);
}

__device__ __forceinline__ void ld16(const float* p, int lane, float (&v)[16]) {
#pragma unroll
    for (int j = 0; j < 2; ++j) { const f32x4 a = *(const f32x4*)(p + 8 * lane + 512 * j), b = *(const f32x4*)(p + 8 * lane + 512 * j + 4);
        v[8 * j] = a[0]; v[8 * j + 1] = a[1]; v[8 * j + 2] = a[2]; v[8 * j + 3] = a[3]; v[8 * j + 4] = b[0]; v[8 * j + 5] = b[1]; v[8 * j + 6] = b[2]; v[8 * j + 7] = b[3]; }
}
__device__ __forceinline__ void ld16_nt(const float* p, int lane, float (&v)[16]) {
#pragma unroll
    for (int j = 0; j < 2; ++j) { const f32x4 a = __builtin_nontemporal_load((const f32x4*)(p + 8 * lane + 512 * j)), b = __builtin_nontemporal_load((const f32x4*)(p + 8 * lane + 512 * j + 4));
        v[8 * j] = a[0]; v[8 * j + 1] = a[1]; v[8 * j + 2] = a[2]; v[8 * j + 3] = a[3]; v[8 * j + 4] = b[0]; v[8 * j + 5] = b[1]; v[8 * j + 6] = b[2]; v[8 * j + 7] = b[3]; }
}
__device__ __forceinline__ void st16_f32_nt(float* p, int lane, const float (&v)[16]) {
#pragma unroll
    for (int j = 0; j < 2; ++j) { __builtin_nontemporal_store((f32x4){v[8 * j], v[8 * j + 1], v[8 * j + 2], v[8 * j + 3]}, (f32x4*)(p + 8 * lane + 512 * j)); __builtin_nontemporal_store((f32x4){v[8 * j + 4], v[8 * j + 5], v[8 * j + 6], v[8 * j + 7]}, (f32x4*)(p + 8 * lane + 512 * j + 4)); }
}
__device__ __forceinline__ void ld16_bf16(const bf16_t* p, int lane, float (&v)[16]) {
#pragma unroll
    for (int j = 0; j < 2; ++j) { const u32x4 w = *(const u32x4*)(p + 8 * lane + 512 * j);
#pragma unroll
        for (int k = 0; k < 4; ++k) { v[8 * j + 2 * k] = bf_lo(w[k]); v[8 * j + 2 * k + 1] = bf_hi(w[k]); } }
}
__device__ __forceinline__ void st16_f32(float* p, int lane, const float (&v)[16]) {
#pragma unroll
    for (int j = 0; j < 2; ++j) { *(f32x4*)(p + 8 * lane + 512 * j) = (f32x4){v[8 * j], v[8 * j + 1], v[8 * j + 2], v[8 * j + 3]}; *(f32x4*)(p + 8 * lane + 512 * j + 4) = (f32x4){v[8 * j + 4], v[8 * j + 5], v[8 * j + 6], v[8 * j + 7]}; }
}
__device__ __forceinline__ void st16_bf16(bf16_t* p, int lane, const float (&v)[16]) {
#pragma unroll
    for (int j = 0; j < 2; ++j) { u32x4 w; w.x = pk_bf16(v[8 * j], v[8 * j + 1]); w.y = pk_bf16(v[8 * j + 2], v[8 * j + 3]); w.z = pk_bf16(v[8 * j + 4], v[8 * j + 5]); w.w = pk_bf16(v[8 * j + 6], v[8 * j + 7]); *(u32x4*)(p + 8 * lane + 512 * j) = w; }
}
__device__ __forceinline__ float st16_i8_lds(LAS unsigned char* p, int lane, const float (&v)[16]) {
    float mx = 0.f;
#pragma unroll
    for (int k = 0; k < 16; ++k) mx = fmaxf(mx, fabsf(v[k]));
    mx = wave_max(mx); mx = mx > 0.f ? mx : 1.0f;
    const float inv = 127.0f / mx;
#pragma unroll
    for (int j = 0; j < 2; ++j) { u32x2 w; w.x = pk_i8x4(v[8 * j] * inv, v[8 * j + 1] * inv, v[8 * j + 2] * inv, v[8 * j + 3] * inv); w.y = pk_i8x4(v[8 * j + 4] * inv, v[8 * j + 5] * inv, v[8 * j + 6] * inv, v[8 * j + 7] * inv);
        *(LAS u32x2*)(p + 8 * lane + 512 * j) = w; }
    return mx * (1.0f / 127.0f);
}
__device__ __forceinline__ float st16_i8(unsigned char* p, int lane, const float (&v)[16]) {
    float mx = 0.f;
#pragma unroll
    for (int k = 0; k < 16; ++k) mx = fmaxf(mx, fabsf(v[k]));
    mx = wave_max(mx); mx = mx > 0.f ? mx : 1.0f;
    const float inv = 127.0f / mx;
#pragma unroll
    for (int j = 0; j < 2; ++j) { u32x2 w; w.x = pk_i8x4(v[8 * j] * inv, v[8 * j + 1] * inv, v[8 * j + 2] * inv, v[8 * j + 3] * inv); w.y = pk_i8x4(v[8 * j + 4] * inv, v[8 * j + 5] * inv, v[8 * j + 6] * inv, v[8 * j + 7] * inv);
        *(u32x2*)(p + 8 * lane + 512 * j) = w; }
    return mx * (1.0f / 127.0f);
}
__device__ __forceinline__ float sumsq16(const float (&v)[16]) { float s = 0.f;
#pragma unroll
    for (int i = 0; i < 16; ++i) s += v[i] * v[i];
    return wave_sum(s); }
__device__ __forceinline__ const float* modp(const Params& p, int layer, int bidx, int which) { return (const float*)(p.ws + OFF_MOD) + (((size_t)layer * 9 + bidx) * 6 + which) * 1024; }
__device__ __forceinline__ const float* xin_row(const Params& p, int row) { return row < MLAT ? p.in[0] + (size_t)row * DM : p.in[2] + (size_t)(row - MLAT) * DM; }
__device__ __forceinline__ int row_bidx(int row) { return row < MLAT ? (row >> 12) : 8; }

__device__ __forceinline__ void phase_h0(const Params& p, const int wv) {
    const int tid = opaque_tid(wv), lane = tid & 63, wave = tid >> 6;
    bf16_t* abuf = (bf16_t*)(p.ws + OFF_ABUF);
    float gs[16], sh[16];
    int cur = -1;
    const int row0 = blockIdx.x * ROWS_PER_BLOCK + wave;
    constexpr int NI = ROWS_PER_BLOCK / NWAVES;
    float Xb[3][16];
    auto step = [&](int i, float (&x)[16], float (&xn2)[16]) -> bool {
        if (i >= NI) return false;
        const int row = row0 + NWAVES * i, bidx = row_bidx(row);
        if (i + 2 < NI) ld16_nt(xin_row(p, row + 2 * NWAVES), lane, xn2);
        if (bidx != cur) { cur = bidx; float t[16]; ld16(modp(p, 0, bidx, 1), lane, gs); ld16(p.in[6], lane, t);
#pragma unroll
            for (int k = 0; k < 16; ++k) gs[k] = t[k] * (1.0f + gs[k]);
            ld16(modp(p, 0, bidx, 0), lane, sh); }
        const float rstd = rsqrtf(sumsq16(x) * (1.0f / DM) + EPSN);
#pragma unroll
        for (int k = 0; k < 16; ++k) x[k] = x[k] * rstd * gs[k] + sh[k];
        { const float fs = st16_i8((unsigned char*)abuf + (size_t)row * DM, lane, x); if (lane == 0) ((float*)(p.ws + OFF_FSC))[row] = fs; }
        return true;
    };
    ld16_nt(xin_row(p, row0), lane, Xb[0]); ld16_nt(xin_row(p, row0 + NWAVES), lane, Xb[1]);
#pragma unroll 1
    for (int i = 0; i < NI; i += 3) {
        if (!step(i, Xb[0], Xb[2])) break;
        if (!step(i + 1, Xb[1], Xb[0])) break;
        if (!step(i + 2, Xb[2], Xb[1])) break;
    }
}

template <bool ODD>
__device__ __forceinline__ void phase_rowB(const Params& p, const int wv, LAS unsigned char* lds, int layer, const bf16_t* Y, int nrows, bool dummy = false) {
    const int tid = opaque_tid(wv), lane = tid & 63, wave = tid >> 6;
    const bf16_t* xs_in = (const bf16_t*)(p.ws + OFF_XS); bf16_t* xs = (bf16_t*)(p.ws + (dummy ? WS_END : OFF_XS)); bf16_t* abuf = (bf16_t*)(p.ws + (dummy ? WS_END + (size_t)MTOT * DM * 4 : OFF_ABUF));
    const float* ng = p.in[6] + (size_t)layer * 4 * DM;
    float mg1[16], gs2[16], m3[16];
    LAS float* wrt = (LAS float*)lds;
    LAS int* lcnt = (LAS int*)(lds + 32768);
    LAS int* lbase = (LAS int*)(lds + 32768 + 64);
    LAS int* rinfo = (LAS int*)(lds + 32768 + 128);
    LAS float* rwt = (LAS float*)(lds + 32768 + 128 + ROWS_PER_BLOCK * 16);
    LAS unsigned char* stash = lds + 40960;
    if (ODD) {
        const float* wr = p.in[21] + (size_t)(layer >> 1) * DM * NEXP;
        for (int i = tid; i < DM * NEXP; i += NTHREADS) wrt[i] = wr[i];
        if (tid < 8) lcnt[tid] = 0;
        __syncthreads();
    }
    int cur = -1;
    const int row0 = blockIdx.x * ROWS_PER_BLOCK + wave;
    constexpr int NI = ROWS_PER_BLOCK / NWAVES;
    float Yb[3][16], Xb[3][16];
    auto issue = [&](int row, float (&yy)[16], float (&xx)[16]) { ld16_bf16(Y + (size_t)row * DM, lane, yy); if (layer == 0) ld16_nt(xin_row(p, row), lane, xx); else ld16_bf16(xs_in + (size_t)row * DM, lane, xx); };
    auto step = [&](int i, float (&y)[16], float (&x)[16], float (&yn2)[16], float (&xn2)[16]) -> bool {
        const int lrow = wave + NWAVES * i, row = row0 + NWAVES * i, bidx = row_bidx(row);
        if (i >= NI || row >= nrows) return false;
        if (i + 2 < NI && row + 2 * NWAVES < nrows) issue(row + 2 * NWAVES, yn2, xn2);
        if (bidx != cur) { cur = bidx; float t[16]; ld16(modp(p, layer, bidx, 2), lane, mg1); ld16(ng + DM, lane, t);
#pragma unroll
            for (int k = 0; k < 16; ++k) mg1[k] *= t[k];
            ld16(modp(p, layer, bidx, 4), lane, gs2); ld16(ng + 2 * DM, lane, t);
#pragma unroll
            for (int k = 0; k < 16; ++k) gs2[k] = t[k] * (1.0f + gs2[k]);
            ld16(modp(p, layer, bidx, 3), lane, m3); }
        const float rsy = rsqrtf(sumsq16(y) * (1.0f / DM) + EPSN);
#pragma unroll
        for (int k = 0; k < 16; ++k) x[k] = x[k] + mg1[k] * (y[k] * rsy);
        st16_bf16(xs + (size_t)row * DM, lane, x);
        const float rs1 = rsqrtf(sumsq16(x) * (1.0f / DM) + EPSN);
#pragma unroll
        for (int k = 0; k < 16; ++k) y[k] = x[k] * rs1 * gs2[k] + m3[k];
        float fs;
        if (ODD) fs = st16_i8_lds(stash + (size_t)(i < 9 ? wave * 9 + i : wave * 8 + (i - 9)) * 1024, lane, y);
        else { fs = st16_i8((unsigned char*)abuf + (size_t)row * DM, lane, y); if (lane == 0 && !dummy) ((float*)(p.ws + OFF_FSC))[row] = fs; }
        if (ODD) {
            float lg[8];
#pragma unroll
            for (int e = 0; e < 8; ++e) lg[e] = 0.f;
#pragma unroll
            for (int j = 0; j < 4; ++j)
#pragma unroll
                for (int q = 0; q < 4; ++q) { const int col = 8 * lane + 512 * (j >> 1) + 4 * (j & 1) + q; const f32x4 wa = *(const LAS f32x4*)(wrt + col * 8), wb = *(const LAS f32x4*)(wrt + col * 8 + 4); const float f = y[4 * j + q];
                    lg[0] += f * wa[0]; lg[1] += f * wa[1]; lg[2] += f * wa[2]; lg[3] += f * wa[3]; lg[4] += f * wb[0]; lg[5] += f * wb[1]; lg[6] += f * wb[2]; lg[7] += f * wb[3]; }
#pragma unroll
            for (int e = 0; e < 8; ++e) lg[e] = wave_sum(lg[e]);
            int e0 = 0; float l0 = lg[0];
#pragma unroll
            for (int e = 1; e < 8; ++e) if (lg[e] > l0) { l0 = lg[e]; e0 = e; }
            int e1 = e0 == 0 ? 1 : 0; float l1 = -INFINITY;
#pragma unroll
            for (int e = 0; e < 8; ++e) if (e != e0 && lg[e] > l1) { l1 = lg[e]; e1 = e; }
            if (lane == 0) {
                const float w1 = 1.0f / (1.0f + expf(l0 - l1)), w0 = 1.0f - w1;
                const int i0 = __hip_atomic_fetch_add(lcnt + e0, 1, __ATOMIC_RELAXED, __HIP_MEMORY_SCOPE_WORKGROUP);
                const int i1 = __hip_atomic_fetch_add(lcnt + e1, 1, __ATOMIC_RELAXED, __HIP_MEMORY_SCOPE_WORKGROUP);
                rinfo[lrow * 4 + 0] = e0; rinfo[lrow * 4 + 1] = e1; rinfo[lrow * 4 + 2] = i0; rinfo[lrow * 4 + 3] = i1; rwt[lrow * 3] = w0; rwt[lrow * 3 + 1] = w1; rwt[lrow * 3 + 2] = fs;
            }
        }
        return true;
    };
    auto flush = [&](int i_lo, int i_hi) {
        __syncthreads();
        unsigned* cnt = (unsigned*)(p.ws + OFF_CTL) + CW_MOECNT + (layer >> 1) * 64;
        if (tid < 8) lbase[tid] = (int)__hip_atomic_fetch_add(cnt + tid, (unsigned)lcnt[tid], __ATOMIC_RELAXED, __HIP_MEMORY_SCOPE_AGENT);
        __syncthreads();
        int* slot = (int*)(p.ws + OFF_SLOT); float* twt = (float*)(p.ws + OFF_TWT); float* tsc = (float*)(p.ws + OFF_GWT); unsigned char* gbuf = p.ws + OFF_GBUF;
        for (int i = i_lo; i < i_hi; ++i) {
            const int lrow = wave + NWAVES * i, row = row0 + NWAVES * i;
            if (row >= nrows) break;
            const int e0 = rinfo[lrow * 4], e1 = rinfo[lrow * 4 + 1], s0 = lbase[e0] + rinfo[lrow * 4 + 2], s1 = lbase[e1] + rinfo[lrow * 4 + 3];
            const u32x4 v = *(const LAS u32x4*)(stash + (size_t)(i < 9 ? wave * 9 + i : wave * 8 + (i - 9)) * 1024 + lane * 16);
            *(u32x4*)(gbuf + ((size_t)e0 * CAPR + s0) * 1024 + lane * 16) = v;
            *(u32x4*)(gbuf + ((size_t)e1 * CAPR + s1) * 1024 + lane * 16) = v;
            if (lane == 0) { *(int4*)(slot + (size_t)row * 4) = make_int4(e0, s0, e1, s1);
                twt[(size_t)e0 * MTOT + s0] = rwt[lrow * 3]; twt[(size_t)e1 * MTOT + s1] = rwt[lrow * 3 + 1]; tsc[(size_t)e0 * MTOT + s0] = rwt[lrow * 3 + 2]; tsc[(size_t)e1 * MTOT + s1] = rwt[lrow * 3 + 2]; }
        }
        __syncthreads();
        if (tid < 8) lcnt[tid] = 0;
        __syncthreads();
    };
    if (row0 < nrows) issue(row0, Yb[0], Xb[0]);
    if (row0 + NWAVES < nrows) issue(row0 + NWAVES, Yb[1], Xb[1]);
    bool live = true;
#pragma unroll 1
    for (int i = 0; i < 9 && live; i += 3) {
        if (!step(i, Yb[0], Xb[0], Yb[2], Xb[2])) { live = false; break; }
        if (!step(i + 1, Yb[1], Xb[1], Yb[0], Xb[0])) { live = false; break; }
        if (!step(i + 2, Yb[2], Xb[2], Yb[1], Xb[1])) { live = false; break; }
    }
    if (ODD && !dummy) flush(0, 9);
#pragma unroll 1
    for (int i = 9; i < NI && live; i += 3) {
        if (!step(i, Yb[0], Xb[0], Yb[2], Xb[2])) break;
        if (!step(i + 1, Yb[1], Xb[1], Yb[0], Xb[0])) break;
        if (!step(i + 2, Yb[2], Xb[2], Yb[1], Xb[1])) break;
    }
    if (ODD && !dummy) flush(9, NI);
}

struct MoeLayout { int cnt[8], ustart[9], tstart[9]; };
__device__ __forceinline__ MoeLayout moe_layout(const Params& p, int layer) {
    unsigned* cnt = (unsigned*)(p.ws + OFF_CTL) + CW_MOECNT + (layer >> 1) * 64;
    MoeLayout L; int u = 0, t = 0;
#pragma unroll
    for (int e = 0; e < 8; ++e) { const int c = __builtin_amdgcn_readfirstlane((int)__hip_atomic_load(cnt + e, __ATOMIC_RELAXED, __HIP_MEMORY_SCOPE_AGENT)); L.cnt[e] = c; L.ustart[e] = u; L.tstart[e] = t; u += c; t += (c + 255) >> 8; }
    L.ustart[8] = u; L.tstart[8] = t; return L;
}

template <bool MOE>
__device__ __forceinline__ void phase_rowC(const Params& p, const int wv, int layer, const bf16_t* F, bool last, bool dummy = false) {
    const int tid = opaque_tid(wv), lane = tid & 63, wave = tid >> 6;
    const bf16_t* xs_in = (const bf16_t*)(p.ws + OFF_XS); bf16_t* xs = (bf16_t*)(p.ws + (dummy ? WS_END : OFF_XS)); bf16_t* abuf = (bf16_t*)(p.ws + (dummy ? WS_END + (size_t)MTOT * DM * 4 : OFF_ABUF));
    float* outp = dummy ? (float*)xs : p.out;
    const float* ng = p.in[6] + (size_t)layer * 4 * DM;
    float mg3[16], gsn[16], sh[16];
    const int nrows = last ? MLAT : MTOT;
    const bf16_t* eout = (const bf16_t*)(p.ws + OFF_EOUT);
    constexpr int NI = ROWS_PER_BLOCK / NWAVES;
    const int row0 = blockIdx.x * ROWS_PER_BLOCK + wave;
    int my0 = 0, my1 = 0;
    if (MOE) {
        const MoeLayout L = moe_layout(p, layer);
        const int r = row0 + NWAVES * lane;
        if (lane < NI && r < nrows) {
            const int4 si = *(const int4*)((const int*)(p.ws + OFF_SLOT) + (size_t)r * 4);
            int t0 = 0, t1 = 0;
#pragma unroll
            for (int j = 0; j < 8; ++j) { t0 = (j == si.x) ? L.tstart[j] : t0; t1 = (j == si.z) ? L.tstart[j] : t1; }
            my0 = t0 * 256 + si.y; my1 = t1 * 256 + si.w;
        }
    }
    float Fb[3][16], Gb[3][16], Xb[3][16];
    auto issue = [&](int i, int row, float (&ff)[16], float (&gg)[16], float (&xx)[16]) {
        if (MOE) { const int a0 = __builtin_amdgcn_readlane(my0, i), a1 = __builtin_amdgcn_readlane(my1, i); ld16_bf16(eout + (size_t)a0 * DM, lane, ff); ld16_bf16(eout + (size_t)a1 * DM, lane, gg); }
        else ld16_bf16(F + (size_t)row * DM, lane, ff);
        ld16_bf16(xs_in + (size_t)row * DM, lane, xx);
    };
    int cur = -1;
    auto step = [&](int i, float (&f)[16], float (&f1)[16], float (&x)[16], float (&fn2)[16], float (&gn2)[16], float (&xn2)[16]) -> bool {
        const int row = row0 + NWAVES * i, bidx = row_bidx(row);
        if (i >= NI || row >= nrows) return false;
        constexpr int AHEAD = MOE ? 1 : 2;
        if (i + AHEAD < NI && row + AHEAD * NWAVES < nrows) issue(i + AHEAD, row + AHEAD * NWAVES, fn2, gn2, xn2);
        if (MOE) {
#pragma unroll
            for (int k = 0; k < 16; ++k) f[k] += f1[k];
        }
        if (bidx != cur) { cur = bidx; float t[16]; ld16(modp(p, layer, bidx, 5), lane, mg3); ld16(ng + 3 * DM, lane, t);
#pragma unroll
            for (int k = 0; k < 16; ++k) mg3[k] *= t[k];
            if (!last) { ld16(modp(p, layer + 1, bidx, 1), lane, gsn); ld16(ng + 4 * DM, lane, t);
#pragma unroll
                for (int k = 0; k < 16; ++k) gsn[k] = t[k] * (1.0f + gsn[k]);
                ld16(modp(p, layer + 1, bidx, 0), lane, sh); } }
        const float rsf = rsqrtf(sumsq16(f) * (1.0f / DM) + EPSN);
#pragma unroll
        for (int k = 0; k < 16; ++k) x[k] = x[k] + mg3[k] * (f[k] * rsf);
        if (last) st16_f32_nt(outp + (size_t)row * DM, lane, x);
        else {
            st16_bf16(xs + (size_t)row * DM, lane, x);
            const float rs2 = rsqrtf(sumsq16(x) * (1.0f / DM) + EPSN);
#pragma unroll
            for (int k = 0; k < 16; ++k) f[k] = x[k] * rs2 * gsn[k] + sh[k];
            { const float fs = st16_i8((unsigned char*)abuf + (size_t)row * DM, lane, f); if (lane == 0 && !dummy) ((float*)(p.ws + OFF_FSC))[row] = fs; }
        }
        return true;
    };
    if (row0 < nrows) issue(0, row0, Fb[0], Gb[0], Xb[0]);
    if constexpr (MOE) {
#pragma unroll 1
        for (int i = 0; i < NI; i += 2) {
            if (!step(i, Fb[0], Gb[0], Xb[0], Fb[1], Gb[1], Xb[1])) break;
            if (!step(i + 1, Fb[1], Gb[1], Xb[1], Fb[0], Gb[0], Xb[0])) break;
        }
    } else {
        if (row0 + NWAVES < nrows) issue(1, row0 + NWAVES, Fb[1], Gb[1], Xb[1]);
#pragma unroll 1
        for (int i = 0; i < NI; i += 3) {
            if (!step(i, Fb[0], Gb[0], Xb[0], Fb[2], Gb[2], Xb[2])) break;
            if (!step(i + 1, Fb[1], Gb[1], Xb[1], Fb[0], Gb[0], Xb[0])) break;
            if (!step(i + 2, Fb[2], Gb[2], Xb[2], Fb[1], Gb[1], Xb[1])) break;
        }
    }
}

__device__ __forceinline__ void phase_nrm(const Params& p, const int wv) {
    const int tid = opaque_tid(wv), lane = tid & 63, wave = tid >> 6;
    const bf16_t* P = (const bf16_t*)(p.ws + OFF_U + U_P_O); bf16_t* mqn = (bf16_t*)(p.ws + OFF_U + U_NRM_O); bf16_t* kvn = (bf16_t*)(p.ws + OFF_U + U_KVN_O);
    for (int row = blockIdx.x * NWAVES + wave; row < MTOT; row += gridDim.x * NWAVES) {
        const bf16_t* pr = P + (size_t)row * ODD_INP;
        const u32x2 q = *(const u32x2*)(pr + 4 * lane); const unsigned kv = *(const unsigned*)(pr + 256 + 2 * lane);
        const float q0 = bf_lo(q.x), q1 = bf_hi(q.x), q2 = bf_lo(q.y), q3 = bf_hi(q.y), k0 = bf_lo(kv), k1 = bf_hi(kv);
        const float rq = rsqrtf(wave_sum(q0 * q0 + q1 * q1 + q2 * q2 + q3 * q3) * (1.0f / 256.0f) + EPSN);
        const float rk = rsqrtf(wave_sum(k0 * k0 + k1 * k1) * (1.0f / 128.0f) + EPSN);
        u32x2 w; w.x = pk_bf16(q0 * rq, q1 * rq); w.y = pk_bf16(q2 * rq, q3 * rq); *(u32x2*)(mqn + (size_t)row * 256 + 4 * lane) = w;
        u32x2 z; z.x = pk_bf16(k0 * rk, k1 * rk); z.y = 0u;
        bf16_t* o = kvn + (size_t)row * 256;
        *(unsigned*)(o + 2 * lane) = z.x; *(unsigned*)(o + 128 + 2 * lane) = 0u;
    }
}

__device__ __forceinline__ void phase_conv(const Params& p, const int wv, int layer) {
    const int tid = opaque_tid(wv), lane = tid & 63, wave = tid >> 6;
    const bf16_t* P = (const bf16_t*)(p.ws + OFF_U + U_P_E); bf16_t* mix = (bf16_t*)(p.ws + OFF_U + U_MIX_E);
    const float* cw = p.in[8] + (size_t)(layer >> 1) * 3 * 512;
    float w0[8], w1[8], w2[8];
#pragma unroll
    for (int k = 0; k < 8; ++k) { w0[k] = cw[8 * lane + k]; w1[k] = cw[512 + 8 * lane + k]; w2[k] = cw[1024 + 8 * lane + k]; }
    const int bA = (int)(blockIdx.x & 7), isA = bA < 2, nit = isA ? 14 : 18;
    const int jb = (int)(blockIdx.x >> 3) * 6 + (bA - 2), oa = jb / 3, orow = (14 + jb % 3) * 2048 + ((oa >> 1) * 8 + (oa & 1)) * 8 + wave;
#pragma unroll 1
    for (int it = 0; it < nit; ++it) {
        const int row = it < 17 ? it * 2048 + (int)blockIdx.x * NWAVES + wave : orow;
        const int pos = row < MLAT ? (row & (SEQ - 1)) : ((row - MLAT) & (CTXL - 1)), len = row < MLAT ? SEQ : CTXL;
        const bf16_t* pr = P + (size_t)row * EVEN_IN + 8 * lane;
        const u32x4 bg = *(const u32x4*)pr;
        float acc[8];
#pragma unroll
        for (int k = 0; k < 8; ++k) acc[k] = 0.f;
#pragma unroll
        for (int d = -1; d <= 1; ++d) {
            if (pos + d < 0 || pos + d >= len) continue;
            const bf16_t* q = pr + (ptrdiff_t)d * EVEN_IN;
            const u32x4 cg = *(const u32x4*)(q + 512), uu = *(const u32x4*)(q + 1024);
            const float* w = d < 0 ? w0 : (d == 0 ? w1 : w2);
#pragma unroll
            for (int k = 0; k < 4; ++k) { acc[2 * k] += w[2 * k] * bf_lo(cg[k]) * bf_lo(uu[k]); acc[2 * k + 1] += w[2 * k + 1] * bf_hi(cg[k]) * bf_hi(uu[k]); }
        }
        u32x4 o;
#pragma unroll
        for (int k = 0; k < 4; ++k) o[k] = pk_bf16(bf_lo(bg[k]) * acc[2 * k], bf_hi(bg[k]) * acc[2 * k + 1]);
        *(u32x4*)(mix + (size_t)row * DM + 8 * lane) = o;
    }
}

__device__ __forceinline__ float max3f(float a, float b, float c) { return __builtin_fmaxf(__builtin_fmaxf(a, b), c); }
__device__ __forceinline__ float xhalf_max(float v) { const auto rr = __builtin_amdgcn_permlane32_swap(__float_as_uint(v), __float_as_uint(v), false, false); return fmaxf(__uint_as_float(rr[0]), __uint_as_float(rr[1])); }
__device__ __forceinline__ float xhalf_sum(float v) { const auto rr = __builtin_amdgcn_permlane32_swap(__float_as_uint(v), __float_as_uint(v), false, false); return __uint_as_float(rr[0]) + __uint_as_float(rr[1]); }
struct NoMask { __device__ __forceinline__ void operator()(f32x16&, f32x16&) const {} };
struct BandMask {
    int kp0, qp, hi;
    __device__ __forceinline__ void operator()(f32x16& s0, f32x16& s1) const {
#pragma unroll
        for (int r = 0; r < 16; ++r) { const int d0 = kp0 + crow(r, hi) - qp, d1 = d0 + 32; if (d0 > 128 || d0 < -128) s0[r] = -INFINITY; if (d1 > 128 || d1 < -128) s1[r] = -INFINITY; }
    }
};
#define ABAR() asm volatile("s_waitcnt lgkmcnt(0)\n\ts_barrier" ::: "memory")
template <int KP, int NKS>
__device__ __forceinline__ void attn_X(const LAS unsigned char* Kt, const bf16x8 (&qf)[NKS], const f32x16& negm, f32x16& s0, f32x16& s1, int lane) {
    const int r32 = lane & 31, hi = lane >> 5;
    const LAS unsigned char* kp = Kt + r32 * KP + hi * 16;
#pragma unroll
    for (int s = 0; s < NKS; ++s) {
        const bf16x8 k0 = *(const LAS bf16x8*)(kp + s * 32), k1 = *(const LAS bf16x8*)(kp + 32 * KP + s * 32);
        s0 = __builtin_amdgcn_mfma_f32_32x32x16_bf16(k0, qf[s], s == 0 ? negm : s0, 0, 0, 0);
        s1 = __builtin_amdgcn_mfma_f32_32x32x16_bf16(k1, qf[s], s == 0 ? negm : s1, 0, 0, 0);
    }
}
template <int NDB, class Mask>
__device__ __forceinline__ void attn_Y(f32x16& s0, f32x16& s1, u32x4 (&pw)[4], f32x16 (&o)[NDB], f32x16& negm, float& m, float& l, bool first, const Mask& mask) {
    constexpr float THR = 8.0f;
    mask(s0, s1);
    float a = max3f(s0[0], s0[1], s1[0]), b = max3f(s0[2], s0[3], s1[1]); a = max3f(a, s1[2], s1[3]);
#pragma unroll
    for (int r = 4; r < 16; r += 4) { a = max3f(a, s0[r], s0[r + 1]); b = max3f(b, s0[r + 2], s0[r + 3]); a = max3f(a, s1[r], s1[r + 1]); b = max3f(b, s1[r + 2], s1[r + 3]); }
    const float rm = xhalf_max(fmaxf(a, b));
    if (first || __any(rm > THR)) {
        const float dl = first ? fmaxf(rm, -64.0f) : fmaxf(rm, 0.f), f = fast_exp2(-dl);
        m += dl; l *= f;
#pragma unroll
        for (int r = 0; r < 16; ++r) { s0[r] -= dl; s1[r] -= dl; negm[r] = -m; }
#pragma unroll
        for (int d = 0; d < NDB; ++d)
#pragma unroll
            for (int r = 0; r < 16; ++r) o[d][r] *= f;
    }
    float ps = 0.f;
#pragma unroll
    for (int r = 0; r < 16; ++r) { s0[r] = fast_exp2(s0[r]); s1[r] = fast_exp2(s1[r]); ps += s0[r] + s1[r]; }
    l += ps;
#pragma unroll
    for (int ks = 0; ks < 2; ++ks) {
        pw[ks] = (u32x4){pk_bf16(s0[8 * ks], s0[8 * ks + 1]), pk_bf16(s0[8 * ks + 2], s0[8 * ks + 3]), pk_bf16(s0[8 * ks + 4], s0[8 * ks + 5]), pk_bf16(s0[8 * ks + 6], s0[8 * ks + 7])};
        pw[2 + ks] = (u32x4){pk_bf16(s1[8 * ks], s1[8 * ks + 1]), pk_bf16(s1[8 * ks + 2], s1[8 * ks + 3]), pk_bf16(s1[8 * ks + 4], s1[8 * ks + 5]), pk_bf16(s1[8 * ks + 6], s1[8 * ks + 7])};
    }
}
template <int VP, int NDB>
__device__ __forceinline__ void attn_Z(const LAS unsigned char* Vt, const u32x4 (&pw)[4], f32x16 (&o)[NDB], int lane) {
    const int hi = lane >> 5;
    const LAS unsigned char* vp = Vt + (4 * hi + ((lane & 15) >> 2)) * VP + ((lane >> 4) & 1) * 32 + (lane & 3) * 8;
    if constexpr (NDB <= 4) {
        s16x4 lo[NDB], hh[NDB], lon[NDB], hhn[NDB];
#pragma unroll
        for (int d = 0; d < NDB; ++d) { lo[d] = __builtin_bit_cast(s16x4, __builtin_amdgcn_ds_read_tr16_b64_v4i16((LAS s16x4*)(vp + d * 64))); hh[d] = __builtin_bit_cast(s16x4, __builtin_amdgcn_ds_read_tr16_b64_v4i16((LAS s16x4*)(vp + d * 64 + 8 * VP))); }
#pragma unroll
        for (int st = 0; st < 4; ++st) {
            __builtin_amdgcn_sched_barrier(0);
            if (st < 3) {
#pragma unroll
                for (int d = 0; d < NDB; ++d) { const LAS unsigned char* a = vp + (16 * (st + 1)) * VP + d * 64;
                    lon[d] = __builtin_bit_cast(s16x4, __builtin_amdgcn_ds_read_tr16_b64_v4i16((LAS s16x4*)a)); hhn[d] = __builtin_bit_cast(s16x4, __builtin_amdgcn_ds_read_tr16_b64_v4i16((LAS s16x4*)(a + 8 * VP))); }
            }
            const bf16x8 pf = __builtin_bit_cast(bf16x8, pw[st]);
#pragma unroll
            for (int d = 0; d < NDB; ++d) { const bf16x8 vf = {lo[d][0], lo[d][1], lo[d][2], lo[d][3], hh[d][0], hh[d][1], hh[d][2], hh[d][3]}; o[d] = __builtin_amdgcn_mfma_f32_32x32x16_bf16(vf, pf, o[d], 0, 0, 0); }
#pragma unroll
            for (int d = 0; d < NDB; ++d) { lo[d] = lon[d]; hh[d] = hhn[d]; }
        }
    } else {
#pragma unroll
        for (int st = 0; st < 4; ++st) {
            __builtin_amdgcn_sched_barrier(0);
            const bf16x8 pf = __builtin_bit_cast(bf16x8, pw[st]);
#pragma unroll
            for (int d = 0; d < NDB; ++d) { const LAS unsigned char* a = vp + (16 * st) * VP + d * 64;
                const s16x4 lo = __builtin_bit_cast(s16x4, __builtin_amdgcn_ds_read_tr16_b64_v4i16((LAS s16x4*)a)), hh = __builtin_bit_cast(s16x4, __builtin_amdgcn_ds_read_tr16_b64_v4i16((LAS s16x4*)(a + 8 * VP)));
                const bf16x8 vf = {lo[0], lo[1], lo[2], lo[3], hh[0], hh[1], hh[2], hh[3]}; o[d] = __builtin_amdgcn_mfma_f32_32x32x16_bf16(vf, pf, o[d], 0, 0, 0); }
        }
    }
}
template <int KP, int VP, int NKS, int NDB, class GLK, class GLV, class STK, class STV, class MaskF>
__device__ __forceinline__ void attn_run1(LAS unsigned char* lds, int KB, int SB, int kcoff, const bf16x8 (&qf)[NKS], f32x16 (&o)[NDB], float& m, float& l, int NT, int lane,
                                          GLK glk, GLV glv, STK stk, STV stv, MaskF maskf) {
    f32x16 s0, s1, negm; u32x4 pw[4];
    m = 0.f;
#pragma unroll
    for (int r = 0; r < 16; ++r) negm[r] = 0.f;
    glk(0); glv(0); stk(0); stv(0); ABAR();
#pragma unroll 1
    for (int t = 0; t < NT; ++t) {
        if (t + 1 < NT) { glk(t + 1); glv(t + 1); }
        const LAS unsigned char* Kt = lds + (t & 1) * SB;
        attn_X<KP, NKS>(Kt + kcoff, qf, negm, s0, s1, lane);
        __builtin_amdgcn_sched_barrier(0);
        attn_Y<NDB>(s0, s1, pw, o, negm, m, l, t == 0, [&](f32x16& x0, f32x16& x1) { maskf(t, x0, x1); });
        __builtin_amdgcn_sched_barrier(0);
        attn_Z<VP, NDB>(Kt + KB, pw, o, lane);
        if (t + 1 < NT) { stk((t + 1) & 1); stv((t + 1) & 1); }
        ABAR();
    }
}

template <int NDB, class Mask>
__device__ __forceinline__ void attn_Y1(f32x16& s0, f32x16& s1, f32x16 (&o)[NDB], f32x16& negm, float& m, float& l, bool first, const Mask& mask) {
    constexpr float THR = 8.0f;
    mask(s0, s1);
    float a = max3f(s0[0], s0[1], s1[0]), b = max3f(s0[2], s0[3], s1[1]); a = max3f(a, s1[2], s1[3]);
#pragma unroll
    for (int r = 4; r < 16; r += 4) { a = max3f(a, s0[r], s0[r + 1]); b = max3f(b, s0[r + 2], s0[r + 3]); a = max3f(a, s1[r], s1[r + 1]); b = max3f(b, s1[r + 2], s1[r + 3]); }
    const float rm = xhalf_max(fmaxf(a, b));
    if (first || __any(rm > THR)) {
        const float dl = first ? fmaxf(rm, -64.0f) : fmaxf(rm, 0.f), f = fast_exp2(-dl);
        m += dl; l *= f;
#pragma unroll
        for (int r = 0; r < 16; ++r) { s0[r] -= dl; s1[r] -= dl; negm[r] = -m; }
#pragma unroll
        for (int d = 0; d < NDB; ++d)
#pragma unroll
            for (int r = 0; r < 16; ++r) o[d][r] *= f;
    }
}
__device__ __forceinline__ void attn_Y2(f32x16& s0, f32x16& s1, u32x4 (&pw)[4], float& l) {
    float ps = 0.f;
#pragma unroll
    for (int r = 0; r < 16; ++r) { s0[r] = fast_exp2(s0[r]); s1[r] = fast_exp2(s1[r]); ps += s0[r] + s1[r]; }
    l += ps;
#pragma unroll
    for (int ks = 0; ks < 2; ++ks) {
        pw[ks] = (u32x4){pk_bf16(s0[8 * ks], s0[8 * ks + 1]), pk_bf16(s0[8 * ks + 2], s0[8 * ks + 3]), pk_bf16(s0[8 * ks + 4], s0[8 * ks + 5]), pk_bf16(s0[8 * ks + 6], s0[8 * ks + 7])};
        pw[2 + ks] = (u32x4){pk_bf16(s1[8 * ks], s1[8 * ks + 1]), pk_bf16(s1[8 * ks + 2], s1[8 * ks + 3]), pk_bf16(s1[8 * ks + 4], s1[8 * ks + 5]), pk_bf16(s1[8 * ks + 6], s1[8 * ks + 7])};
    }
}
template <int KP, int VP, int NKS, int NDB, int VPM  , class GLK, class GLV, class STK, class STV, class MaskF>
__device__ __forceinline__ void attn_run2(LAS unsigned char* lds, int KB, int SB, int kcoff, const bf16x8 (&qf)[NKS], f32x16 (&o)[NDB], float& m, float& l, int NT, int lane,
                                          GLK glk, GLV glv, STK stk, STV stv, MaskF maskf) {
    f32x16 sa0, sa1, sb0, sb1, negm; u32x4 pw[4];
    m = 0.f;
#pragma unroll
    for (int r = 0; r < 16; ++r) negm[r] = 0.f;
    glk(0); stk(0); glv(0); stv(0);
    if (NT > 1) { glk(1); stk(1); }
    ABAR();
    attn_X<KP, NKS>(lds + kcoff, qf, negm, sa0, sa1, lane);
    auto step = [&](int t, f32x16& c0, f32x16& c1, f32x16& n0, f32x16& n1) {
        if (t + 2 < NT) glk(t + 2);
        if (t + 1 < NT) glv(t + 1);
        attn_Y1<NDB>(c0, c1, o, negm, m, l, t == 0, [&](f32x16& x0, f32x16& x1) { maskf(t, x0, x1); });
        if (t + 1 < NT) attn_X<KP, NKS>(lds + ((t + 1) & 1) * SB + kcoff, qf, negm, n0, n1, lane);
        attn_Y2(c0, c1, pw, l);
        __builtin_amdgcn_sched_group_barrier(0x100, 2 * NKS, 0);
#pragma unroll
        for (int i = 0; i < 2 * NKS; ++i) { __builtin_amdgcn_sched_group_barrier(0x008, 1, 0); __builtin_amdgcn_sched_group_barrier(0x002, VPM, 0); }
        __builtin_amdgcn_sched_barrier(0);
        attn_Z<VP, NDB>(lds + (t & 1) * SB + KB, pw, o, lane);
        if (t + 2 < NT) stk(t & 1);
        if (t + 1 < NT) stv((t + 1) & 1);
        ABAR();
    };
#pragma unroll 1
    for (int t = 0; t < NT; t += 2) {
        step(t, sa0, sa1, sb0, sb1);
        if (t + 1 < NT) step(t + 1, sb0, sb1, sa0, sa1);
    }
}

__device__ __forceinline__ void store_row_pairs(bf16_t* p32, const u32x2 (&w)[4], int hi) {
#pragma unroll
    for (int k = 0; k < 4; k += 2) {
        u32x2 a = w[k], b = w[k + 1];
        { const auto r = __builtin_amdgcn_permlane32_swap(a.x, b.x, false, false); a.x = r[0]; b.x = r[1]; }
        { const auto r = __builtin_amdgcn_permlane32_swap(a.y, b.y, false, false); a.y = r[0]; b.y = r[1]; }
        *(u32x4*)(p32 + 8 * k + 8 * hi) = (u32x4){a.x, a.y, b.x, b.y};
    }
}
__device__ __forceinline__ bf16x8 load_q(const bf16_t* p, float qs) {
    const u32x4 w = *(const u32x4*)p; u32x4 o;
#pragma unroll
    for (int k = 0; k < 4; ++k) o[k] = pk_bf16(bf_lo(w[k]) * qs, bf_hi(w[k]) * qs);
    return __builtin_bit_cast(bf16x8, o);
}
__device__ __forceinline__ int attn_vcu() { return (int)((blockIdx.x & 7) * (gridDim.x >> 3) + (blockIdx.x >> 3)); }

__device__ __forceinline__ void swa_unit(const Params& p, const int wv, LAS unsigned char* lds, int layer, int b, int g, int q0, bool ctxq) {
    constexpr int KP = 144, VP = 192, KB = 64 * KP, SB = KB + 64 * VP;
    const int tid = opaque_tid(wv), lane = tid & 63, wave = __builtin_amdgcn_readfirstlane(tid >> 6), r32 = lane & 31, hi = lane >> 5;
    const bf16_t* P = (const bf16_t*)(p.ws + OFF_U + U_P_E); bf16_t* mix = (bf16_t*)(p.ws + OFF_U + U_MIX_E);
    const int hd = 4 * g + (wave >> 1);
    const int qrow = (ctxq ? MLAT + b * CTXL : b * SEQ) + q0 + 32 * (wave & 1) + r32;
    const float qs = 0.125f * LOG2E;
    bf16x8 qf[4];
#pragma unroll
    for (int s = 0; s < 4; ++s) qf[s] = load_q(P + (size_t)qrow * EVEN_IN + 1536 + hd * 64 + 16 * s + 8 * hi, qs);
    f32x16 o[2];
#pragma unroll
    for (int d = 0; d < 2; ++d)
#pragma unroll
        for (int r = 0; r < 16; ++r) o[d][r] = 0.f;
    float m = -1e30f, l = 0.f;
    int ilo = 0, nlat = 0;
    if (!ctxq) { ilo = q0 >= 128 ? 0 : (128 - q0) / 64; int ihi = (SEQ + 64 - q0) / 64; ihi = ihi > 4 ? 4 : ihi; nlat = ihi - ilo + 1; }
    const int NT = nlat + 4;
    const int ki = tid >> 3, kc = tid & 7;
    u32x4 rk, rv;
    auto krow = [&](int t) { return t < nlat ? b * SEQ + q0 - 128 + 64 * (ilo + t) + ki : MLAT + b * CTXL + 64 * (t - nlat) + ki; };
    auto glk = [&](int t) { rk = *(const u32x4*)(P + (size_t)krow(t) * EVEN_IN + 2048 + g * 64 + kc * 8); };
    auto glv = [&](int t) { rv = *(const u32x4*)(P + (size_t)krow(t) * EVEN_IN + 2176 + g * 64 + kc * 8); };
    auto stk = [&](int buf) { *(LAS u32x4*)(lds + buf * SB + ki * KP + kc * 16) = rk; };
    auto stv = [&](int buf) { *(LAS u32x4*)(lds + buf * SB + KB + ki * VP + kc * 16) = rv; };
    const int qp = q0 + 32 * (wave & 1) + r32;
    attn_run1<KP, VP, 4, 2>(lds, KB, SB, 0, qf, o, m, l, NT, lane, glk, glv, stk, stv,
        [&](int t, f32x16& x0, f32x16& x1) { if (t < nlat) { BandMask bm; bm.kp0 = q0 - 128 + 64 * (ilo + t); bm.qp = qp; bm.hi = hi; bm(x0, x1); } });
    l = xhalf_sum(l);
    l += fast_exp2(p.in[9][(layer >> 1) * 8 + hd] * LOG2E - m);
    const float inv = 1.0f / l;
    bf16_t* orow = mix + (size_t)qrow * DM + 512 + hd * 64;
#pragma unroll
    for (int d = 0; d < 2; ++d) { u32x2 w[4];
#pragma unroll
        for (int gq = 0; gq < 4; ++gq) { w[gq].x = pk_bf16(o[d][4 * gq] * inv, o[d][4 * gq + 1] * inv); w[gq].y = pk_bf16(o[d][4 * gq + 2] * inv, o[d][4 * gq + 3] * inv); }
        store_row_pairs(orow + 32 * d, w, hi); }
}
__device__ __forceinline__ void phase_swa(const Params& p, const int wv, LAS unsigned char* lds, int layer) {
    const int v = attn_vcu();
    for (int u = v; u < 1024 + 64; u += gridDim.x) {
        if (u < 1024) swa_unit(p, wv, lds, layer, u >> 7, (u >> 6) & 1, (u & 63) * 64, false);
        else { const int c = u - 1024; swa_unit(p, wv, lds, layer, c >> 3, (c >> 2) & 1, (c & 3) * 64, true); }
    }
}

__device__ __forceinline__ void mla_unit(const Params& p, const int wv, LAS unsigned char* lds, int b, int h, int qrow0, int nl) {
    constexpr int KP = 208, VP = 192, KB = 64 * KP, SB = KB + 64 * VP;
    const int tid = opaque_tid(wv), lane = tid & 63, wave = __builtin_amdgcn_readfirstlane(tid >> 6), r32 = lane & 31, hi = lane >> 5;
    const bf16_t* P = (const bf16_t*)(p.ws + OFF_U + U_P_O); const bf16_t* QF = (const bf16_t*)(p.ws + OFF_U + U_QF_O); const bf16_t* KVF = (const bf16_t*)(p.ws + OFF_U + U_KVF_O);
    bf16_t* mix = (bf16_t*)(p.ws + OFF_U + U_MIX_O);
    const int qrow = qrow0 + 32 * wave + r32;
    const float qs = 0.10206207261596575f * LOG2E;
    bf16x8 qf[6];
#pragma unroll
    for (int s = 0; s < 4; ++s) qf[s] = load_q(QF + (size_t)qrow * 768 + h * 96 + 16 * s + 8 * hi, qs);
    {
        const u32x4 a = *(const u32x4*)(QF + (size_t)qrow * 768 + h * 96 + 64 + 8 * hi), bq = *(const u32x4*)(QF + (size_t)qrow * 768 + h * 96 + 80 + 8 * hi);
        float x1[8], x2[8];
#pragma unroll
        for (int k = 0; k < 4; ++k) { x1[2 * k] = bf_lo(a[k]); x1[2 * k + 1] = bf_hi(a[k]); x2[2 * k] = bf_lo(bq[k]); x2[2 * k + 1] = bf_hi(bq[k]); }
        if (nl > 0) {
            const float* tab = (const float*)(p.ws + OFF_TAB) + 2048; const int sp = qrow & (SEQ - 1), pos = hi ? (sp & 63) : (sp >> 6);
#pragma unroll
            for (int k = 0; k < 8; ++k) { const float cs = tab[pos * 8 + k], sn = tab[512 + pos * 8 + k]; const float o1 = x1[k] * cs - x2[k] * sn, o2 = x2[k] * cs + x1[k] * sn; x1[k] = o1; x2[k] = o2; }
        }
        u32x4 w1, w2;
#pragma unroll
        for (int k = 0; k < 4; ++k) { w1[k] = pk_bf16(x1[2 * k] * qs, x1[2 * k + 1] * qs); w2[k] = pk_bf16(x2[2 * k] * qs, x2[2 * k + 1] * qs); }
        qf[4] = __builtin_bit_cast(bf16x8, w1); qf[5] = __builtin_bit_cast(bf16x8, w2);
    }
    f32x16 o[2];
#pragma unroll
    for (int d = 0; d < 2; ++d)
#pragma unroll
        for (int r = 0; r < 16; ++r) o[d][r] = 0.f;
    float m = -1e30f, l = 0.f;
    const int NT = nl + 4;
    const int ki = tid >> 3, kc = tid & 7, ki2 = (tid >> 2) & 63, kc2 = tid & 3;
    u32x4 rk, rv, rp;
    auto krow = [&](int t, int i) { return t < nl ? b * SEQ + 64 * t + i : MLAT + b * CTXL + 64 * (t - nl) + i; };
    auto glk = [&](int t) { rk = *(const u32x4*)(KVF + (size_t)krow(t, ki) * 1024 + h * 128 + kc * 8); if (tid < 256) rp = *(const u32x4*)(P + (size_t)krow(t, ki2) * ODD_INP + 384 + kc2 * 8); };
    auto glv = [&](int t) { rv = *(const u32x4*)(KVF + (size_t)krow(t, ki) * 1024 + h * 128 + 64 + kc * 8); };
    auto stk = [&](int buf) { *(LAS u32x4*)(lds + buf * SB + ki * KP + kc * 16) = rk; if (tid < 256) *(LAS u32x4*)(lds + buf * SB + ki2 * KP + 128 + kc2 * 16) = rp; };
    auto stv = [&](int buf) { *(LAS u32x4*)(lds + buf * SB + KB + ki * VP + kc * 16) = rv; };
    attn_run2<KP, VP, 6, 2, 7>(lds, KB, SB, 0, qf, o, m, l, NT, lane, glk, glv, stk, stv, [](int, f32x16&, f32x16&) {});
    l = xhalf_sum(l);
    const float inv = 1.0f / l;
    bf16_t* orow = mix + (size_t)qrow * DM + h * 64;
#pragma unroll
    for (int d = 0; d < 2; ++d) { u32x2 w[4];
#pragma unroll
        for (int gq = 0; gq < 4; ++gq) { w[gq].x = pk_bf16(o[d][4 * gq] * inv, o[d][4 * gq + 1] * inv); w[gq].y = pk_bf16(o[d][4 * gq + 2] * inv, o[d][4 * gq + 3] * inv); }
        store_row_pairs(orow + 32 * d, w, hi); }
}

__device__ __forceinline__ void diff_unit(const Params& p, const int wv, LAS unsigned char* lds, int layer, int b, int h, int qrow0, int nl, float lam, float lam_init) {
    constexpr int KP = 272, VP = 320, KB = 64 * KP, SB = KB + 64 * VP, XP = 528;
    const int tid = opaque_tid(wv), lane = tid & 63, wave = __builtin_amdgcn_readfirstlane(tid >> 6), r32 = lane & 31, hi = lane >> 5;
    const bf16_t* P = (const bf16_t*)(p.ws + OFF_U + U_P_O); bf16_t* mix = (bf16_t*)(p.ws + OFF_U + U_MIX_O);
    const int comp = wave >> 2, qrow = qrow0 + 32 * (wave & 3) + r32;
    const float qs = 0.125f * LOG2E;
    bf16x8 qf[4];
#pragma unroll
    for (int s = 0; s < 4; ++s) qf[s] = load_q(P + (size_t)qrow * ODD_INP + 512 + h * 128 + comp * 64 + 16 * s + 8 * hi, qs);
    f32x16 o[4];
#pragma unroll
    for (int d = 0; d < 4; ++d)
#pragma unroll
        for (int r = 0; r < 16; ++r) o[d][r] = 0.f;
    float m = -1e30f, l = 0.f;
    const int NT = nl + 4;
    const int ki = tid >> 3, kc = tid & 7;
    u32x4 rk0, rk1, rv0, rv1;
    auto krow = [&](int t) { return t < nl ? b * SEQ + 64 * t + ki : MLAT + b * CTXL + 64 * (t - nl) + ki; };
    auto glk = [&](int t) { const bf16_t* pr = P + (size_t)krow(t) * ODD_INP + 1024 + h * 128 + kc * 8; rk0 = *(const u32x4*)pr; rk1 = *(const u32x4*)(pr + 64); };
    auto glv = [&](int t) { const bf16_t* pr = P + (size_t)krow(t) * ODD_INP + 1536 + h * 128 + kc * 8; rv0 = *(const u32x4*)pr; rv1 = *(const u32x4*)(pr + 64); };
    auto stk = [&](int buf) { LAS unsigned char* kb = lds + buf * SB + ki * KP + kc * 16; *(LAS u32x4*)kb = rk0; *(LAS u32x4*)(kb + 128) = rk1; };
    auto stv = [&](int buf) { LAS unsigned char* vb = lds + buf * SB + KB + ki * VP + kc * 16; *(LAS u32x4*)vb = rv0; *(LAS u32x4*)(vb + 128) = rv1; };
    attn_run2<KP, VP, 4, 4, 10>(lds, KB, SB, comp * 128, qf, o, m, l, NT, lane, glk, glv, stk, stv, [](int, f32x16&, f32x16&) {});
    l = xhalf_sum(l);
    const float inv = 1.0f / l;
    LAS unsigned char* xrow = lds + (32 * (wave & 3) + r32) * XP;
    if (comp == 1) {
#pragma unroll
        for (int d = 0; d < 4; ++d)
#pragma unroll
            for (int gq = 0; gq < 4; ++gq) *(LAS f32x4*)(xrow + (32 * d + 8 * gq + 4 * hi) * 4) = (f32x4){o[d][4 * gq] * inv, o[d][4 * gq + 1] * inv, o[d][4 * gq + 2] * inv, o[d][4 * gq + 3] * inv};
    }
    __syncthreads();
    if (comp == 0) {
        float ss = 0.f;
#pragma unroll
        for (int d = 0; d < 4; ++d)
#pragma unroll
            for (int gq = 0; gq < 4; ++gq) { const f32x4 o2 = *(const LAS f32x4*)(xrow + (32 * d + 8 * gq + 4 * hi) * 4);
#pragma unroll
                for (int k = 0; k < 4; ++k) { const float v = o[d][4 * gq + k] * inv - lam * o2[k]; o[d][4 * gq + k] = v; ss += v * v; } }
        ss = xhalf_sum(ss);
        const float omli = __uint_as_float(__builtin_amdgcn_readfirstlane(__float_as_uint(layer == 1 ? 1.0f - 0.35550906f : 1.0f - 0.55605820f)));
        const float rs = rsqrtf(ss * (1.0f / 128.0f) + EPSN) * omli;
        const float* sg = p.in[17] + (size_t)(layer >> 1) * 128;
        bf16_t* orow = mix + (size_t)qrow * DM + 512 + h * 128;
#pragma unroll
        for (int d = 0; d < 4; ++d) { u32x2 w[4];
#pragma unroll
            for (int gq = 0; gq < 4; ++gq) { const int c = 32 * d + 8 * gq + 4 * hi; const f32x4 gg = *(const f32x4*)(sg + c);
                w[gq].x = pk_bf16(o[d][4 * gq] * rs * gg[0], o[d][4 * gq + 1] * rs * gg[1]); w[gq].y = pk_bf16(o[d][4 * gq + 2] * rs * gg[2], o[d][4 * gq + 3] * rs * gg[3]); }
            store_row_pairs(orow + 32 * d, w, hi); }
    }
    __syncthreads();
}
__device__ __forceinline__ void phase_attn_odd(const Params& p, const int wv, LAS unsigned char* lds, int layer) {
    const int v = attn_vcu();
    const bool need_ctx = layer < 3;
    const float* lp = p.in[16] + (size_t)(layer >> 1) * 256; const int ln = opaque_tid(wv) & 63;
    const float lam_init = layer == 1 ? 0.35550906f : 0.55605820f;
    const float lam = __uint_as_float(__builtin_amdgcn_readfirstlane(__float_as_uint(expf(wave_sum(lp[ln] * lp[64 + ln])) - expf(wave_sum(lp[128 + ln] * lp[192 + ln])) + lam_init)));
    const int n_mla = 1024 + (need_ctx ? 64 : 0);
#ifndef NO_MLA
    for (int u = v; u < n_mla; u += gridDim.x) {
        if (u < 1024) { const int bh = u >> 4, qb = u & 15; mla_unit(p, wv, lds, bh >> 3, bh & 7, (bh >> 3) * SEQ + qb * 256, 64); }
        else { const int c = u - 1024; mla_unit(p, wv, lds, c >> 3, c & 7, MLAT + (c >> 3) * CTXL, 0); }
    }
#endif
#ifndef NO_DIFF
    for (int u = v; u < n_mla + 64; u += gridDim.x) {
        if (u < 1024) { const int bh = u >> 5, qb = u & 31; diff_unit(p, wv, lds, layer, bh >> 2, bh & 3, (bh >> 2) * SEQ + qb * 128, 64, lam, lam_init); }
        else if (u >= 1024 + 64) { const int c = u - 1024 - 64, bh = c >> 1; diff_unit(p, wv, lds, layer, bh >> 2, bh & 3, MLAT + (bh >> 2) * CTXL + (c & 1) * 128, 0, lam, lam_init); }
    }
#endif
}

__device__ __forceinline__ bool tail_share(int nwg, int G, int c, int& rank, int& nidle) {
    const int rmax = (nwg + G - 1) / G; int busy = nwg - (rmax - 1) * G; busy = busy >= G ? 0 : busy;
    rank = c - busy; nidle = G - busy; return c >= busy;
}

constexpr int NPH_PAIR = 16, NPHASES = 2 + 2 * NPH_PAIR;
__global__ void __launch_bounds__(NTHREADS, 2) fwd(Params p, int lo, int hi) {
    extern __shared__ __attribute__((aligned(16))) unsigned char smem_raw[];
    LAS unsigned char* lds = (LAS unsigned char*)smem_raw;
    volatile LAS unsigned* xbw = (volatile LAS unsigned*)(lds + LDS_BYTES - 16);
    unsigned char* ws = p.ws;
    const int wv = __builtin_amdgcn_readfirstlane((int)(threadIdx.x >> 6));
    XcdBarrier bar; bar.bar = (unsigned*)(ws + OFF_CTL); bar.x = 0; bar.st = xbw; bar.wv = wv;
    if (hi - lo > 1) {
        if (wv == 0 && lane_id() == 0) { xbw[0] = 0u; xbw[1] = 0u; xbw[2] = 0u; xbw[3] = 0u; }
        __syncthreads();
        bar = xcd_barrier_post((unsigned*)(ws + OFF_CTL), xbw, wv);
    }
    const int G = gridDim.x, c = blockIdx.x;
    constexpr int NM = MTOT / 256;
#ifndef PH_MASK
#define PH_MASK 0xFFFFFFFFu
#endif
#define PHASE(id) if (lo <= (id) && (id) < hi)
#ifndef DUP_MASK
#define DUP_MASK 0u
#endif
#define DUPK(k) _Pragma("unroll 1") for (int dup_ = 0; dup_ < ((((DUP_MASK) >> (k)) & 1u) ? 2 : 1); ++dup_)
#define DUP_DUMMY(k) (((((DUP_MASK) >> (k)) & 1u) != 0u) && dup_ == 0)
#define PMARK(k) asm volatile("; PHASE_MARK " #k ::: "memory")
#define PHM(k) if constexpr ((PH_MASK >> (k)) & 1u)
#define SEAM(id) do { if ((id) > lo) xcd_barrier(bar); } while (0)
    PHM(0) PHASE(0) DUPK(0) { PMARK(0); phase_prologue(p, wv, lds); }
    PHM(1) PHASE(1) DUPK(1) { PMARK(1); SEAM(1); phase_h0(p, wv); }
    for (int pr = 0; pr < 2; ++pr) {
        Params pq = p; pq.ws = fresh_ws();
        unsigned char* ws = pq.ws;
        const int le = 2 * pr, lod = 2 * pr + 1, pb = 2 + pr * NPH_PAIR;
        const bf16_t* abuf = (const bf16_t*)(ws + OFF_ABUF);
        PHM(2) PHASE(pb + 0) DUPK(2) { PMARK(2); SEAM(pb + 0);
            pg8::Gemm g{abuf, ws + OFF_WINE + pr * SZ_WINE, 1024, 1024}; pg8::StaticOrder S; S.init(NM, EVEN_IN / 256, G, c);
            pg8::EpiRope<0> E{(bf16_t*)(ws + OFF_U + U_P_E), EVEN_IN, (const float*)(ws + OFF_TAB), (const float*)(ws + OFF_FSC), (const float*)(ws + OFF_WSCI) + (size_t)pr * EVEN_IN, nullptr}; pg8::gemm_phase<3>(lds, g, S, E, wv); }
        PHM(3) PHASE(pb + 1) DUPK(3) { PMARK(3); SEAM(pb + 1); phase_conv(pq, wv, le); phase_swa(pq, wv, lds, le); }
        PHM(4) PHASE(pb + 2) DUPK(4) { PMARK(4); SEAM(pb + 2);
            pg8::Gemm g{(const bf16_t*)(ws + OFF_U + U_MIX_E), (const bf16_t*)(ws + OFF_WOUTE + pr * SZ_WOUT), 1024, 1024}; pg8::StaticOrder S; S.init(NM, 4, G, c);
            pg8::EpiBf16S E{(bf16_t*)(ws + OFF_U + U_Y_E), 1024, 4, nullptr, 1.0f}; pg8::gemm_phase<2>(lds, g, S, E, wv);
            { int rk, ni; if (tail_share(NM * 4, G, c, rk, ni)) conv_tiles_run(p, lds, opaque_tid(wv), CV_NT_PRO + pr * (CV_NT_E / 2), CV_NT_PRO + pr * (CV_NT_E / 2) + TAIL_T_SPLIT, rk, ni); } }
        PHM(5) PHASE(pb + 3) DUPK(5) { PMARK(5); SEAM(pb + 3); phase_rowB<false>(pq, wv, lds, le, (const bf16_t*)(ws + OFF_U + U_Y_E), MTOT, DUP_DUMMY(5)); }
        PHM(6) PHASE(pb + 4) DUPK(6) { PMARK(6); SEAM(pb + 4);
            pg8::Gemm g{abuf, ws + OFF_WGU + pr * SZ_WGU, 1024, 1024}; pg8::StaticOrder S; S.init(NM, 2 * FFD / 256, G, c);
            pg8::EpiSwiGLU<FFN_DOWN_FP8 != 0> E{ws + OFF_U + U_ACT_E, FFD, 2 * FFD / 256, (const float*)(ws + OFF_FSC), (const float*)(ws + OFF_WSCD) + (size_t)pr * 2 * FFD}; pg8::gemm_phase<3>(lds, g, S, E, wv); }
        PHM(7) PHASE(pb + 5) DUPK(7) { PMARK(7); SEAM(pb + 5);
            pg8::Gemm g{ws + OFF_U + U_ACT_E, ws + OFF_WDN + pr * SZ_WDN, FFD, FFD}; pg8::StaticOrder S; S.init(NM, 4, G, c);
            pg8::EpiBf16S E{(bf16_t*)(ws + OFF_U + U_Y_E), 1024, 4, nullptr, FFN_DOWN_FP8 ? 1.0f / W8_SCALE : 1.0f}; pg8::gemm_phase<FFN_DOWN_FP8 ? 1 : 2>(lds, g, S, E, wv);
            { int rk, ni; if (tail_share(NM * 4, G, c, rk, ni)) {
                if (pr == 0) conv_units(p, lds, opaque_tid(wv), CV_NU_PRO, CV_NU_PRO + TAIL_U_SPLIT, rk, ni); else conv_units(p, lds, opaque_tid(wv), CV_NU_PRO + CV_NU_E / 2 + TAIL_U_SPLIT, CV_NU, rk, ni); } } }
        PHM(8) PHASE(pb + 6) DUPK(8) { PMARK(8); SEAM(pb + 6); phase_rowC<false>(pq, wv, le, (const bf16_t*)(ws + OFF_U + U_Y_E), false, DUP_DUMMY(8)); }
        PHM(9) PHASE(pb + 7) DUPK(9) { PMARK(9); SEAM(pb + 7);
            pg8::Gemm g{abuf, ws + OFF_WINO + pr * SZ_WINO, 1024, 1024}; pg8::StaticOrder S; S.init(NM, ODD_INP / 256, G, c);
            pg8::EpiRope<1> E{(bf16_t*)(ws + OFF_U + U_P_O), ODD_INP, (const float*)(ws + OFF_TAB), (const float*)(ws + OFF_FSC), (const float*)(ws + OFF_WSCI) + 2 * EVEN_IN + (size_t)pr * ODD_INP, (float*)(ws + OFF_U + U_SSQ_O)}; pg8::gemm_phase<3>(lds, g, S, E, wv);
            { int rk, ni; if (tail_share(NM * (ODD_INP / 256), G, c, rk, ni)) conv_tiles_run(p, lds, opaque_tid(wv), CV_NT_PRO + pr * (CV_NT_E / 2) + TAIL_T_SPLIT, CV_NT_PRO + (pr + 1) * (CV_NT_E / 2), rk, ni); } }
        PHM(11) PHASE(pb + 8) DUPK(11) { PMARK(11); SEAM(pb + 8);
            pg8::Gemm g{(const bf16_t*)(ws + OFF_U + U_P_O), (const bf16_t*)(ws + OFF_WQUP + pr * SZ_WQUP), ODD_INP, 256}; pg8::StaticOrder S; S.init(NM, 3, G, c);
            pg8::EpiBf16N<8> E{(bf16_t*)(ws + OFF_U + U_QF_O), 768, (const float*)(ws + OFF_U + U_SSQ_O), 1.0f / 256.0f}; pg8::gemm_phase<2>(lds, g, S, E, wv); }
        PHM(19) PHASE(pb + 9) DUPK(19) { PMARK(19);
            pg8::Gemm g{(const bf16_t*)(ws + OFF_U + U_P_O) + 256, (const bf16_t*)(ws + OFF_WKVUP + pr * SZ_WKVUP), ODD_INP, 256}; pg8::StaticOrder S; S.init(NM, 4, G, G - 1 - c);
            pg8::EpiBf16N<4> E{(bf16_t*)(ws + OFF_U + U_KVF_O), 1024, (const float*)(ws + OFF_U + U_SSQ_O) + 8, 1.0f / 128.0f}; pg8::gemm_phase<2>(lds, g, S, E, wv); }
        PHM(12) PHASE(pb + 10) DUPK(12) { PMARK(12); SEAM(pb + 10); phase_attn_odd(pq, wv, lds, lod); }
        PHM(13) PHASE(pb + 11) DUPK(13) { PMARK(13); SEAM(pb + 11);
            pg8::Gemm g{(const bf16_t*)(ws + OFF_U + U_MIX_O), (const bf16_t*)(ws + OFF_WOUTO + pr * SZ_WOUT), 1024, 1024}; pg8::StaticOrder S; S.init(pr == 1 ? MLAT / 256 : NM, 4, G, c);
            pg8::EpiBf16S E{(bf16_t*)(ws + OFF_EOUT), 1024, 4, nullptr, 1.0f}; pg8::gemm_phase<2>(lds, g, S, E, wv);
            { int rk, ni; if (pr == 0 && tail_share(NM * 4, G, c, rk, ni)) conv_units(p, lds, opaque_tid(wv), CV_NU_PRO + TAIL_U_SPLIT, CV_NU_PRO + CV_NU_E / 2, rk, ni); } }
        PHM(14) PHASE(pb + 12) DUPK(14) { PMARK(14); SEAM(pb + 12); phase_rowB<true>(pq, wv, lds, lod, (const bf16_t*)(ws + OFF_EOUT), pr == 1 ? MLAT : MTOT, DUP_DUMMY(14)); }
        PHM(16) PHASE(pb + 13) DUPK(16) { PMARK(16); SEAM(pb + 13);
            const MoeLayout L = moe_layout(pq, lod);
            pg8::Gemm g{ws + OFF_GBUF, ws + OFF_WEGU + (size_t)pr * 8 * (SZ_WEGU / 2), 1024, 1024};
            pg8::MoeOrder S; S.gatherA = true; S.so.init(L.tstart[8], 2 * FFE / 256, G, c);
#pragma unroll
            for (int e = 0; e < 9; ++e) S.ts[e] = L.tstart[e];
            pg8::EpiSwiGLU<FFN_DOWN_FP8 != 0> E{ws + OFF_U, FFE, 2 * FFE / 256, (const float*)(ws + OFF_GWT), (const float*)(ws + OFF_WSCE) + (size_t)pr * 8 * 2 * FFE}; pg8::gemm_phase<3>(lds, g, S, E, wv); }
        PHM(17) PHASE(pb + 14) DUPK(17) { PMARK(17); SEAM(pb + 14);
            const MoeLayout L = moe_layout(pq, lod);
            pg8::Gemm g{ws + OFF_U, ws + OFF_WEDN + (size_t)pr * 8 * (SZ_WEDN / (FFN_DOWN_FP8 ? 2 : 1)), FFE, FFE};
            pg8::MoeOrder S; S.gatherA = false; S.so.init(L.tstart[8], 4, G, c);
#pragma unroll
            for (int e = 0; e < 9; ++e) S.ts[e] = L.tstart[e];
            pg8::EpiBf16S E{(bf16_t*)(ws + OFF_EOUT), 1024, 4, (const float*)(ws + OFF_TWT), FFN_DOWN_FP8 ? 1.0f / W8_SCALE : 1.0f}; pg8::gemm_phase<FFN_DOWN_FP8 ? 1 : 2>(lds, g, S, E, wv);
            { int rk, ni; if (pr == 0 && tail_share(4 * L.tstart[8], G, c, rk, ni)) conv_units(p, lds, opaque_tid(wv), CV_NU_PRO + CV_NU_E / 2, CV_NU_PRO + CV_NU_E / 2 + TAIL_U_SPLIT, rk, ni); } }
        PHM(18) PHASE(pb + 15) DUPK(18) { PMARK(18); SEAM(pb + 15); phase_rowC<true>(pq, wv, lod, nullptr, pr == 1, DUP_DUMMY(18)); }
    }
#undef PHASE
#undef SEAM
}

extern "C" void kernel_launch(void* const* d_in, const int* in_sizes, int n_in, void* d_out, int out_size, void* d_ws, size_t ws_size, hipStream_t stream) {
    static int grid = 0;
    if (grid == 0) {
        if (n_in != 24 || out_size != MLAT * DM || ws_size < WS_END + (DUP_MASK != 0u ? (size_t)MTOT * DM * 6 : (size_t)0)) { fprintf(stderr, "kernel_launch: unexpected shapes (n_in %d, out %d, ws %zu, need %zu)\n", n_in, out_size, ws_size, (size_t)WS_END); grid = -1; return; }
        int dev = 0, cus = 0, per_cu = 0;
        if (hipGetDevice(&dev) != hipSuccess || hipDeviceGetAttribute(&cus, hipDeviceAttributeMultiprocessorCount, dev) != hipSuccess) { grid = -1; return; }
        if (hipFuncSetAttribute((const void*)fwd, hipFuncAttributeMaxDynamicSharedMemorySize, LDS_BYTES) != hipSuccess) { fprintf(stderr, "kernel_launch: hipFuncSetAttribute failed\n"); grid = -1; return; }
        if (hipOccupancyMaxActiveBlocksPerMultiprocessor(&per_cu, (const void*)fwd, NTHREADS, LDS_BYTES) != hipSuccess || per_cu < 1) { fprintf(stderr, "kernel_launch: occupancy query says %d\n", per_cu); grid = -1; return; }
        grid = cus < 256 ? cus : 256;
        if (grid != 256) fprintf(stderr, "kernel_launch: %d CUs; the row-wise phases assume 256 workgroups\n", cus);
    }
    if (grid != 256) return;
    Params p{};
    for (int i = 0; i < 24; ++i) p.in[i] = (const float*)d_in[i];
    p.out = (float*)d_out; p.ws = (unsigned char*)d_ws;
    hipMemsetAsync((char*)d_ws + OFF_CTL, 0, CTL_BYTES, stream);
#if MK_MULTI_LAUNCH
    for (int ph = 0; ph < NPHASES; ++ph) hipLaunchKernelGGL(fwd, dim3(grid), dim3(NTHREADS), LDS_BYTES, stream, p, ph, ph + 1);
#else
    hipLaunchKernelGGL(fwd, dim3(grid), dim3(NTHREADS), LDS_BYTES, stream, p, 0, NPHASES);
#endif
}
```

```cpp
#include <hip/hip_runtime.h>
#include <cstdio>
#include <cstdint>
#include <cstddef>

#ifndef FFN_DOWN_FP8
#define FFN_DOWN_FP8 1
#endif
#ifndef MK_MULTI_LAUNCH
#define MK_MULTI_LAUNCH 0
#endif

#define LAS __attribute__((address_space(3)))
typedef unsigned short bf16_t;
typedef short bf16x8 __attribute__((ext_vector_type(8)));
typedef short s16x4 __attribute__((ext_vector_type(4)));
typedef float f32x4 __attribute__((ext_vector_type(4)));
typedef float f32x2 __attribute__((ext_vector_type(2)));
typedef float f32x16 __attribute__((ext_vector_type(16)));
typedef unsigned u32x4 __attribute__((ext_vector_type(4)));
typedef unsigned u32x2 __attribute__((ext_vector_type(2)));

constexpr int DM = 1024, NB = 8, SEQ = 4096, CTXL = 256;
constexpr int MLAT = NB * SEQ, MCTX = NB * CTXL, MTOT = MLAT + MCTX;
constexpr int EVEN_IN = 2304, ODD_INP = 2048  , FFD = 2816, FFE = 3584, NEXP = 8;
constexpr int MG_ROWS = 2 * MTOT + NEXP * 256;
constexpr float EPSN = 1e-6f;
constexpr float LOG2E = 1.4426950408889634f;
constexpr int NTHREADS = 512, NWAVES = 8;
constexpr int LDS_BYTES = 147456;
constexpr int ROWS_PER_BLOCK = MTOT / 256;

constexpr size_t al256(size_t x) { return (x + 255) & ~(size_t)255; }
constexpr size_t OFF_CTL   = 0;
constexpr size_t CTL_BYTES = 65536;
constexpr size_t OFF_MOD   = OFF_CTL + CTL_BYTES;
constexpr size_t OFF_TAB   = al256(OFF_MOD + (size_t)4 * 9 * 6144 * 4);
constexpr size_t OFF_SLOT  = al256(OFF_TAB + 16384);
constexpr size_t OFF_TOK   = al256(OFF_SLOT + (size_t)MTOT * 16);
constexpr size_t OFF_TWT   = al256(OFF_TOK + (size_t)NEXP * MTOT * 4);
constexpr size_t OFF_GWT   = al256(OFF_TWT + (size_t)NEXP * MTOT * 4);
constexpr size_t OFF_GSC   = al256(OFF_GWT + (size_t)NEXP * MTOT * 4);
constexpr size_t OFF_FSC   = al256(OFF_GSC + (size_t)MG_ROWS * 4);
constexpr size_t OFF_WSCD  = al256(OFF_FSC + (size_t)MTOT * 4);
constexpr size_t OFF_WSCE  = al256(OFF_WSCD + (size_t)2 * 2 * FFD * 4);
constexpr size_t OFF_WSCI  = al256(OFF_WSCE + (size_t)16 * 2 * FFE * 4);
constexpr size_t OFF_WINE  = al256(OFF_WSCI + (size_t)(2 * EVEN_IN + 2 * ODD_INP) * 4);
constexpr size_t SZ_WINE   = (size_t)EVEN_IN * 1024 * 2;
constexpr size_t OFF_WOUTE = OFF_WINE + 2 * SZ_WINE;
constexpr size_t SZ_WOUT   = (size_t)1024 * 1024 * 2;
constexpr size_t OFF_WINO  = OFF_WOUTE + 2 * SZ_WOUT;
constexpr size_t SZ_WINO   = (size_t)ODD_INP * 1024 * 2;
constexpr size_t OFF_WQUP  = OFF_WINO + 2 * SZ_WINO;
constexpr size_t SZ_WQUP   = (size_t)768 * 256 * 2;
constexpr size_t OFF_WKVUP = OFF_WQUP + 2 * SZ_WQUP;
constexpr size_t SZ_WKVUP  = (size_t)1024 * 256 * 2;
constexpr size_t OFF_WOUTO = OFF_WKVUP + 2 * SZ_WKVUP;
constexpr size_t OFF_WGU   = OFF_WOUTO + 2 * SZ_WOUT;
constexpr size_t SZ_WGU    = (size_t)2 * FFD * 1024 * 2;
constexpr size_t OFF_WDN   = OFF_WGU + 2 * SZ_WGU;
constexpr size_t SZ_WDN    = (size_t)1024 * FFD * 2;
constexpr size_t OFF_WEGU  = OFF_WDN + 2 * SZ_WDN;
constexpr size_t SZ_WEGU   = (size_t)2 * FFE * 1024 * 2;
constexpr size_t OFF_WEDN  = OFF_WEGU + 16 * SZ_WEGU;
constexpr size_t SZ_WEDN   = (size_t)1024 * FFE * 2;
constexpr size_t OFF_XS    = al256(OFF_WEDN + 16 * SZ_WEDN);
constexpr size_t OFF_ABUF  = OFF_XS + (size_t)MTOT * 1024 * 4;
constexpr size_t OFF_U     = OFF_ABUF + (size_t)MTOT * 1024 * 2;
constexpr size_t SZ_U      = (size_t)MG_ROWS * FFE * 2;
constexpr size_t U_P_E   = 0;
constexpr size_t U_MIX_E = U_P_E + (size_t)MTOT * EVEN_IN * 2;
constexpr size_t U_Y_E   = U_MIX_E + (size_t)MTOT * 1024 * 2;
constexpr size_t U_ACT_E = 0;
constexpr size_t U_P_O   = 0;
constexpr size_t U_NRM_O = U_P_O + (size_t)MTOT * ODD_INP * 2;
constexpr size_t U_KVN_O = U_NRM_O + (size_t)MTOT * 256 * 2;
constexpr size_t U_SSQ_O = U_NRM_O;
constexpr size_t U_QF_O  = U_KVN_O + (size_t)MTOT * 256 * 2;
constexpr size_t U_KVF_O = U_QF_O + (size_t)MTOT * 768 * 2;
constexpr size_t U_MIX_O = U_KVF_O + (size_t)MTOT * 1024 * 2;
static_assert(U_MIX_O + (size_t)MTOT * 1024 * 2 <= SZ_U, "odd-layer map fits the union region");
static_assert(U_Y_E + (size_t)MTOT * 1024 * 4 <= SZ_U, "even-layer map fits the union region");
static_assert((size_t)MTOT * FFD * 2 <= U_Y_E, "dense act must not overlap F");
constexpr int    CAPR      = MTOT;
constexpr size_t OFF_GBUF  = OFF_U + SZ_U;
constexpr size_t OFF_EOUT  = OFF_GBUF + (size_t)NEXP * CAPR * 1024;
constexpr size_t WS_END    = OFF_EOUT + (size_t)MG_ROWS * 1024 * 2;

constexpr int CW_MOECNT = 4096;

struct Params { const float* in[24]; float* out; unsigned char* ws; };

__device__ __forceinline__ unsigned pk_bf16(float lo, float hi) { typedef __bf16 b2 __attribute__((ext_vector_type(2))); f32x2 v = {lo, hi}; b2 b = __builtin_convertvector(v, b2); return __builtin_bit_cast(unsigned, b); }
__device__ __forceinline__ float bf_lo(unsigned w) { return __uint_as_float(w << 16); }
__device__ __forceinline__ float bf_hi(unsigned w) { return __uint_as_float(w & 0xffff0000u); }
__device__ __forceinline__ float clamp448(float x) { return __builtin_fminf(__builtin_fmaxf(x, -448.0f), 448.0f); }
__device__ __forceinline__ unsigned pk_fp8x4(float a, float b, float c, float d) {
    int v = __builtin_amdgcn_cvt_pk_fp8_f32(clamp448(a), clamp448(b), 0, false); v = __builtin_amdgcn_cvt_pk_fp8_f32(clamp448(c), clamp448(d), v, true); return (unsigned)v; }
__device__ __forceinline__ unsigned pk_i8x4(float a, float b, float c, float d) {
    const int ia = (int)__builtin_rintf(a), ib = (int)__builtin_rintf(b), ic = (int)__builtin_rintf(c), id = (int)__builtin_rintf(d);
    return (unsigned)(ia & 0xff) | ((unsigned)(ib & 0xff) << 8) | ((unsigned)(ic & 0xff) << 16) | ((unsigned)id << 24); }
template <int CTRL> __device__ __forceinline__ float dppf(float v) { return __builtin_bit_cast(float, __builtin_amdgcn_update_dpp(0, __builtin_bit_cast(int, v), CTRL, 0xF, 0xF, true)); }
__device__ __forceinline__ float wave_max(float v) {
    v = fmaxf(v, dppf<0xB1>(v)); v = fmaxf(v, dppf<0x4E>(v)); v = fmaxf(v, dppf<0x141>(v)); v = fmaxf(v, dppf<0x140>(v));
    { const auto rr = __builtin_amdgcn_permlane16_swap(__float_as_uint(v), __float_as_uint(v), false, false); v = fmaxf(__uint_as_float(rr[0]), __uint_as_float(rr[1])); }
    { const auto rr = __builtin_amdgcn_permlane32_swap(__float_as_uint(v), __float_as_uint(v), false, false); v = fmaxf(__uint_as_float(rr[0]), __uint_as_float(rr[1])); }
    return v; }
__device__ __forceinline__ float wave_sum(float v) {
    v += dppf<0xB1>(v); v += dppf<0x4E>(v); v += dppf<0x141>(v); v += dppf<0x140>(v);
    { const auto rr = __builtin_amdgcn_permlane16_swap(__float_as_uint(v), __float_as_uint(v), false, false); v = __uint_as_float(rr[0]) + __uint_as_float(rr[1]); }
    { const auto rr = __builtin_amdgcn_permlane32_swap(__float_as_uint(v), __float_as_uint(v), false, false); v = __uint_as_float(rr[0]) + __uint_as_float(rr[1]); }
    return v; }
__device__ __forceinline__ float fast_exp2(float x) { return __builtin_amdgcn_exp2f(x); }
__device__ __forceinline__ float fast_rcp(float x) { return __builtin_amdgcn_rcpf(x); }
__device__ __forceinline__ float silu_f(float g) { return g * fast_rcp(1.0f + fast_exp2(-g * LOG2E)); }
__device__ __forceinline__ int lane_id() { int l; asm volatile("v_mbcnt_lo_u32_b32 %0, -1, 0\n\tv_mbcnt_hi_u32_b32 %0, -1, %0" : "=v"(l)); return l; }
__device__ __forceinline__ int opaque_tid(int wv) { int t = (wv << 6) | lane_id(); asm volatile("" : "+v"(t)); return t; }
__device__ __forceinline__ int crow(int r, int hi) { return (r & 3) + 8 * (r >> 2) + 4 * hi; }

#define XB_TMO      128
#define XB_XCNT(j)  (256  + 64 * (j))
#define XB_XSUB(j)  (1280 + 64 * (j))
#define XB_XGEN(j)  (2304 + 64 * (j))
#define XB_TOP      3328
#define XB_TOPGEN   3392
#define XCD_BAR_WORDS 3456
#define XB_SPIN_CAP (1u << 22)
__device__ __forceinline__ unsigned xb_ld(unsigned* p)              { return __hip_atomic_load(p, __ATOMIC_RELAXED, __HIP_MEMORY_SCOPE_AGENT); }
__device__ __forceinline__ unsigned xb_add(unsigned* p, unsigned v) { return __hip_atomic_fetch_add(p, v, __ATOMIC_RELAXED, __HIP_MEMORY_SCOPE_AGENT); }
__device__ __forceinline__ unsigned xb_xcc_id() { return (unsigned)__builtin_amdgcn_s_getreg((3 << 11) | 20) & 0xFu; }
#define XB_SPIN(cond, bar) do { unsigned _sp = 0; while (cond) { __builtin_amdgcn_s_sleep(1); \
    if ((++_sp & 255u) == 0u) { if (xb_ld(&(bar)[XB_TMO])) break; if (_sp > XB_SPIN_CAP) { atomicAdd(&(bar)[XB_TMO], 1u); break; } } } } while (0)
struct XcdBarrier { unsigned* bar; unsigned x; volatile LAS unsigned* st; int wv; };
__device__ __forceinline__ XcdBarrier xcd_barrier_post(unsigned* bar, volatile LAS unsigned* st, int wv) {
    XcdBarrier b; b.bar = bar; b.x = xb_xcc_id(); b.st = st; b.wv = wv;
    if (wv == 0 && lane_id() == 0) (void)xb_add(&bar[XB_XCNT(b.x)], 1u);
    return b;
}
__device__ __forceinline__ void xcd_barrier_complete(unsigned* bar, unsigned x, unsigned& nloc, unsigned& nx) {
    const unsigned G = gridDim.x * gridDim.y * gridDim.z;
    unsigned sum, cnt, mine, sp = 0u;
    for (;;) {
        sum = 0u; cnt = 0u; mine = 0u;
#pragma unroll
        for (unsigned j = 0; j < 16; ++j) { const unsigned c = xb_ld(&bar[XB_XCNT(j)]); sum += c; cnt += (c > 0u) ? 1u : 0u; mine = (j == x) ? c : mine; }
        if (sum == G) break;
        __builtin_amdgcn_s_sleep(1);
        if ((++sp & 255u) == 0u) { if (xb_ld(&bar[XB_TMO])) break; if (sp > XB_SPIN_CAP) { atomicAdd(&bar[XB_TMO], 1u); break; } }
    }
    nloc = mine > 0u ? mine : 1u; nx = cnt > 0u ? cnt : 1u;
}
__device__ __forceinline__ void xcd_barrier(const XcdBarrier& b) {
    asm volatile("s_waitcnt vmcnt(0)" ::: "memory");
    __syncthreads();
    if (b.wv == 0 && lane_id() == 0) {
        unsigned* bar = b.bar;
        __builtin_amdgcn_s_waitcnt(0);
        unsigned nloc = b.st[0], nx = b.st[1];
        if (nloc == 0u) { xcd_barrier_complete(bar, b.x, nloc, nx); b.st[0] = nloc; b.st[1] = nx; }
        const unsigned old = xb_add(&bar[XB_XSUB(b.x)], 1u);
        const unsigned gen = old / nloc;
        if (old + 1u == (gen + 1u) * nloc) {
            __builtin_amdgcn_fence(__ATOMIC_RELEASE, "agent");
            asm volatile("s_waitcnt vmcnt(0)" ::: "memory");
            const unsigned og = xb_add(&bar[XB_TOP], 1u);
            const unsigned tg = og / nx;
            if (og + 1u == (tg + 1u) * nx) xb_add(&bar[XB_TOPGEN], 1u);
            else XB_SPIN(xb_ld(&bar[XB_TOPGEN]) == tg, bar);
            __builtin_amdgcn_fence(__ATOMIC_ACQUIRE, "agent");
            xb_add(&bar[XB_XGEN(b.x)], 1u);
            asm volatile("s_waitcnt vmcnt(0)" ::: "memory");
        } else {
            XB_SPIN(xb_ld(&bar[XB_XGEN(b.x)]) == gen, bar);
            __builtin_amdgcn_fence(__ATOMIC_ACQUIRE, "agent");
            asm volatile("s_waitcnt vmcnt(0)" ::: "memory");
        }
    }
    __syncthreads();
}

namespace pg8 {
constexpr int BM = 256, BK = 64, HALF = 128, HTB = HALF * BK * 2, STAGE_BYTES = 8 * HTB, NXCD = 8, WGM = 8;
__host__ __device__ __forceinline__ int lds_byte(int r, int c) { const int st = (r >> 4) * 2 + (c >> 5), rr = r & 15, cc = c & 31, ob = rr * 64 + cc * 2; return st * 1024 + (ob ^ (((ob >> 9) & 1) << 5)); }
__host__ __device__ __forceinline__ void stage_rc(int b, int& R, int& C) { const int st = b / 1024, sb = b % 1024, swz = sb ^ (((sb >> 9) & 1) << 5); R = (st >> 1) * 16 + swz / 64; C = (st & 1) * 32 + (swz % 64) / 2; }
__host__ __device__ __forceinline__ int perm32(int rho) { const int n = rho >> 4, i = rho & 15; return 8 * (i >> 2) + 4 * n + (i & 3); }
typedef int v8i32 __attribute__((ext_vector_type(8))); typedef int v4i32 __attribute__((ext_vector_type(4)));
__device__ __forceinline__ v8i32 cat8(bf16x8 a, bf16x8 b) { const v4i32 x = __builtin_bit_cast(v4i32, a), y = __builtin_bit_cast(v4i32, b); return (v8i32){x[0], x[1], x[2], x[3], y[0], y[1], y[2], y[3]}; }
struct Unit { int pm, pn, pa, ro; };
struct Gemm { const void* A; const void* Bt; int lda, K; };
struct StaticOrder {
    int nM, nN, nwg, G, c;
    __device__ void init(int nM_, int nN_, int G_, int c_) { nM = nM_; nN = nN_; nwg = nM * nN; G = G_; c = c_; }
    __device__ __forceinline__ bool next(int i, Unit& u) const {
        const long L = (long)i * G + c; if (L >= nwg) return false;
        int wgid = (int)L; { const int q = nwg / NXCD, r = nwg % NXCD, xcd = wgid % NXCD, off = wgid / NXCD; wgid = (xcd < r ? xcd * (q + 1) : r * (q + 1) + (xcd - r) * q) + off; }
        const int nig = WGM * nN, gid = wgid / nig, fm = gid * WGM, gsz = (nM - fm) < WGM ? (nM - fm) : WGM;
        u.pm = fm + ((wgid % nig) % gsz); u.pn = (wgid % nig) / gsz; u.pa = u.pm; u.ro = 0; return true;
    }
};
struct MoeOrder {
    StaticOrder so; int ts[9]; bool gatherA;
    __device__ __forceinline__ bool next(int i, Unit& u) const {
        if (!so.next(i, u)) return false;
        int e = 0;
#pragma unroll
        for (int j = 1; j < 8; ++j) e += (u.pm >= ts[j]) ? 1 : 0;
        int te = 0;
#pragma unroll
        for (int j = 0; j < 8; ++j) te = (j == e) ? ts[j] : te;
        u.pn += e * so.nN; u.pa = gatherA ? e * (CAPR / 256) + (u.pm - te) : u.pm; u.ro = e * MTOT - te * 256; return true;
    }
};

template <int FMT, class Epi, class Sched>
__device__ __forceinline__ void gemm_phase(LAS unsigned char* lds, const Gemm g, const Sched& S, const Epi& E, const int wv) {
    const int tid = opaque_tid(wv), wid = __builtin_amdgcn_readfirstlane(tid >> 6), lane = tid & 63, wr = wid >> 2, wc = wid & 3, fr = lane & 15, fq = lane >> 4;
    constexpr int ESZ = FMT == 2 ? 2 : 1;
    int K_ = g.K, lda_ = g.lda; asm volatile("" : "+s"(K_), "+s"(lda_));
    const int K = K_ * ESZ, nt = K / (BK * 2), lda = lda_ * ESZ;
    unsigned voffA[2], voffB[2];
#pragma unroll
    for (int i = 0; i < 2; ++i) { int R, C; stage_rc(tid * 16 + i * 8192, R, C); const int Rb = Epi::PERM ? ((R & ~31) + perm32(R & 31)) : R;
        voffA[i] = (unsigned)(R * lda + C * 2); voffB[i] = (unsigned)(Rb * K + C * 2); }
    const size_t kstep = (size_t)(BK * 2);
    const size_t hstepA = (size_t)HALF * lda, hstepB = (size_t)HALF * K;
    const size_t tstepA = 2 * hstepA, tstepB = 2 * hstepB;
    const unsigned ldsw = (unsigned)wid * 1024u;
    const int aoff = lds_byte(wr * 64 + fr, fq * 8), boff = lds_byte(wc * 32 + fr, fq * 8);
#define PG8_SA(b, h) (((b) * 2 + (h)) * HTB)
#define PG8_SB(b, h) ((4 + (b) * 2 + (h)) * HTB)
#define PG8_STAGE(bufoff, gbase, voff) do { _Pragma("unroll") for (int _i = 0; _i < 2; ++_i) \
        __builtin_amdgcn_global_load_lds((const unsigned*)((const char*)(gbase) + (voff)[_i]), (LAS unsigned*)(lds + (bufoff) + ldsw + _i * 8192), 16, 0, 0); } while (0)
#define PG8_LD8(addr) __builtin_shufflevector(*(const LAS v4i32*)(addr), *(const LAS v4i32*)((addr) + 1024), 0, 1, 2, 3, 4, 5, 6, 7)
#define PG8_LDA(dst, b, h) do { _Pragma("unroll") for (int m = 0; m < 4; ++m) dst[m] = PG8_LD8(lds + PG8_SA(b, h) + aoff + m * 2048); } while (0)
#define PG8_LDB(dst, b, h) do { _Pragma("unroll") for (int n = 0; n < 2; ++n) dst[n] = PG8_LD8(lds + PG8_SB(b, h) + boff + n * 2048); } while (0)
#define PG8_LO(v) __builtin_bit_cast(bf16x8, __builtin_shufflevector(v, v, 0, 1, 2, 3))
#define PG8_HI(v) __builtin_bit_cast(bf16x8, __builtin_shufflevector(v, v, 4, 5, 6, 7))
#define PG8_MMA(ai, bj, At, Bt) do { __builtin_amdgcn_s_setprio(1); \
        if constexpr (FMT == 3) { _Pragma("unroll") for (int m = 0; m < 4; ++m) _Pragma("unroll") for (int n = 0; n < 2; ++n) { \
            v4i32 c_ = __builtin_bit_cast(v4i32, acc[ai][bj][m][n]); \
            c_ = __builtin_amdgcn_mfma_i32_16x16x64_i8(__builtin_shufflevector(Bt[n], Bt[n], 0, 1, 2, 3), __builtin_shufflevector(At[m], At[m], 0, 1, 2, 3), c_, 0, 0, 0); \
            c_ = __builtin_amdgcn_mfma_i32_16x16x64_i8(__builtin_shufflevector(Bt[n], Bt[n], 4, 5, 6, 7), __builtin_shufflevector(At[m], At[m], 4, 5, 6, 7), c_, 0, 0, 0); \
            acc[ai][bj][m][n] = __builtin_bit_cast(f32x4, c_); } } \
        else if constexpr (FMT == 2) { _Pragma("unroll") for (int m = 0; m < 4; ++m) _Pragma("unroll") for (int n = 0; n < 2; ++n) { \
            acc[ai][bj][m][n] = __builtin_amdgcn_mfma_f32_16x16x32_bf16(PG8_LO(Bt[n]), PG8_LO(At[m]), acc[ai][bj][m][n], 0, 0, 0); \
            acc[ai][bj][m][n] = __builtin_amdgcn_mfma_f32_16x16x32_bf16(PG8_HI(Bt[n]), PG8_HI(At[m]), acc[ai][bj][m][n], 0, 0, 0); } } \
        else { asm volatile("s_nop 1\n\t" \
            "v_mfma_f32_16x16x128_f8f6f4 %0, %8, %10, %0\n\t" "v_mfma_f32_16x16x128_f8f6f4 %1, %9, %10, %1\n\t" \
            "v_mfma_f32_16x16x128_f8f6f4 %2, %8, %11, %2\n\t" "v_mfma_f32_16x16x128_f8f6f4 %3, %9, %11, %3\n\t" \
            "v_mfma_f32_16x16x128_f8f6f4 %4, %8, %12, %4\n\t" "v_mfma_f32_16x16x128_f8f6f4 %5, %9, %12, %5\n\t" \
            "v_mfma_f32_16x16x128_f8f6f4 %6, %8, %13, %6\n\t" "v_mfma_f32_16x16x128_f8f6f4 %7, %9, %13, %7\n\t" \
            "s_nop 11" \
            : "+v"(acc[ai][bj][0][0]), "+v"(acc[ai][bj][0][1]), "+v"(acc[ai][bj][1][0]), "+v"(acc[ai][bj][1][1]), "+v"(acc[ai][bj][2][0]), "+v"(acc[ai][bj][2][1]), "+v"(acc[ai][bj][3][0]), "+v"(acc[ai][bj][3][1]) \
            : "v"(Bt[0]), "v"(Bt[1]), "v"(At[0]), "v"(At[1]), "v"(At[2]), "v"(At[3]), "v"(scl8)); } \
        __builtin_amdgcn_s_setprio(0); } while (0)
#define PG8_WAIT_V(n) asm volatile("s_waitcnt vmcnt(" #n ")" ::: "memory")
#define PG8_WAIT_L(n) asm volatile("s_waitcnt lgkmcnt(" #n ")" ::: "memory")
#define PG8_BAR __builtin_amdgcn_s_barrier()
#define PG8_SCHED __builtin_amdgcn_sched_barrier(0)
    Unit cur, nxt; int ui = 0;
    if (!S.next(0, cur)) return;
    f32x4 acc[2][2][4][2];
#pragma unroll
    for (int a = 0; a < 2; ++a)
#pragma unroll
        for (int b = 0; b < 2; ++b)
#pragma unroll
            for (int m = 0; m < 4; ++m)
#pragma unroll
                for (int n = 0; n < 2; ++n) acc[a][b][m][n] = (f32x4){0.f, 0.f, 0.f, 0.f};
    v8i32 At[4], B0[2], B1[2];
    const int scl8 = 0x7F7F7F7F;
    const char* cA = (const char*)g.A + (size_t)cur.pa * tstepA; const char* cB = (const char*)g.Bt + (size_t)cur.pn * tstepB;
    PG8_STAGE(PG8_SB(0, 0), cB, voffB); PG8_STAGE(PG8_SB(0, 1), cB + hstepB, voffB); PG8_STAGE(PG8_SA(0, 0), cA, voffA); PG8_STAGE(PG8_SA(0, 1), cA + hstepA, voffA);
    if (wr == 1) PG8_BAR;
    PG8_WAIT_V(2); PG8_BAR;
    PG8_STAGE(PG8_SB(1, 0), cB + kstep, voffB); PG8_STAGE(PG8_SA(1, 0), cA + kstep, voffA); PG8_STAGE(PG8_SB(1, 1), cB + hstepB + kstep, voffB);
    PG8_WAIT_V(6); PG8_BAR;
    for (;;) {
        const bool has_next = S.next(ui + 1, nxt);
        const char* nA = has_next ? (const char*)g.A + (size_t)nxt.pa * tstepA : cA; const char* nB = has_next ? (const char*)g.Bt + (size_t)nxt.pn * tstepB : cB;
#pragma unroll 1
        for (int t = 0; t < nt; t += 2) {
            const bool last = (t == nt - 2);
            const char* a1 = cA + (size_t)(t + 1) * kstep;
            const char* a2 = last ? nA : cA + (size_t)(t + 2) * kstep; const char* b2 = last ? nB : cB + (size_t)(t + 2) * kstep;
            const char* a3 = a2 + kstep; const char* b3 = b2 + kstep;
            PG8_LDB(B0, 0, 0); PG8_LDB(B1, 0, 1); PG8_SCHED; PG8_LDA(At, 0, 0); PG8_STAGE(PG8_SA(1, 1), a1 + hstepA, voffA);
            PG8_WAIT_V(8); PG8_WAIT_L(0); PG8_BAR; PG8_MMA(0, 0, At, B0); PG8_MMA(0, 1, At, B1); PG8_BAR; PG8_SCHED;
            PG8_LDA(At, 0, 1); PG8_STAGE(PG8_SB(0, 0), b2, voffB); PG8_STAGE(PG8_SB(0, 1), b2 + hstepB, voffB); PG8_STAGE(PG8_SA(0, 0), a2, voffA);
            PG8_WAIT_V(8); PG8_WAIT_L(0); PG8_BAR; PG8_MMA(1, 0, At, B0); PG8_MMA(1, 1, At, B1); PG8_BAR; PG8_SCHED;
            PG8_LDB(B0, 1, 0); PG8_LDB(B1, 1, 1); PG8_SCHED; PG8_LDA(At, 1, 0); PG8_STAGE(PG8_SA(0, 1), a2 + hstepA, voffA);
            PG8_WAIT_V(8); PG8_WAIT_L(0); PG8_BAR; PG8_MMA(0, 0, At, B0); PG8_MMA(0, 1, At, B1); PG8_BAR; PG8_SCHED;
            PG8_LDA(At, 1, 1); PG8_STAGE(PG8_SB(1, 0), b3, voffB); PG8_STAGE(PG8_SB(1, 1), b3 + hstepB, voffB); PG8_STAGE(PG8_SA(1, 0), a3, voffA);
            PG8_WAIT_V(8); PG8_WAIT_L(0); PG8_BAR; PG8_MMA(1, 0, At, B0); PG8_MMA(1, 1, At, B1); PG8_BAR; PG8_SCHED;
        }
        if (wr == 0) PG8_BAR;
        E(acc, cur, wr, wc, fr, fq);
        if (!has_next) break;
#pragma unroll
        for (int a = 0; a < 2; ++a)
#pragma unroll
            for (int b = 0; b < 2; ++b)
#pragma unroll
                for (int m = 0; m < 4; ++m)
#pragma unroll
                    for (int n = 0; n < 2; ++n) acc[a][b][m][n] = (f32x4){0.f, 0.f, 0.f, 0.f};
        cur = nxt; cA = nA; cB = nB; ++ui;
        if (wr == 1) PG8_BAR;
    }
    PG8_WAIT_V(0);
    PG8_BAR;
#undef PG8_SA
#undef PG8_SB
#undef PG8_STAGE
#undef PG8_LDA
#undef PG8_LD8
#undef PG8_LO
#undef PG8_HI
#undef PG8_LDB
#undef PG8_MMA
#undef PG8_WAIT_V
#undef PG8_WAIT_L
#undef PG8_BAR
#undef PG8_SCHED
}

struct EpiBf16S {
    static constexpr bool PERM = true;
    bf16_t* O; int ldc; int ncol_tiles; const float* rowscale; float scale;
    __device__ __forceinline__ void operator()(const f32x4 (&acc)[2][2][4][2], const Unit& u, int wr, int wc, int fr, int fq) const {
        const int row0 = u.pm * BM + wr * 64 + fr, col0 = (u.pn % ncol_tiles) * BM + wc * 32 + 8 * fq;
        float rsv[2][4];
#pragma unroll
        for (int ai = 0; ai < 2; ++ai)
#pragma unroll
            for (int m = 0; m < 4; ++m) rsv[ai][m] = rowscale ? rowscale[(ptrdiff_t)u.ro + row0 + ai * HALF + m * 16] * scale : scale;
#pragma unroll
        for (int ai = 0; ai < 2; ++ai)
#pragma unroll
            for (int m = 0; m < 4; ++m) { const int row = row0 + ai * HALF + m * 16; bf16_t* rowp = O + (size_t)row * ldc + col0; const float rs = rsv[ai][m];
#pragma unroll
                for (int bj = 0; bj < 2; ++bj) { const f32x4 v0 = acc[ai][bj][m][0] * rs, v1 = acc[ai][bj][m][1] * rs;
                    u32x4 w; w.x = pk_bf16(v0[0], v0[1]); w.y = pk_bf16(v0[2], v0[3]); w.z = pk_bf16(v1[0], v1[1]); w.w = pk_bf16(v1[2], v1[3]);
                    *(u32x4*)(rowp + bj * HALF) = w; } }
    }
};
struct EpiBf16 {
    static constexpr bool PERM = true;
    bf16_t* O; int ldc;
    __device__ __forceinline__ void operator()(const f32x4 (&acc)[2][2][4][2], const Unit& u, int wr, int wc, int fr, int fq) const {
        const int row0 = u.pm * BM + wr * 64 + fr, col0 = u.pn * BM + wc * 32 + 8 * fq;
#pragma unroll
        for (int ai = 0; ai < 2; ++ai)
#pragma unroll
            for (int m = 0; m < 4; ++m) { bf16_t* rowp = O + (size_t)(row0 + ai * HALF + m * 16) * ldc + col0;
#pragma unroll
                for (int bj = 0; bj < 2; ++bj) { const f32x4 v0 = acc[ai][bj][m][0], v1 = acc[ai][bj][m][1];
                    u32x4 w; w.x = pk_bf16(v0[0], v0[1]); w.y = pk_bf16(v0[2], v0[3]); w.z = pk_bf16(v1[0], v1[1]); w.w = pk_bf16(v1[2], v1[3]);
                    *(u32x4*)(rowp + bj * HALF) = w; } }
    }
};
template <int NS> struct EpiBf16N {
    static constexpr bool PERM = true;
    bf16_t* O; int ldc; const float* ssq; float invn;
    __device__ __forceinline__ void operator()(const f32x4 (&acc)[2][2][4][2], const Unit& u, int wr, int wc, int fr, int fq) const {
        const int row0 = u.pm * BM + wr * 64 + fr, col0 = u.pn * BM + wc * 32 + 8 * fq;
        float rsv[2][4];
#pragma unroll
        for (int ai = 0; ai < 2; ++ai)
#pragma unroll
            for (int m = 0; m < 4; ++m) { const float* sp = ssq + (size_t)(row0 + ai * HALF + m * 16) * 16; const f32x4 a = *(const f32x4*)sp; float t = (a[0] + a[1]) + (a[2] + a[3]);
                if (NS == 8) { const f32x4 b = *(const f32x4*)(sp + 4); t += (b[0] + b[1]) + (b[2] + b[3]); }
                rsv[ai][m] = rsqrtf(t * invn + EPSN); }
#pragma unroll
        for (int ai = 0; ai < 2; ++ai)
#pragma unroll
            for (int m = 0; m < 4; ++m) { bf16_t* rowp = O + (size_t)(row0 + ai * HALF + m * 16) * ldc + col0; const float rs = rsv[ai][m];
#pragma unroll
                for (int bj = 0; bj < 2; ++bj) { const f32x4 v0 = acc[ai][bj][m][0] * rs, v1 = acc[ai][bj][m][1] * rs;
                    u32x4 w; w.x = pk_bf16(v0[0], v0[1]); w.y = pk_bf16(v0[2], v0[3]); w.z = pk_bf16(v1[0], v1[1]); w.w = pk_bf16(v1[2], v1[3]);
                    *(u32x4*)(rowp + bj * HALF) = w; } }
    }
};
template <bool OUT8> struct EpiSwiGLU {
    static constexpr bool PERM = true;
    unsigned char* O; int ldc; int ncol_tiles; const float* rowscale; const float* colscale;
    __device__ __forceinline__ void operator()(const f32x4 (&acc)[2][2][4][2], const Unit& u, int wr, int wc, int fr, int fq) const {
        const int row0 = u.pm * BM + wr * 64 + fr, col0 = (u.pn % ncol_tiles) * HALF + wc * 32 + 8 * fq;
        const float cg = colscale[(size_t)u.pn * BM + wc * 32], cu = colscale[(size_t)u.pn * BM + HALF + wc * 32];
        const float cgl = cg * (-LOG2E), cgu = cg * cu;
        float rsv[2][4];
#pragma unroll
        for (int ai = 0; ai < 2; ++ai)
#pragma unroll
            for (int m = 0; m < 4; ++m) rsv[ai][m] = rowscale[(ptrdiff_t)u.ro + row0 + ai * HALF + m * 16];
#pragma unroll
        for (int ai = 0; ai < 2; ++ai)
#pragma unroll
            for (int m = 0; m < 4; ++m) { const int row = row0 + ai * HALF + m * 16; unsigned char* rowp = O + ((size_t)row * ldc + col0) * (OUT8 ? 1 : 2);
                const float rs = rsv[ai][m], kt = rs * cgl, iko = fast_rcp((rs * rs) * cgu);
                const v4i32 ig0 = __builtin_bit_cast(v4i32, acc[ai][0][m][0]), ig1 = __builtin_bit_cast(v4i32, acc[ai][0][m][1]), iu0 = __builtin_bit_cast(v4i32, acc[ai][1][m][0]), iu1 = __builtin_bit_cast(v4i32, acc[ai][1][m][1]);
                f32x2 g[4], uu[4], e[4], a[4];
#pragma unroll
                for (int k = 0; k < 2; ++k) { g[k] = (f32x2){(float)ig0[2 * k], (float)ig0[2 * k + 1]}; g[2 + k] = (f32x2){(float)ig1[2 * k], (float)ig1[2 * k + 1]}; uu[k] = (f32x2){(float)iu0[2 * k], (float)iu0[2 * k + 1]}; uu[2 + k] = (f32x2){(float)iu1[2 * k], (float)iu1[2 * k + 1]}; }
#pragma unroll
                for (int k = 0; k < 4; ++k) e[k] = g[k] * kt;
#pragma unroll
                for (int k = 0; k < 4; ++k) { e[k].x = fast_exp2(e[k].x); e[k].y = fast_exp2(e[k].y); }
#pragma unroll
                for (int k = 0; k < 4; ++k) a[k] = g[k] * uu[k];
#pragma unroll
                for (int k = 0; k < 4; ++k) e[k] = e[k] * iko + iko;
#pragma unroll
                for (int k = 0; k < 4; ++k) { e[k].x = fast_rcp(e[k].x); e[k].y = fast_rcp(e[k].y); }
#pragma unroll
                for (int k = 0; k < 4; ++k) a[k] = a[k] * e[k];
                if (OUT8) { u32x2 w; w.x = pk_fp8x4(a[0].x, a[0].y, a[1].x, a[1].y); w.y = pk_fp8x4(a[2].x, a[2].y, a[3].x, a[3].y); *(u32x2*)rowp = w; }
                else { u32x4 w; w.x = pk_bf16(a[0].x, a[0].y); w.y = pk_bf16(a[1].x, a[1].y); w.z = pk_bf16(a[2].x, a[2].y); w.w = pk_bf16(a[3].x, a[3].y); *(u32x4*)rowp = w; } }
    }
};
template <int MODE> struct EpiRope {
    static constexpr bool PERM = false;
    bf16_t* O; int ldc; const float* tab;
    const float* rowscale; const float* colscale;
    float* ssq;
    __device__ __forceinline__ static int kind(int gi) {
        if (MODE == 0) return (gi >= 48 && gi < 68) ? 1 + (gi & 1) : 0;
        if (MODE == 1) return gi == 12 ? 3 : ((gi >= 16 && gi < 48) ? 1 + (gi & 1) : 0);
        return (gi == 2 || gi == 5 || gi == 8 || gi == 11 || gi == 14 || gi == 17 || gi == 20 || gi == 23) ? 3 : 0;
    }
    __device__ __forceinline__ void operator()(const f32x4 (&acc)[2][2][4][2], const Unit& u, int wr, int wc, int fr, int fq) const {
        const int row0 = u.pm * BM + wr * 64 + fr;
        const bool lat = u.pm < (MLAT / BM);
        float rsv[2][4];
#pragma unroll
        for (int ai = 0; ai < 2; ++ai)
#pragma unroll
            for (int m = 0; m < 4; ++m) rsv[ai][m] = rowscale[(ptrdiff_t)u.ro + row0 + ai * HALF + m * 16];
#pragma unroll
        for (int bj = 0; bj < 2; ++bj) {
            const int gi = u.pn * 8 + bj * 4 + wc; const int kd = lat ? kind(gi) : 0;
            const int col0 = gi * 32 + 4 * fq;
            const f32x4 cs1 = *(const f32x4*)(colscale + col0), cs2 = *(const f32x4*)(colscale + col0 + 16);
#pragma unroll
            for (int ai = 0; ai < 2; ++ai)
#pragma unroll
                for (int m = 0; m < 4; ++m) {
                    const int row = row0 + ai * HALF + m * 16; bf16_t* rowp = O + (size_t)row * ldc + col0;
                    const float rsc = rsv[ai][m]; const v4i32 i1 = __builtin_bit_cast(v4i32, acc[ai][bj][m][0]), i2 = __builtin_bit_cast(v4i32, acc[ai][bj][m][1]);
                    f32x4 x1, x2;
#pragma unroll
                    for (int k = 0; k < 4; ++k) { x1[k] = (float)i1[k] * (rsc * cs1[k]); x2[k] = (float)i2[k] * (rsc * cs2[k]); }
                    if (kd != 0) {
                        const int s = row & (SEQ - 1), gr = s >> 6, gc = s & 63;
                        f32x4 cs, sn;
                        if (kd == 3) { const int pos = fq < 2 ? gr : gc; cs = *(const f32x4*)(tab + 2048 + pos * 8 + 4 * (fq & 1)); sn = *(const f32x4*)(tab + 2048 + 512 + pos * 8 + 4 * (fq & 1)); }
                        else { const int pos = kd == 1 ? gr : gc; cs = *(const f32x4*)(tab + pos * 16 + 4 * fq); sn = *(const f32x4*)(tab + 1024 + pos * 16 + 4 * fq); }
                        const f32x4 o1 = x1 * cs - x2 * sn, o2 = x2 * cs + x1 * sn; x1 = o1; x2 = o2;
                    }
                    u32x2 w0, w1; w0.x = pk_bf16(x1[0], x1[1]); w0.y = pk_bf16(x1[2], x1[3]); w1.x = pk_bf16(x2[0], x2[1]); w1.y = pk_bf16(x2[2], x2[3]);
                    if (MODE == 1 && (u.pn == 0 || (u.pn == 1 && bj == 0))) {
                        float ss = bf_lo(w0.x) * bf_lo(w0.x) + bf_hi(w0.x) * bf_hi(w0.x) + bf_lo(w0.y) * bf_lo(w0.y) + bf_hi(w0.y) * bf_hi(w0.y) + bf_lo(w1.x) * bf_lo(w1.x) + bf_hi(w1.x) * bf_hi(w1.x) + bf_lo(w1.y) * bf_lo(w1.y) + bf_hi(w1.y) * bf_hi(w1.y);
                        { const auto rr = __builtin_amdgcn_permlane16_swap(__float_as_uint(ss), __float_as_uint(ss), false, false); ss = __uint_as_float(rr[0]) + __uint_as_float(rr[1]); }
                        { const auto rr = __builtin_amdgcn_permlane32_swap(__float_as_uint(ss), __float_as_uint(ss), false, false); ss = __uint_as_float(rr[0]) + __uint_as_float(rr[1]); }
                        if (fq == 0) ssq[(size_t)row * 16 + (u.pn == 0 ? bj * 4 + wc : 8 + wc)] = ss;
                    }
                    { const auto r = __builtin_amdgcn_permlane16_swap(w0.x, w1.x, false, false); w0.x = r[0]; w1.x = r[1]; }
                    { const auto r = __builtin_amdgcn_permlane16_swap(w0.y, w1.y, false, false); w0.y = r[0]; w1.y = r[1]; }
                    *(u32x4*)(rowp + ((fq & 1) ? 12 : 0)) = (u32x4){w0.x, w0.y, w1.x, w1.y};
                    asm volatile("" ::: "memory");
                }
        }
    }
};
}

__device__ __forceinline__ unsigned char* fresh_ws() {
    static_assert(offsetof(Params, ws) == 200, "Params layout");
    unsigned long long w; const unsigned long long ka = (unsigned long long)__builtin_amdgcn_kernarg_segment_ptr();
    asm volatile("s_load_dwordx2 %0, %1, 0xc8\n\ts_waitcnt lgkmcnt(0)" : "=s"(w) : "s"(ka) : "memory");
    return (unsigned char*)(__attribute__((address_space(1))) unsigned char*)w;
}
__device__ __forceinline__ int rope_orig(int p) { return p < 8 ? p : (p < 16 ? 16 + (p - 8) : (p < 24 ? 8 + (p - 16) : p)); }

struct ConvJob { const float* src; bf16_t* dst; const float* scale; int Ksrc, Nsrc, Kdst, nb, kb, map, f8; };
constexpr float W8_SCALE = 64.0f;
constexpr int CJ_NMAT[10]  = {0, 2, 0, 2, 2, 2, 0, 2, 0, 16};
constexpr int CJ_NB[10]    = {18, 8, 16, 6, 8, 8, 44, 8, 56, 8};
constexpr int CJ_KB[10]    = {16, 16, 16, 4, 4, 16, 16, FFN_DOWN_FP8 ? 22 : 44, 16, FFN_DOWN_FP8 ? 28 : 56};
__device__ __forceinline__ int conv_tiles(int j) { return CJ_NMAT[j] * CJ_NB[j] * CJ_KB[j]; }
constexpr int conv_tiles_total() { int s = 0; for (int j = 0; j < 10; ++j) s += CJ_NMAT[j] * CJ_NB[j] * CJ_KB[j]; return s; }
__device__ __forceinline__ int conv_map(int map, int n) {
    switch (map) {
    case 0: return n;
    case 1:
        if (n < 256) return n; if (n < 384) return 768 + (n - 256); if (n < 416) return 896 + rope_orig(n - 384); if (n < 512) return -1;
        if (n < 1024) return 256 + (n - 512); if (n < 1536) return 928 + (n - 1024); return 1440 + (n - 1536);
    case 2: { const int h = n / 96, j = n % 96; return j < 64 ? n : h * 96 + 64 + rope_orig(j - 64); }
    case 3: { const int t = n >> 8, r = n & 255; return r < 128 ? t * 128 + r : FFD + t * 128 + (r - 128); }
    default: { const int t = n >> 8, r = n & 255; return r < 128 ? t * 128 + r : FFE + t * 128 + (r - 128); }
    }
}
__device__ __forceinline__ ConvJob conv_job(const Params& p, unsigned char* ws, int j, int mat) {
    ConvJob c; c.scale = nullptr; c.map = 0; c.nb = CJ_NB[j]; c.kb = CJ_KB[j]; c.f8 = FFN_DOWN_FP8 && (j == 7 || j == 9);
    switch (j) {
    case 0: c.src = p.in[7] + (size_t)mat * 1024 * EVEN_IN; c.dst = (bf16_t*)(ws + OFF_WINE + mat * SZ_WINE); c.Ksrc = 1024; c.Nsrc = EVEN_IN; c.Kdst = 1024; break;
    case 1: c.src = p.in[10] + (size_t)mat * 1024 * 1024; c.dst = (bf16_t*)(ws + OFF_WOUTE + mat * SZ_WOUT); c.Ksrc = 1024; c.Nsrc = 1024; c.Kdst = 1024; break;
    case 2: c.src = p.in[11] + (size_t)mat * 1024 * 1952; c.dst = (bf16_t*)(ws + OFF_WINO + mat * SZ_WINO); c.Ksrc = 1024; c.Nsrc = 1952; c.Kdst = 1024; c.map = 1; break;
    case 3: c.src = p.in[14] + (size_t)mat * 256 * 768; c.dst = (bf16_t*)(ws + OFF_WQUP + mat * SZ_WQUP); c.Ksrc = 256; c.Nsrc = 768; c.Kdst = 256; c.map = 2; c.scale = p.in[12] + mat * 256; break;
    case 4: c.src = p.in[15] + (size_t)mat * 128 * 1024; c.dst = (bf16_t*)(ws + OFF_WKVUP + mat * SZ_WKVUP); c.Ksrc = 128; c.Nsrc = 1024; c.Kdst = 256; c.scale = p.in[13] + mat * 128; break;
    case 5: c.src = p.in[18] + (size_t)mat * 1024 * 1024; c.dst = (bf16_t*)(ws + OFF_WOUTO + mat * SZ_WOUT); c.Ksrc = 1024; c.Nsrc = 1024; c.Kdst = 1024; break;
    case 6: c.src = p.in[19] + (size_t)mat * 1024 * 2 * FFD; c.dst = (bf16_t*)(ws + OFF_WGU + mat * SZ_WGU); c.Ksrc = 1024; c.Nsrc = 2 * FFD; c.Kdst = 1024; c.map = 3; break;
    case 7: c.src = p.in[20] + (size_t)mat * FFD * 1024; c.dst = (bf16_t*)(ws + OFF_WDN + mat * SZ_WDN); c.Ksrc = FFD; c.Nsrc = 1024; c.Kdst = FFD; break;
    case 8: c.src = p.in[22] + (size_t)mat * 1024 * 2 * FFE; c.dst = (bf16_t*)(ws + OFF_WEGU + mat * (SZ_WEGU / 2)); c.Ksrc = 1024; c.Nsrc = 2 * FFE; c.Kdst = 1024; c.map = 4; break;
    default: c.src = p.in[23] + (size_t)mat * FFE * 1024; c.dst = (bf16_t*)(ws + OFF_WEDN + mat * (SZ_WEDN / (FFN_DOWN_FP8 ? 2 : 1))); c.Ksrc = FFE; c.Nsrc = 1024; c.Kdst = FFE; break;
    }
    return c;
}

constexpr int CV_NU_D = 2 * (2 * FFD / 64), CV_NU_IE = 2 * (EVEN_IN / 64), CV_NU_IO = 2 * (ODD_INP / 64), CV_NU_E = 16 * (2 * FFE / 64), CV_NU_PRO = CV_NU_D + CV_NU_IE + CV_NU_IO, CV_NU = CV_NU_PRO + CV_NU_E;
constexpr int TAIL_U_SPLIT = 560, TAIL_T_SPLIT = 1100;
constexpr int CV_NT = conv_tiles_total(), CV_NT_E = CJ_NMAT[9] * CJ_NB[9] * CJ_KB[9], CV_NT_PRO = CV_NT - CV_NT_E;
__device__ __forceinline__ void conv_units(const Params& p, LAS unsigned char* lds, const int tid, int lo, int hi, int first, int stride) {
    unsigned char* ws = fresh_ws();
    __syncthreads();
    {
        constexpr int WP = 2052;
        LAS unsigned char* wl = lds;
        LAS float* cmx = (LAS float*)(lds + 64 * WP);
        constexpr int NU_D = CV_NU_D, NU_E = CV_NU_E, NU_IE = CV_NU_IE, NU_IO = CV_NU_IO;
        const int cq = tid & 15, rg = tid >> 4, wvn = tid >> 6, col = tid >> 3, piece = tid & 7;
        struct U8 { const float* sp; unsigned char* dst; float* wsc; int Nsrc, ok, blk; };
        auto decode = [&](int u) -> U8 {
            const int cat = u < NU_D ? 0 : (u < NU_D + NU_IE ? 2 : (u < NU_D + NU_IE + NU_IO ? 3 : 1));
            const int uu = u - (cat == 0 ? 0 : (cat == 2 ? NU_D : (cat == 3 ? NU_D + NU_IE : NU_D + NU_IE + NU_IO)));
            const int Ndst = cat == 0 ? 2 * FFD : (cat == 1 ? 2 * FFE : (cat == 2 ? EVEN_IN : ODD_INP)), nbp = Ndst / 64, mat = uu / nbp, nbi = uu % nbp;
            U8 U; U.Nsrc = cat == 3 ? 1952 : Ndst;
            const float* src = (cat == 0 ? p.in[19] : (cat == 1 ? p.in[22] : (cat == 2 ? p.in[7] : p.in[11]))) + (size_t)mat * 1024 * U.Nsrc;
            unsigned char* dstb = cat == 0 ? ws + OFF_WGU + (size_t)mat * SZ_WGU : (cat == 1 ? ws + OFF_WEGU + (size_t)mat * (SZ_WEGU / 2) : (cat == 2 ? ws + OFF_WINE + (size_t)mat * SZ_WINE : ws + OFF_WINO + (size_t)mat * SZ_WINO));
            float* wscb = (cat == 0 ? (float*)(ws + OFF_WSCD) : (cat == 1 ? (float*)(ws + OFF_WSCE) : (cat == 2 ? (float*)(ws + OFF_WSCI) : (float*)(ws + OFF_WSCI) + 2 * EVEN_IN))) + (size_t)mat * Ndst;
            const int cmap = cat == 0 ? 3 : (cat == 1 ? 4 : (cat == 2 ? 0 : 1));
            const int sc = conv_map(cmap, nbi * 64 + cq * 4);
            U.blk = cat < 2; U.ok = sc >= 0; U.sp = src + (size_t)rg * U.Nsrc + (sc >= 0 ? sc : 0); U.dst = dstb + (size_t)(nbi * 64) * 1024; U.wsc = wscb + nbi * 64; return U; };
        auto ldg = [&](const float*& ptr, size_t step, int ok, f32x4 (&v)[8]) {
#pragma unroll
            for (int i = 0; i < 8; ++i) { v[i] = ok ? __builtin_nontemporal_load((const f32x4*)ptr) : (f32x4){0.f, 0.f, 0.f, 0.f}; ptr += step; } };
        auto consume = [&](int q, const f32x4 (&v)[8], f32x4& cm) {
#pragma unroll
            for (int i = 0; i < 8; ++i) { cm = __builtin_elementwise_max(cm, __builtin_elementwise_abs(v[i]));
                const unsigned w0 = pk_bf16(v[i][0], v[i][1]), w1 = pk_bf16(v[i][2], v[i][3]);
                LAS unsigned short* bp = (LAS unsigned short*)(wl + (cq * 4) * WP + ((q * 8 + i) * 32 + rg) * 2);
                bp[0] = (unsigned short)w0; bp[WP / 2] = (unsigned short)(w0 >> 16); bp[WP] = (unsigned short)w1; bp[3 * (WP / 2)] = (unsigned short)(w1 >> 16); } };
        int u = lo + first;
        if (u < hi) {
            U8 U = decode(u);
            f32x4 q0[8], q1[8], q2[8], q3[8];
            const float* lp = U.sp; size_t lstep = (size_t)32 * U.Nsrc; int lok = U.ok;
            ldg(lp, lstep, lok, q0); ldg(lp, lstep, lok, q1);
#pragma unroll 1
            for (;;) {
                const int un = u + stride; const bool hn = un < hi;
                U8 Un = U; if (hn) Un = decode(un);
                f32x4 cm = (f32x4){0.f, 0.f, 0.f, 0.f};
                ldg(lp, lstep, lok, q2); consume(0, q0, cm);
                ldg(lp, lstep, lok, q3); consume(1, q1, cm);
                lp = Un.sp; lstep = (size_t)32 * Un.Nsrc; lok = Un.ok;
                if (hn) ldg(lp, lstep, lok, q0);
                consume(2, q2, cm);
                if (hn) ldg(lp, lstep, lok, q1);
                consume(3, q3, cm);
#pragma unroll
                for (int c = 0; c < 4; ++c) { float v = cm[c];
                    { const auto rr = __builtin_amdgcn_permlane16_swap(__float_as_uint(v), __float_as_uint(v), false, false); v = fmaxf(__uint_as_float(rr[0]), __uint_as_float(rr[1])); }
                    { const auto rr = __builtin_amdgcn_permlane32_swap(__float_as_uint(v), __float_as_uint(v), false, false); v = fmaxf(__uint_as_float(rr[0]), __uint_as_float(rr[1])); }
                    cm[c] = v; }
                if ((tid & 63) < 16) *(LAS f32x4*)(cmx + wvn * 64 + cq * 4) = cm;
                __syncthreads();
                float mx = 0.f;
#pragma unroll
                for (int w = 0; w < 8; ++w) mx = fmaxf(mx, cmx[w * 64 + col]);
                if (U.blk) {
                    mx = wave_max(mx); if ((tid & 63) == 0) cmx[512 + wvn] = mx; __syncthreads();
#pragma unroll
                    for (int w = 0; w < 8; ++w) mx = fmaxf(mx, cmx[512 + w]);
                }
                mx = mx > 0.f ? mx : 1.0f;
                const float inv = 127.0f / mx;
                if (piece == 0) U.wsc[col] = mx * (1.0f / 127.0f);
#pragma unroll 2
                for (int it = 0; it < 8; ++it) {
                    const int k0 = it * 128 + piece * 16;
                    const LAS unsigned* rp = (const LAS unsigned*)(wl + col * WP + k0 * 2);
                    unsigned w[8];
#pragma unroll
                    for (int j = 0; j < 8; ++j) w[j] = rp[j];
                    u32x4 o;
#pragma unroll
                    for (int j = 0; j < 4; ++j) o[j] = pk_i8x4(bf_lo(w[2 * j]) * inv, bf_hi(w[2 * j]) * inv, bf_lo(w[2 * j + 1]) * inv, bf_hi(w[2 * j + 1]) * inv);
                    *(u32x4*)(U.dst + (size_t)col * 1024 + k0) = o;
                }
                __syncthreads();
                if (!hn) break;
                U = Un; u = un;
            }
        }
    }
    __syncthreads();
}

__device__ __forceinline__ void conv_tiles_run(const Params& p, LAS unsigned char* lds, const int tid, int lo, int hi, int first, int stride) {
    unsigned char* ws = fresh_ws();
    const int ng = tid & 31, kgq = tid >> 5;
    const int orow = tid >> 2, oq = tid & 3;
    {
        __syncthreads();
        struct TileRef { ConvJob c; int nbi, kbi; };
        auto decode = [&](int t) -> TileRef {
            int j = 0, rem = t;
#pragma unroll 1
            for (; j < 9; ++j) { const int n = conv_tiles(j); if (rem < n) break; rem -= n; }
            const int per = CJ_NB[j] * CJ_KB[j], mat = rem / per, r2 = rem % per;
            TileRef T; T.c = conv_job(p, ws, j, mat); T.kbi = r2 / T.c.nb; T.nbi = r2 % T.c.nb; return T; };
        auto issue = [&](const TileRef& T, f32x4 (&v)[8], float (&ks)[8]) {
            const int n0 = T.nbi * 128 + ng * 4, k0 = T.kbi * (T.c.f8 ? 128 : 64) + kgq * 4, sc = conv_map(T.c.map, n0);
#pragma unroll
            for (int r = 0; r < 8; ++r) { const int k = k0 + (r >> 2) * 64 + (r & 3);
                if ((r < 4 || T.c.f8) && sc >= 0 && k < T.c.Ksrc) { v[r] = __builtin_nontemporal_load((const f32x4*)(T.c.src + (size_t)k * T.c.Nsrc + sc)); ks[r] = T.c.scale ? T.c.scale[k] : 1.0f; } else { v[r] = (f32x4){0.f, 0.f, 0.f, 0.f}; ks[r] = 0.f; } } };
        auto finish = [&](const TileRef& T, const f32x4 (&v)[8], const float (&ks)[8], int buf) {
            LAS unsigned char* tl = lds + buf * 32768;
            if (T.c.f8) {
#pragma unroll
                for (int h = 0; h < 2; ++h)
#pragma unroll
                    for (int cc = 0; cc < 4; ++cc) *(LAS unsigned*)(tl + (ng * 4 + cc) * 144 + h * 64 + kgq * 4) = pk_fp8x4(v[4 * h][cc] * (ks[4 * h] * W8_SCALE), v[4 * h + 1][cc] * (ks[4 * h + 1] * W8_SCALE), v[4 * h + 2][cc] * (ks[4 * h + 2] * W8_SCALE), v[4 * h + 3][cc] * (ks[4 * h + 3] * W8_SCALE));
                __syncthreads();
                unsigned char* dp = (unsigned char*)T.c.dst + (size_t)(T.nbi * 128 + orow) * T.c.Kdst + T.kbi * 128 + oq * 32;
                *(u32x4*)dp = *(const LAS u32x4*)(tl + orow * 144 + oq * 32); *(u32x4*)(dp + 16) = *(const LAS u32x4*)(tl + orow * 144 + oq * 32 + 16);
            } else {
#pragma unroll
                for (int cc = 0; cc < 4; ++cc) { u32x2 w; w.x = pk_bf16(v[0][cc] * ks[0], v[1][cc] * ks[1]); w.y = pk_bf16(v[2][cc] * ks[2], v[3][cc] * ks[3]); *(LAS u32x2*)(tl + (ng * 4 + cc) * 144 + kgq * 8) = w; }
                __syncthreads();
                bf16_t* dp = T.c.dst + (size_t)(T.nbi * 128 + orow) * T.c.Kdst + T.kbi * 64 + oq * 16;
                *(u32x4*)dp = *(const LAS u32x4*)(tl + orow * 144 + oq * 32); *(u32x4*)(dp + 8) = *(const LAS u32x4*)(tl + orow * 144 + oq * 32 + 16);
            } };
        int t = lo + first;
        if (t < hi) {
            TileRef TA = decode(t), TB = TA; f32x4 va[8], vb[8]; float sa[8], sb[8];
            issue(TA, va, sa);
#pragma unroll 1
            for (;;) {
                int tn = t + stride; bool hn = tn < hi;
                if (hn) { TB = decode(tn); issue(TB, vb, sb); }
                finish(TA, va, sa, 0);
                if (!hn) break;
                t = tn; tn = t + stride; hn = tn < hi;
                if (hn) { TA = decode(tn); issue(TA, va, sa); }
                finish(TB, vb, sb, 1);
                if (!hn) break;
                t = tn;
            }
        }
    }
    __syncthreads();
}

__device__ __forceinline__ void phase_prologue(const Params& p, const int wv, LAS unsigned char* lds) {
    const int tid = opaque_tid(wv);
    unsigned char* ws = p.ws;
    if (blockIdx.x == 0) {
        float* tab = (float*)(ws + OFF_TAB);
        for (int i = tid; i < 1024; i += NTHREADS) { const int pos = i >> 4, f = i & 15; const float inv = 1.0f / powf(10000.0f, (float)(2 * f) / 32.0f); const float ang = (float)pos * inv; tab[i] = cosf(ang); tab[1024 + i] = sinf(ang); }
        for (int i = tid; i < 512; i += NTHREADS) { const int pos = i >> 3, f = i & 7; const float inv = 1.0f / powf(10000.0f, (float)(2 * f) / 16.0f); const float ang = (float)pos * inv; tab[2048 + i] = cosf(ang); tab[2048 + 512 + i] = sinf(ang); }
    }
    {
        LAS float* sv = (LAS float*)lds;
        LAS float* red = (LAS float*)(lds + 36864);
        for (int i = tid; i < 9 * 1024; i += NTHREADS) { const int r = i >> 10, k = i & 1023; const float c = r < 8 ? p.in[1][r * 1024 + k] : p.in[3][k]; sv[i] = c / (1.0f + expf(-c)); }
        __syncthreads();
        for (int u = blockIdx.x; u < 384; u += gridDim.x) {
            const int layer = u / 96, cg = u % 96, cq = tid & 15, kg = tid >> 4;
            f32x4 acc[9];
#pragma unroll
            for (int r = 0; r < 9; ++r) acc[r] = (f32x4){0.f, 0.f, 0.f, 0.f};
            const float* wp = p.in[4] + ((size_t)layer * 1024 + kg * 32) * 6144 + cg * 64 + cq * 4;
#pragma unroll 8
            for (int kk = 0; kk < 32; ++kk) {
                const f32x4 w = __builtin_nontemporal_load((const f32x4*)(wp + (size_t)kk * 6144));
#pragma unroll
                for (int r = 0; r < 9; ++r) acc[r] += w * sv[r * 1024 + kg * 32 + kk];
            }
#pragma unroll
            for (int r = 0; r < 9; ++r) *(LAS f32x4*)(red + (kg * 9 + r) * 64 + cq * 4) = acc[r];
            __syncthreads();
            float* mod = (float*)(ws + OFF_MOD);
            for (int i = tid; i < 9 * 64; i += NTHREADS) { const int r = i >> 6, cc = i & 63; float sacc = 0.f;
#pragma unroll
                for (int g = 0; g < 32; ++g) sacc += red[(g * 9 + r) * 64 + cc];
                mod[((size_t)layer * 9 + r) * 6144 + cg * 64 + cc] = sacc + p.in[5][layer * 6144 + cg * 64 + cc]; }
            __syncthreads();
        }
    }
    conv_units(p, lds, tid, 0, CV_NU_PRO, (int)((blockIdx.x + (gridDim.x >> 1)) % gridDim.x), (int)gridDim.x);
    conv_tiles_run(p, lds, tid, 0, CV_NT_PRO, (int)(gridDim.x - 1 - blockIdx.x), (int)gridDim.x);
}

__device__ __forceinline__ void ld16(const float* p, int lane, float (&v)[16]) {
#pragma unroll
    for (int j = 0; j < 2; ++j) { const f32x4 a = *(const f32x4*)(p + 8 * lane + 512 * j), b = *(const f32x4*)(p + 8 * lane + 512 * j + 4);
        v[8 * j] = a[0]; v[8 * j + 1] = a[1]; v[8 * j + 2] = a[2]; v[8 * j + 3] = a[3]; v[8 * j + 4] = b[0]; v[8 * j + 5] = b[1]; v[8 * j + 6] = b[2]; v[8 * j + 7] = b[3]; }
}
__device__ __forceinline__ void ld16_nt(const float* p, int lane, float (&v)[16]) {
#pragma unroll
    for (int j = 0; j < 2; ++j) { const f32x4 a = __builtin_nontemporal_load((const f32x4*)(p + 8 * lane + 512 * j)), b = __builtin_nontemporal_load((const f32x4*)(p + 8 * lane + 512 * j + 4));
        v[8 * j] = a[0]; v[8 * j + 1] = a[1]; v[8 * j + 2] = a[2]; v[8 * j + 3] = a[3]; v[8 * j + 4] = b[0]; v[8 * j + 5] = b[1]; v[8 * j + 6] = b[2]; v[8 * j + 7] = b[3]; }
}
__device__ __forceinline__ void st16_f32_nt(float* p, int lane, const float (&v)[16]) {
#pragma unroll
    for (int j = 0; j < 2; ++j) { __builtin_nontemporal_store((f32x4){v[8 * j], v[8 * j + 1], v[8 * j + 2], v[8 * j + 3]}, (f32x4*)(p + 8 * lane + 512 * j)); __builtin_nontemporal_store((f32x4){v[8 * j + 4], v[8 * j + 5], v[8 * j + 6], v[8 * j + 7]}, (f32x4*)(p + 8 * lane + 512 * j + 4)); }
}
__device__ __forceinline__ void ld16_bf16(const bf16_t* p, int lane, float (&v)[16]) {
#pragma unroll
    for (int j = 0; j < 2; ++j) { const u32x4 w = *(const u32x4*)(p + 8 * lane + 512 * j);
#pragma unroll
        for (int k = 0; k < 4; ++k) { v[8 * j + 2 * k] = bf_lo(w[k]); v[8 * j + 2 * k + 1] = bf_hi(w[k]); } }
}
__device__ __forceinline__ void st16_f32(float* p, int lane, const float (&v)[16]) {
#pragma unroll
    for (int j = 0; j < 2; ++j) { *(f32x4*)(p + 8 * lane + 512 * j) = (f32x4){v[8 * j], v[8 * j + 1], v[8 * j + 2], v[8 * j + 3]}; *(f32x4*)(p + 8 * lane + 512 * j + 4) = (f32x4){v[8 * j + 4], v[8 * j + 5], v[8 * j + 6], v[8 * j + 7]}; }
}
__device__ __forceinline__ void st16_bf16(bf16_t* p, int lane, const float (&v)[16]) {
#pragma unroll
    for (int j = 0; j < 2; ++j) { u32x4 w; w.x = pk_bf16(v[8 * j], v[8 * j + 1]); w.y = pk_bf16(v[8 * j + 2], v[8 * j + 3]); w.z = pk_bf16(v[8 * j + 4], v[8 * j + 5]); w.w = pk_bf16(v[8 * j + 6], v[8 * j + 7]); *(u32x4*)(p + 8 * lane + 512 * j) = w; }
}
__device__ __forceinline__ float st16_i8_lds(LAS unsigned char* p, int lane, const float (&v)[16]) {
    float mx = 0.f;
#pragma unroll
    for (int k = 0; k < 16; ++k) mx = fmaxf(mx, fabsf(v[k]));
    mx = wave_max(mx); mx = mx > 0.f ? mx : 1.0f;
    const float inv = 127.0f / mx;
#pragma unroll
    for (int j = 0; j < 2; ++j) { u32x2 w; w.x = pk_i8x4(v[8 * j] * inv, v[8 * j + 1] * inv, v[8 * j + 2] * inv, v[8 * j + 3] * inv); w.y = pk_i8x4(v[8 * j + 4] * inv, v[8 * j + 5] * inv, v[8 * j + 6] * inv, v[8 * j + 7] * inv);
        *(LAS u32x2*)(p + 8 * lane + 512 * j) = w; }
    return mx * (1.0f / 127.0f);
}
__device__ __forceinline__ float st16_i8(unsigned char* p, int lane, const float (&v)[16]) {
    float mx = 0.f;
#pragma unroll
    for (int k = 0; k < 16; ++k) mx = fmaxf(mx, fabsf(v[k]));
    mx = wave_max(mx); mx = mx > 0.f ? mx : 1.0f;
    const float inv = 127.0f / mx;
#pragma unroll
    for (int j = 0; j < 2; ++j) { u32x2 w; w.x = pk_i8x4(v[8 * j] * inv, v[8 * j + 1] * inv, v[8 * j + 2] * inv, v[8 * j + 3] * inv); w.y = pk_i8x4(v[8 * j + 4] * inv, v[8 * j + 5] * inv, v[8 * j + 6] * inv, v[8 * j + 7] * inv);
        *(u32x2*)(p + 8 * lane + 512 * j) = w; }
    return mx * (1.0f / 127.0f);
}
__device__ __forceinline__ float sumsq16(const float (&v)[16]) { float s = 0.f;
#pragma unroll
    for (int i = 0; i < 16; ++i) s += v[i] * v[i];
    return wave_sum(s); }
__device__ __forceinline__ const float* modp(const Params& p, int layer, int bidx, int which) { return (const float*)(p.ws + OFF_MOD) + (((size_t)layer * 9 + bidx) * 6 + which) * 1024; }
__device__ __forceinline__ const float* xin_row(const Params& p, int row) { return row < MLAT ? p.in[0] + (size_t)row * DM : p.in[2] + (size_t)(row - MLAT) * DM; }
__device__ __forceinline__ int row_bidx(int row) { return row < MLAT ? (row >> 12) : 8; }

__device__ __forceinline__ void phase_h0(const Params& p, const int wv) {
    const int tid = opaque_tid(wv), lane = tid & 63, wave = tid >> 6;
    bf16_t* abuf = (bf16_t*)(p.ws + OFF_ABUF);
    float gs[16], sh[16];
    int cur = -1;
    const int row0 = blockIdx.x * ROWS_PER_BLOCK + wave;
    constexpr int NI = ROWS_PER_BLOCK / NWAVES;
    float Xb[3][16];
    auto step = [&](int i, float (&x)[16], float (&xn2)[16]) -> bool {
        if (i >= NI) return false;
        const int row = row0 + NWAVES * i, bidx = row_bidx(row);
        if (i + 2 < NI) ld16_nt(xin_row(p, row + 2 * NWAVES), lane, xn2);
        if (bidx != cur) { cur = bidx; float t[16]; ld16(modp(p, 0, bidx, 1), lane, gs); ld16(p.in[6], lane, t);
#pragma unroll
            for (int k = 0; k < 16; ++k) gs[k] = t[k] * (1.0f + gs[k]);
            ld16(modp(p, 0, bidx, 0), lane, sh); }
        const float rstd = rsqrtf(sumsq16(x) * (1.0f / DM) + EPSN);
#pragma unroll
        for (int k = 0; k < 16; ++k) x[k] = x[k] * rstd * gs[k] + sh[k];
        { const float fs = st16_i8((unsigned char*)abuf + (size_t)row * DM, lane, x); if (lane == 0) ((float*)(p.ws + OFF_FSC))[row] = fs; }
        return true;
    };
    ld16_nt(xin_row(p, row0), lane, Xb[0]); ld16_nt(xin_row(p, row0 + NWAVES), lane, Xb[1]);
#pragma unroll 1
    for (int i = 0; i < NI; i += 3) {
        if (!step(i, Xb[0], Xb[2])) break;
        if (!step(i + 1, Xb[1], Xb[0])) break;
        if (!step(i + 2, Xb[2], Xb[1])) break;
    }
}

template <bool ODD>
__device__ __forceinline__ void phase_rowB(const Params& p, const int wv, LAS unsigned char* lds, int layer, const bf16_t* Y, int nrows, bool dummy = false) {
    const int tid = opaque_tid(wv), lane = tid & 63, wave = tid >> 6;
    const bf16_t* xs_in = (const bf16_t*)(p.ws + OFF_XS); bf16_t* xs = (bf16_t*)(p.ws + (dummy ? WS_END : OFF_XS)); bf16_t* abuf = (bf16_t*)(p.ws + (dummy ? WS_END + (size_t)MTOT * DM * 4 : OFF_ABUF));
    const float* ng = p.in[6] + (size_t)layer * 4 * DM;
    float mg1[16], gs2[16], m3[16];
    LAS float* wrt = (LAS float*)lds;
    LAS int* lcnt = (LAS int*)(lds + 32768);
    LAS int* lbase = (LAS int*)(lds + 32768 + 64);
    LAS int* rinfo = (LAS int*)(lds + 32768 + 128);
    LAS float* rwt = (LAS float*)(lds + 32768 + 128 + ROWS_PER_BLOCK * 16);
    LAS unsigned char* stash = lds + 40960;
    if (ODD) {
        const float* wr = p.in[21] + (size_t)(layer >> 1) * DM * NEXP;
        for (int i = tid; i < DM * NEXP; i += NTHREADS) wrt[i] = wr[i];
        if (tid < 8) lcnt[tid] = 0;
        __syncthreads();
    }
    int cur = -1;
    const int row0 = blockIdx.x * ROWS_PER_BLOCK + wave;
    constexpr int NI = ROWS_PER_BLOCK / NWAVES;
    float Yb[3][16], Xb[3][16];
    auto issue = [&](int row, float (&yy)[16], float (&xx)[16]) { ld16_bf16(Y + (size_t)row * DM, lane, yy); if (layer == 0) ld16_nt(xin_row(p, row), lane, xx); else ld16_bf16(xs_in + (size_t)row * DM, lane, xx); };
    auto step = [&](int i, float (&y)[16], float (&x)[16], float (&yn2)[16], float (&xn2)[16]) -> bool {
        const int lrow = wave + NWAVES * i, row = row0 + NWAVES * i, bidx = row_bidx(row);
        if (i >= NI || row >= nrows) return false;
        if (i + 2 < NI && row + 2 * NWAVES < nrows) issue(row + 2 * NWAVES, yn2, xn2);
        if (bidx != cur) { cur = bidx; float t[16]; ld16(modp(p, layer, bidx, 2), lane, mg1); ld16(ng + DM, lane, t);
#pragma unroll
            for (int k = 0; k < 16; ++k) mg1[k] *= t[k];
            ld16(modp(p, layer, bidx, 4), lane, gs2); ld16(ng + 2 * DM, lane, t);
#pragma unroll
            for (int k = 0; k < 16; ++k) gs2[k] = t[k] * (1.0f + gs2[k]);
            ld16(modp(p, layer, bidx, 3), lane, m3); }
        const float rsy = rsqrtf(sumsq16(y) * (1.0f / DM) + EPSN);
#pragma unroll
        for (int k = 0; k < 16; ++k) x[k] = x[k] + mg1[k] * (y[k] * rsy);
        st16_bf16(xs + (size_t)row * DM, lane, x);
        const float rs1 = rsqrtf(sumsq16(x) * (1.0f / DM) + EPSN);
#pragma unroll
        for (int k = 0; k < 16; ++k) y[k] = x[k] * rs1 * gs2[k] + m3[k];
        float fs;
        if (ODD) fs = st16_i8_lds(stash + (size_t)(i < 9 ? wave * 9 + i : wave * 8 + (i - 9)) * 1024, lane, y);
        else { fs = st16_i8((unsigned char*)abuf + (size_t)row * DM, lane, y); if (lane == 0 && !dummy) ((float*)(p.ws + OFF_FSC))[row] = fs; }
        if (ODD) {
            float lg[8];
#pragma unroll
            for (int e = 0; e < 8; ++e) lg[e] = 0.f;
#pragma unroll
            for (int j = 0; j < 4; ++j)
#pragma unroll
                for (int q = 0; q < 4; ++q) { const int col = 8 * lane + 512 * (j >> 1) + 4 * (j & 1) + q; const f32x4 wa = *(const LAS f32x4*)(wrt + col * 8), wb = *(const LAS f32x4*)(wrt + col * 8 + 4); const float f = y[4 * j + q];
                    lg[0] += f * wa[0]; lg[1] += f * wa[1]; lg[2] += f * wa[2]; lg[3] += f * wa[3]; lg[4] += f * wb[0]; lg[5] += f * wb[1]; lg[6] += f * wb[2]; lg[7] += f * wb[3]; }
#pragma unroll
            for (int e = 0; e < 8; ++e) lg[e] = wave_sum(lg[e]);
            int e0 = 0; float l0 = lg[0];
#pragma unroll
            for (int e = 1; e < 8; ++e) if (lg[e] > l0) { l0 = lg[e]; e0 = e; }
            int e1 = e0 == 0 ? 1 : 0; float l1 = -INFINITY;
#pragma unroll
            for (int e = 0; e < 8; ++e) if (e != e0 && lg[e] > l1) { l1 = lg[e]; e1 = e; }
            if (lane == 0) {
                const float w1 = 1.0f / (1.0f + expf(l0 - l1)), w0 = 1.0f - w1;
                const int i0 = __hip_atomic_fetch_add(lcnt + e0, 1, __ATOMIC_RELAXED, __HIP_MEMORY_SCOPE_WORKGROUP);
                const int i1 = __hip_atomic_fetch_add(lcnt + e1, 1, __ATOMIC_RELAXED, __HIP_MEMORY_SCOPE_WORKGROUP);
                rinfo[lrow * 4 + 0] = e0; rinfo[lrow * 4 + 1] = e1; rinfo[lrow * 4 + 2] = i0; rinfo[lrow * 4 + 3] = i1; rwt[lrow * 3] = w0; rwt[lrow * 3 + 1] = w1; rwt[lrow * 3 + 2] = fs;
            }
        }
        return true;
    };
    auto flush = [&](int i_lo, int i_hi) {
        __syncthreads();
        unsigned* cnt = (unsigned*)(p.ws + OFF_CTL) + CW_MOECNT + (layer >> 1) * 64;
        if (tid < 8) lbase[tid] = (int)__hip_atomic_fetch_add(cnt + tid, (unsigned)lcnt[tid], __ATOMIC_RELAXED, __HIP_MEMORY_SCOPE_AGENT);
        __syncthreads();
        int* slot = (int*)(p.ws + OFF_SLOT); float* twt = (float*)(p.ws + OFF_TWT); float* tsc = (float*)(p.ws + OFF_GWT); unsigned char* gbuf = p.ws + OFF_GBUF;
        for (int i = i_lo; i < i_hi; ++i) {
            const int lrow = wave + NWAVES * i, row = row0 + NWAVES * i;
            if (row >= nrows) break;
            const int e0 = rinfo[lrow * 4], e1 = rinfo[lrow * 4 + 1], s0 = lbase[e0] + rinfo[lrow * 4 + 2], s1 = lbase[e1] + rinfo[lrow * 4 + 3];
            const u32x4 v = *(const LAS u32x4*)(stash + (size_t)(i < 9 ? wave * 9 + i : wave * 8 + (i - 9)) * 1024 + lane * 16);
            *(u32x4*)(gbuf + ((size_t)e0 * CAPR + s0) * 1024 + lane * 16) = v;
            *(u32x4*)(gbuf + ((size_t)e1 * CAPR + s1) * 1024 + lane * 16) = v;
            if (lane == 0) { *(int4*)(slot + (size_t)row * 4) = make_int4(e0, s0, e1, s1);
                twt[(size_t)e0 * MTOT + s0] = rwt[lrow * 3]; twt[(size_t)e1 * MTOT + s1] = rwt[lrow * 3 + 1]; tsc[(size_t)e0 * MTOT + s0] = rwt[lrow * 3 + 2]; tsc[(size_t)e1 * MTOT + s1] = rwt[lrow * 3 + 2]; }
        }
        __syncthreads();
        if (tid < 8) lcnt[tid] = 0;
        __syncthreads();
    };
    if (row0 < nrows) issue(row0, Yb[0], Xb[0]);
    if (row0 + NWAVES < nrows) issue(row0 + NWAVES, Yb[1], Xb[1]);
    bool live = true;
#pragma unroll 1
    for (int i = 0; i < 9 && live; i += 3) {
        if (!step(i, Yb[0], Xb[0], Yb[2], Xb[2])) { live = false; break; }
        if (!step(i + 1, Yb[1], Xb[1], Yb[0], Xb[0])) { live = false; break; }
        if (!step(i + 2, Yb[2], Xb[2], Yb[1], Xb[1])) { live = false; break; }
    }
    if (ODD && !dummy) flush(0, 9);
#pragma unroll 1
    for (int i = 9; i < NI && live; i += 3) {
        if (!step(i, Yb[0], Xb[0], Yb[2], Xb[2])) break;
        if (!step(i + 1, Yb[1], Xb[1], Yb[0], Xb[0])) break;
        if (!step(i + 2, Yb[2], Xb[2], Yb[1], Xb[1])) break;
    }
    if (ODD && !dummy) flush(9, NI);
}

struct MoeLayout { int cnt[8], ustart[9], tstart[9]; };
__device__ __forceinline__ MoeLayout moe_layout(const Params& p, int layer) {
    unsigned* cnt = (unsigned*)(p.ws + OFF_CTL) + CW_MOECNT + (layer >> 1) * 64;
    MoeLayout L; int u = 0, t = 0;
#pragma unroll
    for (int e = 0; e < 8; ++e) { const int c = __builtin_amdgcn_readfirstlane((int)__hip_atomic_load(cnt + e, __ATOMIC_RELAXED, __HIP_MEMORY_SCOPE_AGENT)); L.cnt[e] = c; L.ustart[e] = u; L.tstart[e] = t; u += c; t += (c + 255) >> 8; }
    L.ustart[8] = u; L.tstart[8] = t; return L;
}

template <bool MOE>
__device__ __forceinline__ void phase_rowC(const Params& p, const int wv, int layer, const bf16_t* F, bool last, bool dummy = false) {
    const int tid = opaque_tid(wv), lane = tid & 63, wave = tid >> 6;
    const bf16_t* xs_in = (const bf16_t*)(p.ws + OFF_XS); bf16_t* xs = (bf16_t*)(p.ws + (dummy ? WS_END : OFF_XS)); bf16_t* abuf = (bf16_t*)(p.ws + (dummy ? WS_END + (size_t)MTOT * DM * 4 : OFF_ABUF));
    float* outp = dummy ? (float*)xs : p.out;
    const float* ng = p.in[6] + (size_t)layer * 4 * DM;
    float mg3[16], gsn[16], sh[16];
    const int nrows = last ? MLAT : MTOT;
    const bf16_t* eout = (const bf16_t*)(p.ws + OFF_EOUT);
    constexpr int NI = ROWS_PER_BLOCK / NWAVES;
    const int row0 = blockIdx.x * ROWS_PER_BLOCK + wave;
    int my0 = 0, my1 = 0;
    if (MOE) {
        const MoeLayout L = moe_layout(p, layer);
        const int r = row0 + NWAVES * lane;
        if (lane < NI && r < nrows) {
            const int4 si = *(const int4*)((const int*)(p.ws + OFF_SLOT) + (size_t)r * 4);
            int t0 = 0, t1 = 0;
#pragma unroll
            for (int j = 0; j < 8; ++j) { t0 = (j == si.x) ? L.tstart[j] : t0; t1 = (j == si.z) ? L.tstart[j] : t1; }
            my0 = t0 * 256 + si.y; my1 = t1 * 256 + si.w;
        }
    }
    float Fb[3][16], Gb[3][16], Xb[3][16];
    auto issue = [&](int i, int row, float (&ff)[16], float (&gg)[16], float (&xx)[16]) {
        if (MOE) { const int a0 = __builtin_amdgcn_readlane(my0, i), a1 = __builtin_amdgcn_readlane(my1, i); ld16_bf16(eout + (size_t)a0 * DM, lane, ff); ld16_bf16(eout + (size_t)a1 * DM, lane, gg); }
        else ld16_bf16(F + (size_t)row * DM, lane, ff);
        ld16_bf16(xs_in + (size_t)row * DM, lane, xx);
    };
    int cur = -1;
    auto step = [&](int i, float (&f)[16], float (&f1)[16], float (&x)[16], float (&fn2)[16], float (&gn2)[16], float (&xn2)[16]) -> bool {
        const int row = row0 + NWAVES * i, bidx = row_bidx(row);
        if (i >= NI || row >= nrows) return false;
        constexpr int AHEAD = MOE ? 1 : 2;
        if (i + AHEAD < NI && row + AHEAD * NWAVES < nrows) issue(i + AHEAD, row + AHEAD * NWAVES, fn2, gn2, xn2);
        if (MOE) {
#pragma unroll
            for (int k = 0; k < 16; ++k) f[k] += f1[k];
        }
        if (bidx != cur) { cur = bidx; float t[16]; ld16(modp(p, layer, bidx, 5), lane, mg3); ld16(ng + 3 * DM, lane, t);
#pragma unroll
            for (int k = 0; k < 16; ++k) mg3[k] *= t[k];
            if (!last) { ld16(modp(p, layer + 1, bidx, 1), lane, gsn); ld16(ng + 4 * DM, lane, t);
#pragma unroll
                for (int k = 0; k < 16; ++k) gsn[k] = t[k] * (1.0f + gsn[k]);
                ld16(modp(p, layer + 1, bidx, 0), lane, sh); } }
        const float rsf = rsqrtf(sumsq16(f) * (1.0f / DM) + EPSN);
#pragma unroll
        for (int k = 0; k < 16; ++k) x[k] = x[k] + mg3[k] * (f[k] * rsf);
        if (last) st16_f32_nt(outp + (size_t)row * DM, lane, x);
        else {
            st16_bf16(xs + (size_t)row * DM, lane, x);
            const float rs2 = rsqrtf(sumsq16(x) * (1.0f / DM) + EPSN);
#pragma unroll
            for (int k = 0; k < 16; ++k) f[k] = x[k] * rs2 * gsn[k] + sh[k];
            { const float fs = st16_i8((unsigned char*)abuf + (size_t)row * DM, lane, f); if (lane == 0 && !dummy) ((float*)(p.ws + OFF_FSC))[row] = fs; }
        }
        return true;
    };
    if (row0 < nrows) issue(0, row0, Fb[0], Gb[0], Xb[0]);
    if constexpr (MOE) {
#pragma unroll 1
        for (int i = 0; i < NI; i += 2) {
            if (!step(i, Fb[0], Gb[0], Xb[0], Fb[1], Gb[1], Xb[1])) break;
            if (!step(i + 1, Fb[1], Gb[1], Xb[1], Fb[0], Gb[0], Xb[0])) break;
        }
    } else {
        if (row0 + NWAVES < nrows) issue(1, row0 + NWAVES, Fb[1], Gb[1], Xb[1]);
#pragma unroll 1
        for (int i = 0; i < NI; i += 3) {
            if (!step(i, Fb[0], Gb[0], Xb[0], Fb[2], Gb[2], Xb[2])) break;
            if (!step(i + 1, Fb[1], Gb[1], Xb[1], Fb[0], Gb[0], Xb[0])) break;
            if (!step(i + 2, Fb[2], Gb[2], Xb[2], Fb[1], Gb[1], Xb[1])) break;
        }
    }
}

__device__ __forceinline__ void phase_nrm(const Params& p, const int wv) {
    const int tid = opaque_tid(wv), lane = tid & 63, wave = tid >> 6;
    const bf16_t* P = (const bf16_t*)(p.ws + OFF_U + U_P_O); bf16_t* mqn = (bf16_t*)(p.ws + OFF_U + U_NRM_O); bf16_t* kvn = (bf16_t*)(p.ws + OFF_U + U_KVN_O);
    for (int row = blockIdx.x * NWAVES + wave; row < MTOT; row += gridDim.x * NWAVES) {
        const bf16_t* pr = P + (size_t)row * ODD_INP;
        const u32x2 q = *(const u32x2*)(pr + 4 * lane); const unsigned kv = *(const unsigned*)(pr + 256 + 2 * lane);
        const float q0 = bf_lo(q.x), q1 = bf_hi(q.x), q2 = bf_lo(q.y), q3 = bf_hi(q.y), k0 = bf_lo(kv), k1 = bf_hi(kv);
        const float rq = rsqrtf(wave_sum(q0 * q0 + q1 * q1 + q2 * q2 + q3 * q3) * (1.0f / 256.0f) + EPSN);
        const float rk = rsqrtf(wave_sum(k0 * k0 + k1 * k1) * (1.0f / 128.0f) + EPSN);
        u32x2 w; w.x = pk_bf16(q0 * rq, q1 * rq); w.y = pk_bf16(q2 * rq, q3 * rq); *(u32x2*)(mqn + (size_t)row * 256 + 4 * lane) = w;
        u32x2 z; z.x = pk_bf16(k0 * rk, k1 * rk); z.y = 0u;
        bf16_t* o = kvn + (size_t)row * 256;
        *(unsigned*)(o + 2 * lane) = z.x; *(unsigned*)(o + 128 + 2 * lane) = 0u;
    }
}

__device__ __forceinline__ void phase_conv(const Params& p, const int wv, int layer) {
    const int tid = opaque_tid(wv), lane = tid & 63, wave = tid >> 6;
    const bf16_t* P = (const bf16_t*)(p.ws + OFF_U + U_P_E); bf16_t* mix = (bf16_t*)(p.ws + OFF_U + U_MIX_E);
    const float* cw = p.in[8] + (size_t)(layer >> 1) * 3 * 512;
    float w0[8], w1[8], w2[8];
#pragma unroll
    for (int k = 0; k < 8; ++k) { w0[k] = cw[8 * lane + k]; w1[k] = cw[512 + 8 * lane + k]; w2[k] = cw[1024 + 8 * lane + k]; }
    const int bA = (int)(blockIdx.x & 7), isA = bA < 2, nit = isA ? 14 : 18;
    const int jb = (int)(blockIdx.x >> 3) * 6 + (bA - 2), oa = jb / 3, orow = (14 + jb % 3) * 2048 + ((oa >> 1) * 8 + (oa & 1)) * 8 + wave;
#pragma unroll 1
    for (int it = 0; it < nit; ++it) {
        const int row = it < 17 ? it * 2048 + (int)blockIdx.x * NWAVES + wave : orow;
        const int pos = row < MLAT ? (row & (SEQ - 1)) : ((row - MLAT) & (CTXL - 1)), len = row < MLAT ? SEQ : CTXL;
        const bf16_t* pr = P + (size_t)row * EVEN_IN + 8 * lane;
        const u32x4 bg = *(const u32x4*)pr;
        float acc[8];
#pragma unroll
        for (int k = 0; k < 8; ++k) acc[k] = 0.f;
#pragma unroll
        for (int d = -1; d <= 1; ++d) {
            if (pos + d < 0 || pos + d >= len) continue;
            const bf16_t* q = pr + (ptrdiff_t)d * EVEN_IN;
            const u32x4 cg = *(const u32x4*)(q + 512), uu = *(const u32x4*)(q + 1024);
            const float* w = d < 0 ? w0 : (d == 0 ? w1 : w2);
#pragma unroll
            for (int k = 0; k < 4; ++k) { acc[2 * k] += w[2 * k] * bf_lo(cg[k]) * bf_lo(uu[k]); acc[2 * k + 1] += w[2 * k + 1] * bf_hi(cg[k]) * bf_hi(uu[k]); }
        }
        u32x4 o;
#pragma unroll
        for (int k = 0; k < 4; ++k) o[k] = pk_bf16(bf_lo(bg[k]) * acc[2 * k], bf_hi(bg[k]) * acc[2 * k + 1]);
        *(u32x4*)(mix + (size_t)row * DM + 8 * lane) = o;
    }
}

__device__ __forceinline__ float max3f(float a, float b, float c) { return __builtin_fmaxf(__builtin_fmaxf(a, b), c); }
__device__ __forceinline__ float xhalf_max(float v) { const auto rr = __builtin_amdgcn_permlane32_swap(__float_as_uint(v), __float_as_uint(v), false, false); return fmaxf(__uint_as_float(rr[0]), __uint_as_float(rr[1])); }
__device__ __forceinline__ float xhalf_sum(float v) { const auto rr = __builtin_amdgcn_permlane32_swap(__float_as_uint(v), __float_as_uint(v), false, false); return __uint_as_float(rr[0]) + __uint_as_float(rr[1]); }
struct NoMask { __device__ __forceinline__ void operator()(f32x16&, f32x16&) const {} };
struct BandMask {
    int kp0, qp, hi;
    __device__ __forceinline__ void operator()(f32x16& s0, f32x16& s1) const {
#pragma unroll
        for (int r = 0; r < 16; ++r) { const int d0 = kp0 + crow(r, hi) - qp, d1 = d0 + 32; if (d0 > 128 || d0 < -128) s0[r] = -INFINITY; if (d1 > 128 || d1 < -128) s1[r] = -INFINITY; }
    }
};
#define ABAR() asm volatile("s_waitcnt lgkmcnt(0)\n\ts_barrier" ::: "memory")
template <int KP, int NKS>
__device__ __forceinline__ void attn_X(const LAS unsigned char* Kt, const bf16x8 (&qf)[NKS], const f32x16& negm, f32x16& s0, f32x16& s1, int lane) {
    const int r32 = lane & 31, hi = lane >> 5;
    const LAS unsigned char* kp = Kt + r32 * KP + hi * 16;
#pragma unroll
    for (int s = 0; s < NKS; ++s) {
        const bf16x8 k0 = *(const LAS bf16x8*)(kp + s * 32), k1 = *(const LAS bf16x8*)(kp + 32 * KP + s * 32);
        s0 = __builtin_amdgcn_mfma_f32_32x32x16_bf16(k0, qf[s], s == 0 ? negm : s0, 0, 0, 0);
        s1 = __builtin_amdgcn_mfma_f32_32x32x16_bf16(k1, qf[s], s == 0 ? negm : s1, 0, 0, 0);
    }
}
template <int NDB, class Mask>
__device__ __forceinline__ void attn_Y(f32x16& s0, f32x16& s1, u32x4 (&pw)[4], f32x16 (&o)[NDB], f32x16& negm, float& m, float& l, bool first, const Mask& mask) {
    constexpr float THR = 8.0f;
    mask(s0, s1);
    float a = max3f(s0[0], s0[1], s1[0]), b = max3f(s0[2], s0[3], s1[1]); a = max3f(a, s1[2], s1[3]);
#pragma unroll
    for (int r = 4; r < 16; r += 4) { a = max3f(a, s0[r], s0[r + 1]); b = max3f(b, s0[r + 2], s0[r + 3]); a = max3f(a, s1[r], s1[r + 1]); b = max3f(b, s1[r + 2], s1[r + 3]); }
    const float rm = xhalf_max(fmaxf(a, b));
    if (first || __any(rm > THR)) {
        const float dl = first ? fmaxf(rm, -64.0f) : fmaxf(rm, 0.f), f = fast_exp2(-dl);
        m += dl; l *= f;
#pragma unroll
        for (int r = 0; r < 16; ++r) { s0[r] -= dl; s1[r] -= dl; float nm_ = -m; asm volatile("" : "+v"(nm_)); negm[r] = nm_; }
        asm volatile("s_nop 7" ::: "memory");
#pragma unroll
        for (int d = 0; d < NDB; ++d)
#pragma unroll
            for (int r = 0; r < 16; ++r) o[d][r] *= f;
    }
    float ps = 0.f;
#pragma unroll
    for (int r = 0; r < 16; ++r) { s0[r] = fast_exp2(s0[r]); s1[r] = fast_exp2(s1[r]); ps += s0[r] + s1[r]; }
    l += ps;
#pragma unroll
    for (int ks = 0; ks < 2; ++ks) {
        pw[ks] = (u32x4){pk_bf16(s0[8 * ks], s0[8 * ks + 1]), pk_bf16(s0[8 * ks + 2], s0[8 * ks + 3]), pk_bf16(s0[8 * ks + 4], s0[8 * ks + 5]), pk_bf16(s0[8 * ks + 6], s0[8 * ks + 7])};
        pw[2 + ks] = (u32x4){pk_bf16(s1[8 * ks], s1[8 * ks + 1]), pk_bf16(s1[8 * ks + 2], s1[8 * ks + 3]), pk_bf16(s1[8 * ks + 4], s1[8 * ks + 5]), pk_bf16(s1[8 * ks + 6], s1[8 * ks + 7])};
    }
}
template <int VP, int NDB>
__device__ __forceinline__ void attn_Z(const LAS unsigned char* Vt, const u32x4 (&pw)[4], f32x16 (&o)[NDB], int lane) {
    const int hi = lane >> 5;
    const LAS unsigned char* vp = Vt + (4 * hi + ((lane & 15) >> 2)) * VP + ((lane >> 4) & 1) * 32 + (lane & 3) * 8;
    if constexpr (NDB <= 4) {
        s16x4 lo[NDB], hh[NDB], lon[NDB], hhn[NDB];
#pragma unroll
        for (int d = 0; d < NDB; ++d) { lo[d] = __builtin_bit_cast(s16x4, __builtin_amdgcn_ds_read_tr16_b64_v4i16((LAS s16x4*)(vp + d * 64))); hh[d] = __builtin_bit_cast(s16x4, __builtin_amdgcn_ds_read_tr16_b64_v4i16((LAS s16x4*)(vp + d * 64 + 8 * VP))); }
#pragma unroll
        for (int st = 0; st < 4; ++st) {
            __builtin_amdgcn_sched_barrier(0);
            if (st < 3) {
#pragma unroll
                for (int d = 0; d < NDB; ++d) { const LAS unsigned char* a = vp + (16 * (st + 1)) * VP + d * 64;
                    lon[d] = __builtin_bit_cast(s16x4, __builtin_amdgcn_ds_read_tr16_b64_v4i16((LAS s16x4*)a)); hhn[d] = __builtin_bit_cast(s16x4, __builtin_amdgcn_ds_read_tr16_b64_v4i16((LAS s16x4*)(a + 8 * VP))); }
            }
            const bf16x8 pf = __builtin_bit_cast(bf16x8, pw[st]);
#pragma unroll
            for (int d = 0; d < NDB; ++d) { const bf16x8 vf = {lo[d][0], lo[d][1], lo[d][2], lo[d][3], hh[d][0], hh[d][1], hh[d][2], hh[d][3]}; o[d] = __builtin_amdgcn_mfma_f32_32x32x16_bf16(vf, pf, o[d], 0, 0, 0); }
#pragma unroll
            for (int d = 0; d < NDB; ++d) { lo[d] = lon[d]; hh[d] = hhn[d]; }
        }
    } else {
#pragma unroll
        for (int st = 0; st < 4; ++st) {
            __builtin_amdgcn_sched_barrier(0);
            const bf16x8 pf = __builtin_bit_cast(bf16x8, pw[st]);
#pragma unroll
            for (int d = 0; d < NDB; ++d) { const LAS unsigned char* a = vp + (16 * st) * VP + d * 64;
                const s16x4 lo = __builtin_bit_cast(s16x4, __builtin_amdgcn_ds_read_tr16_b64_v4i16((LAS s16x4*)a)), hh = __builtin_bit_cast(s16x4, __builtin_amdgcn_ds_read_tr16_b64_v4i16((LAS s16x4*)(a + 8 * VP)));
                const bf16x8 vf = {lo[0], lo[1], lo[2], lo[3], hh[0], hh[1], hh[2], hh[3]}; o[d] = __builtin_amdgcn_mfma_f32_32x32x16_bf16(vf, pf, o[d], 0, 0, 0); }
        }
    }
}
template <int KP, int VP, int NKS, int NDB, class GLK, class GLV, class STK, class STV, class MaskF>
__device__ __forceinline__ void attn_run1(LAS unsigned char* lds, int KB, int SB, int kcoff, const bf16x8 (&qf)[NKS], f32x16 (&o)[NDB], float& m, float& l, int NT, int lane,
                                          GLK glk, GLV glv, STK stk, STV stv, MaskF maskf) {
    f32x16 s0, s1, negm; u32x4 pw[4];
    m = 0.f;
#pragma unroll
    for (int r = 0; r < 16; ++r) negm[r] = 0.f;
    glk(0); glv(0); stk(0); stv(0); ABAR();
#pragma unroll 1
    for (int t = 0; t < NT; ++t) {
        if (t + 1 < NT) { glk(t + 1); glv(t + 1); }
        const LAS unsigned char* Kt = lds + (t & 1) * SB;
        attn_X<KP, NKS>(Kt + kcoff, qf, negm, s0, s1, lane);
        __builtin_amdgcn_sched_barrier(0);
        attn_Y<NDB>(s0, s1, pw, o, negm, m, l, t == 0, [&](f32x16& x0, f32x16& x1) { maskf(t, x0, x1); });
        __builtin_amdgcn_sched_barrier(0);
        attn_Z<VP, NDB>(Kt + KB, pw, o, lane);
        if (t + 1 < NT) { stk((t + 1) & 1); stv((t + 1) & 1); }
        ABAR();
    }
}

template <int NDB, class Mask>
__device__ __forceinline__ void attn_Y1(f32x16& s0, f32x16& s1, f32x16 (&o)[NDB], f32x16& negm, float& m, float& l, bool first, const Mask& mask) {
    constexpr float THR = 8.0f;
    mask(s0, s1);
    float a = max3f(s0[0], s0[1], s1[0]), b = max3f(s0[2], s0[3], s1[1]); a = max3f(a, s1[2], s1[3]);
#pragma unroll
    for (int r = 4; r < 16; r += 4) { a = max3f(a, s0[r], s0[r + 1]); b = max3f(b, s0[r + 2], s0[r + 3]); a = max3f(a, s1[r], s1[r + 1]); b = max3f(b, s1[r + 2], s1[r + 3]); }
    const float rm = xhalf_max(fmaxf(a, b));
    if (first || __any(rm > THR)) {
        const float dl = first ? fmaxf(rm, -64.0f) : fmaxf(rm, 0.f), f = fast_exp2(-dl);
        m += dl; l *= f;
#pragma unroll
        for (int r = 0; r < 16; ++r) { s0[r] -= dl; s1[r] -= dl; float nm_ = -m; asm volatile("" : "+v"(nm_)); negm[r] = nm_; }
        asm volatile("s_nop 7" ::: "memory");
#pragma unroll
        for (int d = 0; d < NDB; ++d)
#pragma unroll
            for (int r = 0; r < 16; ++r) o[d][r] *= f;
    }
}
__device__ __forceinline__ void attn_Y2(f32x16& s0, f32x16& s1, u32x4 (&pw)[4], float& l) {
    float ps = 0.f;
#pragma unroll
    for (int r = 0; r < 16; ++r) { s0[r] = fast_exp2(s0[r]); s1[r] = fast_exp2(s1[r]); ps += s0[r] + s1[r]; }
    l += ps;
#pragma unroll
    for (int ks = 0; ks < 2; ++ks) {
        pw[ks] = (u32x4){pk_bf16(s0[8 * ks], s0[8 * ks + 1]), pk_bf16(s0[8 * ks + 2], s0[8 * ks + 3]), pk_bf16(s0[8 * ks + 4], s0[8 * ks + 5]), pk_bf16(s0[8 * ks + 6], s0[8 * ks + 7])};
        pw[2 + ks] = (u32x4){pk_bf16(s1[8 * ks], s1[8 * ks + 1]), pk_bf16(s1[8 * ks + 2], s1[8 * ks + 3]), pk_bf16(s1[8 * ks + 4], s1[8 * ks + 5]), pk_bf16(s1[8 * ks + 6], s1[8 * ks + 7])};
    }
}
template <int KP, int VP, int NKS, int NDB, int VPM  , class GLK, class GLV, class STK, class STV, class MaskF>
__device__ __forceinline__ void attn_run2(LAS unsigned char* lds, int KB, int SB, int kcoff, const bf16x8 (&qf)[NKS], f32x16 (&o)[NDB], float& m, float& l, int NT, int lane,
                                          GLK glk, GLV glv, STK stk, STV stv, MaskF maskf) {
    f32x16 sa0, sa1, sb0, sb1, negm; u32x4 pw[4];
    m = 0.f;
#pragma unroll
    for (int r = 0; r < 16; ++r) negm[r] = 0.f;
    glk(0); stk(0); glv(0); stv(0);
    if (NT > 1) { glk(1); stk(1); }
    ABAR();
    attn_X<KP, NKS>(lds + kcoff, qf, negm, sa0, sa1, lane);
    auto step = [&](int t, f32x16& c0, f32x16& c1, f32x16& n0, f32x16& n1) {
        if (t + 2 < NT) glk(t + 2);
        if (t + 1 < NT) glv(t + 1);
        attn_Y1<NDB>(c0, c1, o, negm, m, l, t == 0, [&](f32x16& x0, f32x16& x1) { maskf(t, x0, x1); });
        if (t + 1 < NT) attn_X<KP, NKS>(lds + ((t + 1) & 1) * SB + kcoff, qf, negm, n0, n1, lane);
        attn_Y2(c0, c1, pw, l);
        __builtin_amdgcn_sched_group_barrier(0x100, 2 * NKS, 0);
#pragma unroll
        for (int i = 0; i < 2 * NKS; ++i) { __builtin_amdgcn_sched_group_barrier(0x008, 1, 0); __builtin_amdgcn_sched_group_barrier(0x002, VPM, 0); }
        __builtin_amdgcn_sched_barrier(0);
        attn_Z<VP, NDB>(lds + (t & 1) * SB + KB, pw, o, lane);
        if (t + 2 < NT) stk(t & 1);
        if (t + 1 < NT) stv((t + 1) & 1);
        ABAR();
    };
#pragma unroll 1
    for (int t = 0; t < NT; t += 2) {
        step(t, sa0, sa1, sb0, sb1);
        if (t + 1 < NT) step(t + 1, sb0, sb1, sa0, sa1);
    }
}

__device__ __forceinline__ void store_row_pairs(bf16_t* p32, const u32x2 (&w)[4], int hi) {
#pragma unroll
    for (int k = 0; k < 4; k += 2) {
        u32x2 a = w[k], b = w[k + 1];
        { const auto r = __builtin_amdgcn_permlane32_swap(a.x, b.x, false, false); a.x = r[0]; b.x = r[1]; }
        { const auto r = __builtin_amdgcn_permlane32_swap(a.y, b.y, false, false); a.y = r[0]; b.y = r[1]; }
        *(u32x4*)(p32 + 8 * k + 8 * hi) = (u32x4){a.x, a.y, b.x, b.y};
    }
}
__device__ __forceinline__ bf16x8 load_q(const bf16_t* p, float qs) {
    const u32x4 w = *(const u32x4*)p; u32x4 o;
#pragma unroll
    for (int k = 0; k < 4; ++k) o[k] = pk_bf16(bf_lo(w[k]) * qs, bf_hi(w[k]) * qs);
    return __builtin_bit_cast(bf16x8, o);
}
__device__ __forceinline__ int attn_vcu() { return (int)((blockIdx.x & 7) * (gridDim.x >> 3) + (blockIdx.x >> 3)); }

__device__ __forceinline__ void swa_unit(const Params& p, const int wv, LAS unsigned char* lds, int layer, int b, int g, int q0, bool ctxq) {
    constexpr int KP = 144, VP = 192, KB = 64 * KP, SB = KB + 64 * VP;
    const int tid = opaque_tid(wv), lane = tid & 63, wave = __builtin_amdgcn_readfirstlane(tid >> 6), r32 = lane & 31, hi = lane >> 5;
    const bf16_t* P = (const bf16_t*)(p.ws + OFF_U + U_P_E); bf16_t* mix = (bf16_t*)(p.ws + OFF_U + U_MIX_E);
    const int hd = 4 * g + (wave >> 1);
    const int qrow = (ctxq ? MLAT + b * CTXL : b * SEQ) + q0 + 32 * (wave & 1) + r32;
    const float qs = 0.125f * LOG2E;
    bf16x8 qf[4];
#pragma unroll
    for (int s = 0; s < 4; ++s) qf[s] = load_q(P + (size_t)qrow * EVEN_IN + 1536 + hd * 64 + 16 * s + 8 * hi, qs);
    f32x16 o[2];
#pragma unroll
    for (int d = 0; d < 2; ++d)
#pragma unroll
        for (int r = 0; r < 16; ++r) o[d][r] = 0.f;
    float m = -1e30f, l = 0.f;
    int ilo = 0, nlat = 0;
    if (!ctxq) { ilo = q0 >= 128 ? 0 : (128 - q0) / 64; int ihi = (SEQ + 64 - q0) / 64; ihi = ihi > 4 ? 4 : ihi; nlat = ihi - ilo + 1; }
    const int NT = nlat + 4;
    const int ki = tid >> 3, kc = tid & 7;
    u32x4 rk, rv;
    auto krow = [&](int t) { return t < nlat ? b * SEQ + q0 - 128 + 64 * (ilo + t) + ki : MLAT + b * CTXL + 64 * (t - nlat) + ki; };
    auto glk = [&](int t) { rk = *(const u32x4*)(P + (size_t)krow(t) * EVEN_IN + 2048 + g * 64 + kc * 8); };
    auto glv = [&](int t) { rv = *(const u32x4*)(P + (size_t)krow(t) * EVEN_IN + 2176 + g * 64 + kc * 8); };
    auto stk = [&](int buf) { *(LAS u32x4*)(lds + buf * SB + ki * KP + kc * 16) = rk; };
    auto stv = [&](int buf) { *(LAS u32x4*)(lds + buf * SB + KB + ki * VP + kc * 16) = rv; };
    const int qp = q0 + 32 * (wave & 1) + r32;
    attn_run1<KP, VP, 4, 2>(lds, KB, SB, 0, qf, o, m, l, NT, lane, glk, glv, stk, stv,
        [&](int t, f32x16& x0, f32x16& x1) { if (t < nlat) { BandMask bm; bm.kp0 = q0 - 128 + 64 * (ilo + t); bm.qp = qp; bm.hi = hi; bm(x0, x1); } });
    l = xhalf_sum(l);
    l += fast_exp2(p.in[9][(layer >> 1) * 8 + hd] * LOG2E - m);
    const float inv = 1.0f / l;
    bf16_t* orow = mix + (size_t)qrow * DM + 512 + hd * 64;
#pragma unroll
    for (int d = 0; d < 2; ++d) { u32x2 w[4];
#pragma unroll
        for (int gq = 0; gq < 4; ++gq) { w[gq].x = pk_bf16(o[d][4 * gq] * inv, o[d][4 * gq + 1] * inv); w[gq].y = pk_bf16(o[d][4 * gq + 2] * inv, o[d][4 * gq + 3] * inv); }
        store_row_pairs(orow + 32 * d, w, hi); }
}
__device__ __forceinline__ void phase_swa(const Params& p, const int wv, LAS unsigned char* lds, int layer) {
    const int v = attn_vcu();
    for (int u = v; u < 1024 + 64; u += gridDim.x) {
        if (u < 1024) swa_unit(p, wv, lds, layer, u >> 7, (u >> 6) & 1, (u & 63) * 64, false);
        else { const int c = u - 1024; swa_unit(p, wv, lds, layer, c >> 3, (c >> 2) & 1, (c & 3) * 64, true); }
    }
}

__device__ __forceinline__ void mla_unit(const Params& p, const int wv, LAS unsigned char* lds, int b, int h, int qrow0, int nl) {
    constexpr int KP = 208, VP = 192, KB = 64 * KP, SB = KB + 64 * VP;
    const int tid = opaque_tid(wv), lane = tid & 63, wave = __builtin_amdgcn_readfirstlane(tid >> 6), r32 = lane & 31, hi = lane >> 5;
    const bf16_t* P = (const bf16_t*)(p.ws + OFF_U + U_P_O); const bf16_t* QF = (const bf16_t*)(p.ws + OFF_U + U_QF_O); const bf16_t* KVF = (const bf16_t*)(p.ws + OFF_U + U_KVF_O);
    bf16_t* mix = (bf16_t*)(p.ws + OFF_U + U_MIX_O);
    const int qrow = qrow0 + 32 * wave + r32;
    const float qs = 0.10206207261596575f * LOG2E;
    bf16x8 qf[6];
#pragma unroll
    for (int s = 0; s < 4; ++s) qf[s] = load_q(QF + (size_t)qrow * 768 + h * 96 + 16 * s + 8 * hi, qs);
    {
        const u32x4 a = *(const u32x4*)(QF + (size_t)qrow * 768 + h * 96 + 64 + 8 * hi), bq = *(const u32x4*)(QF + (size_t)qrow * 768 + h * 96 + 80 + 8 * hi);
        float x1[8], x2[8];
#pragma unroll
        for (int k = 0; k < 4; ++k) { x1[2 * k] = bf_lo(a[k]); x1[2 * k + 1] = bf_hi(a[k]); x2[2 * k] = bf_lo(bq[k]); x2[2 * k + 1] = bf_hi(bq[k]); }
        if (nl > 0) {
            const float* tab = (const float*)(p.ws + OFF_TAB) + 2048; const int sp = qrow & (SEQ - 1), pos = hi ? (sp & 63) : (sp >> 6);
#pragma unroll
            for (int k = 0; k < 8; ++k) { const float cs = tab[pos * 8 + k], sn = tab[512 + pos * 8 + k]; const float o1 = x1[k] * cs - x2[k] * sn, o2 = x2[k] * cs + x1[k] * sn; x1[k] = o1; x2[k] = o2; }
        }
        u32x4 w1, w2;
#pragma unroll
        for (int k = 0; k < 4; ++k) { w1[k] = pk_bf16(x1[2 * k] * qs, x1[2 * k + 1] * qs); w2[k] = pk_bf16(x2[2 * k] * qs, x2[2 * k + 1] * qs); }
        qf[4] = __builtin_bit_cast(bf16x8, w1); qf[5] = __builtin_bit_cast(bf16x8, w2);
    }
    f32x16 o[2];
#pragma unroll
    for (int d = 0; d < 2; ++d)
#pragma unroll
        for (int r = 0; r < 16; ++r) o[d][r] = 0.f;
    float m = -1e30f, l = 0.f;
    const int NT = nl + 4;
    const int ki = tid >> 3, kc = tid & 7, ki2 = (tid >> 2) & 63, kc2 = tid & 3;
    u32x4 rk, rv, rp;
    auto krow = [&](int t, int i) { return t < nl ? b * SEQ + 64 * t + i : MLAT + b * CTXL + 64 * (t - nl) + i; };
    auto glk = [&](int t) { rk = *(const u32x4*)(KVF + (size_t)krow(t, ki) * 1024 + h * 128 + kc * 8); if (tid < 256) rp = *(const u32x4*)(P + (size_t)krow(t, ki2) * ODD_INP + 384 + kc2 * 8); };
    auto glv = [&](int t) { rv = *(const u32x4*)(KVF + (size_t)krow(t, ki) * 1024 + h * 128 + 64 + kc * 8); };
    auto stk = [&](int buf) { *(LAS u32x4*)(lds + buf * SB + ki * KP + kc * 16) = rk; if (tid < 256) *(LAS u32x4*)(lds + buf * SB + ki2 * KP + 128 + kc2 * 16) = rp; };
    auto stv = [&](int buf) { *(LAS u32x4*)(lds + buf * SB + KB + ki * VP + kc * 16) = rv; };
    attn_run2<KP, VP, 6, 2, 7>(lds, KB, SB, 0, qf, o, m, l, NT, lane, glk, glv, stk, stv, [](int, f32x16&, f32x16&) {});
    l = xhalf_sum(l);
    const float inv = 1.0f / l;
    bf16_t* orow = mix + (size_t)qrow * DM + h * 64;
#pragma unroll
    for (int d = 0; d < 2; ++d) { u32x2 w[4];
#pragma unroll
        for (int gq = 0; gq < 4; ++gq) { w[gq].x = pk_bf16(o[d][4 * gq] * inv, o[d][4 * gq + 1] * inv); w[gq].y = pk_bf16(o[d][4 * gq + 2] * inv, o[d][4 * gq + 3] * inv); }
        store_row_pairs(orow + 32 * d, w, hi); }
}

__device__ __forceinline__ void diff_unit(const Params& p, const int wv, LAS unsigned char* lds, int layer, int b, int h, int qrow0, int nl, float lam, float lam_init) {
    constexpr int KP = 272, VP = 320, KB = 64 * KP, SB = KB + 64 * VP, XP = 528;
    const int tid = opaque_tid(wv), lane = tid & 63, wave = __builtin_amdgcn_readfirstlane(tid >> 6), r32 = lane & 31, hi = lane >> 5;
    const bf16_t* P = (const bf16_t*)(p.ws + OFF_U + U_P_O); bf16_t* mix = (bf16_t*)(p.ws + OFF_U + U_MIX_O);
    const int comp = wave >> 2, qrow = qrow0 + 32 * (wave & 3) + r32;
    const float qs = 0.125f * LOG2E;
    bf16x8 qf[4];
#pragma unroll
    for (int s = 0; s < 4; ++s) qf[s] = load_q(P + (size_t)qrow * ODD_INP + 512 + h * 128 + comp * 64 + 16 * s + 8 * hi, qs);
    f32x16 o[4];
#pragma unroll
    for (int d = 0; d < 4; ++d)
#pragma unroll
        for (int r = 0; r < 16; ++r) o[d][r] = 0.f;
    float m = -1e30f, l = 0.f;
    const int NT = nl + 4;
    const int ki = tid >> 3, kc = tid & 7;
    u32x4 rk0, rk1, rv0, rv1;
    auto krow = [&](int t) { return t < nl ? b * SEQ + 64 * t + ki : MLAT + b * CTXL + 64 * (t - nl) + ki; };
    auto glk = [&](int t) { const bf16_t* pr = P + (size_t)krow(t) * ODD_INP + 1024 + h * 128 + kc * 8; rk0 = *(const u32x4*)pr; rk1 = *(const u32x4*)(pr + 64); };
    auto glv = [&](int t) { const bf16_t* pr = P + (size_t)krow(t) * ODD_INP + 1536 + h * 128 + kc * 8; rv0 = *(const u32x4*)pr; rv1 = *(const u32x4*)(pr + 64); };
    auto stk = [&](int buf) { LAS unsigned char* kb = lds + buf * SB + ki * KP + kc * 16; *(LAS u32x4*)kb = rk0; *(LAS u32x4*)(kb + 128) = rk1; };
    auto stv = [&](int buf) { LAS unsigned char* vb = lds + buf * SB + KB + ki * VP + kc * 16; *(LAS u32x4*)vb = rv0; *(LAS u32x4*)(vb + 128) = rv1; };
    attn_run2<KP, VP, 4, 4, 10>(lds, KB, SB, comp * 128, qf, o, m, l, NT, lane, glk, glv, stk, stv, [](int, f32x16&, f32x16&) {});
    l = xhalf_sum(l);
    const float inv = 1.0f / l;
    LAS unsigned char* xrow = lds + (32 * (wave & 3) + r32) * XP;
    if (comp == 1) {
#pragma unroll
        for (int d = 0; d < 4; ++d)
#pragma unroll
            for (int gq = 0; gq < 4; ++gq) *(LAS f32x4*)(xrow + (32 * d + 8 * gq + 4 * hi) * 4) = (f32x4){o[d][4 * gq] * inv, o[d][4 * gq + 1] * inv, o[d][4 * gq + 2] * inv, o[d][4 * gq + 3] * inv};
    }
    __syncthreads();
    if (comp == 0) {
        float ss = 0.f;
#pragma unroll
        for (int d = 0; d < 4; ++d)
#pragma unroll
            for (int gq = 0; gq < 4; ++gq) { const f32x4 o2 = *(const LAS f32x4*)(xrow + (32 * d + 8 * gq + 4 * hi) * 4);
#pragma unroll
                for (int k = 0; k < 4; ++k) { const float v = o[d][4 * gq + k] * inv - lam * o2[k]; o[d][4 * gq + k] = v; ss += v * v; } }
        ss = xhalf_sum(ss);
        const float omli = __uint_as_float(__builtin_amdgcn_readfirstlane(__float_as_uint(layer == 1 ? 1.0f - 0.35550906f : 1.0f - 0.55605820f)));
        const float rs = rsqrtf(ss * (1.0f / 128.0f) + EPSN) * omli;
        const float* sg = p.in[17] + (size_t)(layer >> 1) * 128;
        bf16_t* orow = mix + (size_t)qrow * DM + 512 + h * 128;
#pragma unroll
        for (int d = 0; d < 4; ++d) { u32x2 w[4];
#pragma unroll
            for (int gq = 0; gq < 4; ++gq) { const int c = 32 * d + 8 * gq + 4 * hi; const f32x4 gg = *(const f32x4*)(sg + c);
                w[gq].x = pk_bf16(o[d][4 * gq] * rs * gg[0], o[d][4 * gq + 1] * rs * gg[1]); w[gq].y = pk_bf16(o[d][4 * gq + 2] * rs * gg[2], o[d][4 * gq + 3] * rs * gg[3]); }
            store_row_pairs(orow + 32 * d, w, hi); }
    }
    __syncthreads();
}
__device__ __forceinline__ void phase_attn_odd(const Params& p, const int wv, LAS unsigned char* lds, int layer) {
    const int v = attn_vcu();
    const bool need_ctx = layer < 3;
    const float* lp = p.in[16] + (size_t)(layer >> 1) * 256; const int ln = opaque_tid(wv) & 63;
    const float lam_init = layer == 1 ? 0.35550906f : 0.55605820f;
    const float lam = __uint_as_float(__builtin_amdgcn_readfirstlane(__float_as_uint(expf(wave_sum(lp[ln] * lp[64 + ln])) - expf(wave_sum(lp[128 + ln] * lp[192 + ln])) + lam_init)));
    const int n_mla = 1024 + (need_ctx ? 64 : 0);
#ifndef NO_MLA
    for (int u = v; u < n_mla; u += gridDim.x) {
        if (u < 1024) { const int bh = u >> 4, qb = u & 15; mla_unit(p, wv, lds, bh >> 3, bh & 7, (bh >> 3) * SEQ + qb * 256, 64); }
        else { const int c = u - 1024; mla_unit(p, wv, lds, c >> 3, c & 7, MLAT + (c >> 3) * CTXL, 0); }
    }
#endif
#ifndef NO_DIFF
    for (int u = v; u < n_mla + 64; u += gridDim.x) {
        if (u < 1024) { const int bh = u >> 5, qb = u & 31; diff_unit(p, wv, lds, layer, bh >> 2, bh & 3, (bh >> 2) * SEQ + qb * 128, 64, lam, lam_init); }
        else if (u >= 1024 + 64) { const int c = u - 1024 - 64, bh = c >> 1; diff_unit(p, wv, lds, layer, bh >> 2, bh & 3, MLAT + (bh >> 2) * CTXL + (c & 1) * 128, 0, lam, lam_init); }
    }
#endif
}

__device__ __forceinline__ bool tail_share(int nwg, int G, int c, int& rank, int& nidle) {
    const int rmax = (nwg + G - 1) / G; int busy = nwg - (rmax - 1) * G; busy = busy >= G ? 0 : busy;
    rank = c - busy; nidle = G - busy; return c >= busy;
}

constexpr int NPH_PAIR = 16, NPHASES = 2 + 2 * NPH_PAIR;
__global__ void __launch_bounds__(NTHREADS, 2) fwd(Params p, int lo, int hi) {
    extern __shared__ __attribute__((aligned(16))) unsigned char smem_raw[];
    LAS unsigned char* lds = (LAS unsigned char*)smem_raw;
    volatile LAS unsigned* xbw = (volatile LAS unsigned*)(lds + LDS_BYTES - 16);
    unsigned char* ws = p.ws;
    const int wv = __builtin_amdgcn_readfirstlane((int)(threadIdx.x >> 6));
    XcdBarrier bar; bar.bar = (unsigned*)(ws + OFF_CTL); bar.x = 0; bar.st = xbw; bar.wv = wv;
    if (hi - lo > 1) {
        if (wv == 0 && lane_id() == 0) { xbw[0] = 0u; xbw[1] = 0u; xbw[2] = 0u; xbw[3] = 0u; }
        __syncthreads();
        bar = xcd_barrier_post((unsigned*)(ws + OFF_CTL), xbw, wv);
    }
    const int G = gridDim.x, c = blockIdx.x;
    constexpr int NM = MTOT / 256;
#ifndef PH_MASK
#define PH_MASK 0xFFFFFFFFu
#endif
#define PHASE(id) if (lo <= (id) && (id) < hi)
#ifndef DUP_MASK
#define DUP_MASK 0u
#endif
#define DUPK(k) _Pragma("unroll 1") for (int dup_ = 0; dup_ < ((((DUP_MASK) >> (k)) & 1u) ? 2 : 1); ++dup_)
#define DUP_DUMMY(k) (((((DUP_MASK) >> (k)) & 1u) != 0u) && dup_ == 0)
#define PMARK(k) asm volatile("; PHASE_MARK " #k ::: "memory")
#define PHM(k) if constexpr ((PH_MASK >> (k)) & 1u)
#define SEAM(id) do { if ((id) > lo) xcd_barrier(bar); } while (0)
    PHM(0) PHASE(0) DUPK(0) { PMARK(0); phase_prologue(p, wv, lds); }
    PHM(1) PHASE(1) DUPK(1) { PMARK(1); SEAM(1); phase_h0(p, wv); }
    for (int pr = 0; pr < 2; ++pr) {
        Params pq = p; pq.ws = fresh_ws();
        unsigned char* ws = pq.ws;
        const int le = 2 * pr, lod = 2 * pr + 1, pb = 2 + pr * NPH_PAIR;
        const bf16_t* abuf = (const bf16_t*)(ws + OFF_ABUF);
        PHM(2) PHASE(pb + 0) DUPK(2) { PMARK(2); SEAM(pb + 0);
            pg8::Gemm g{abuf, ws + OFF_WINE + pr * SZ_WINE, 1024, 1024}; pg8::StaticOrder S; S.init(NM, EVEN_IN / 256, G, c);
            pg8::EpiRope<0> E{(bf16_t*)(ws + OFF_U + U_P_E), EVEN_IN, (const float*)(ws + OFF_TAB), (const float*)(ws + OFF_FSC), (const float*)(ws + OFF_WSCI) + (size_t)pr * EVEN_IN, nullptr}; pg8::gemm_phase<3>(lds, g, S, E, wv); }
        PHM(3) PHASE(pb + 1) DUPK(3) { PMARK(3); SEAM(pb + 1); phase_conv(pq, wv, le); phase_swa(pq, wv, lds, le); }
        PHM(4) PHASE(pb + 2) DUPK(4) { PMARK(4); SEAM(pb + 2);
            pg8::Gemm g{(const bf16_t*)(ws + OFF_U + U_MIX_E), (const bf16_t*)(ws + OFF_WOUTE + pr * SZ_WOUT), 1024, 1024}; pg8::StaticOrder S; S.init(NM, 4, G, c);
            pg8::EpiBf16S E{(bf16_t*)(ws + OFF_U + U_Y_E), 1024, 4, nullptr, 1.0f}; pg8::gemm_phase<2>(lds, g, S, E, wv);
            { int rk, ni; if (tail_share(NM * 4, G, c, rk, ni)) conv_tiles_run(p, lds, opaque_tid(wv), CV_NT_PRO + pr * (CV_NT_E / 2), CV_NT_PRO + pr * (CV_NT_E / 2) + TAIL_T_SPLIT, rk, ni); } }
        PHM(5) PHASE(pb + 3) DUPK(5) { PMARK(5); SEAM(pb + 3); phase_rowB<false>(pq, wv, lds, le, (const bf16_t*)(ws + OFF_U + U_Y_E), MTOT, DUP_DUMMY(5)); }
        PHM(6) PHASE(pb + 4) DUPK(6) { PMARK(6); SEAM(pb + 4);
            pg8::Gemm g{abuf, ws + OFF_WGU + pr * SZ_WGU, 1024, 1024}; pg8::StaticOrder S; S.init(NM, 2 * FFD / 256, G, c);
            pg8::EpiSwiGLU<FFN_DOWN_FP8 != 0> E{ws + OFF_U + U_ACT_E, FFD, 2 * FFD / 256, (const float*)(ws + OFF_FSC), (const float*)(ws + OFF_WSCD) + (size_t)pr * 2 * FFD}; pg8::gemm_phase<3>(lds, g, S, E, wv); }
        PHM(7) PHASE(pb + 5) DUPK(7) { PMARK(7); SEAM(pb + 5);
            pg8::Gemm g{ws + OFF_U + U_ACT_E, ws + OFF_WDN + pr * SZ_WDN, FFD, FFD}; pg8::StaticOrder S; S.init(NM, 4, G, c);
            pg8::EpiBf16S E{(bf16_t*)(ws + OFF_U + U_Y_E), 1024, 4, nullptr, FFN_DOWN_FP8 ? 1.0f / W8_SCALE : 1.0f}; pg8::gemm_phase<FFN_DOWN_FP8 ? 1 : 2>(lds, g, S, E, wv);
            { int rk, ni; if (tail_share(NM * 4, G, c, rk, ni)) {
                if (pr == 0) conv_units(p, lds, opaque_tid(wv), CV_NU_PRO, CV_NU_PRO + TAIL_U_SPLIT, rk, ni); else conv_units(p, lds, opaque_tid(wv), CV_NU_PRO + CV_NU_E / 2 + TAIL_U_SPLIT, CV_NU, rk, ni); } } }
        PHM(8) PHASE(pb + 6) DUPK(8) { PMARK(8); SEAM(pb + 6); phase_rowC<false>(pq, wv, le, (const bf16_t*)(ws + OFF_U + U_Y_E), false, DUP_DUMMY(8)); }
        PHM(9) PHASE(pb + 7) DUPK(9) { PMARK(9); SEAM(pb + 7);
            pg8::Gemm g{abuf, ws + OFF_WINO + pr * SZ_WINO, 1024, 1024}; pg8::StaticOrder S; S.init(NM, ODD_INP / 256, G, c);
            pg8::EpiRope<1> E{(bf16_t*)(ws + OFF_U + U_P_O), ODD_INP, (const float*)(ws + OFF_TAB), (const float*)(ws + OFF_FSC), (const float*)(ws + OFF_WSCI) + 2 * EVEN_IN + (size_t)pr * ODD_INP, (float*)(ws + OFF_U + U_SSQ_O)}; pg8::gemm_phase<3>(lds, g, S, E, wv);
            { int rk, ni; if (tail_share(NM * (ODD_INP / 256), G, c, rk, ni)) conv_tiles_run(p, lds, opaque_tid(wv), CV_NT_PRO + pr * (CV_NT_E / 2) + TAIL_T_SPLIT, CV_NT_PRO + (pr + 1) * (CV_NT_E / 2), rk, ni); } }
        PHM(11) PHASE(pb + 8) DUPK(11) { PMARK(11); SEAM(pb + 8);
            pg8::Gemm g{(const bf16_t*)(ws + OFF_U + U_P_O), (const bf16_t*)(ws + OFF_WQUP + pr * SZ_WQUP), ODD_INP, 256}; pg8::StaticOrder S; S.init(NM, 3, G, c);
            pg8::EpiBf16N<8> E{(bf16_t*)(ws + OFF_U + U_QF_O), 768, (const float*)(ws + OFF_U + U_SSQ_O), 1.0f / 256.0f}; pg8::gemm_phase<2>(lds, g, S, E, wv); }
        PHM(19) PHASE(pb + 9) DUPK(19) { PMARK(19);
            pg8::Gemm g{(const bf16_t*)(ws + OFF_U + U_P_O) + 256, (const bf16_t*)(ws + OFF_WKVUP + pr * SZ_WKVUP), ODD_INP, 256}; pg8::StaticOrder S; S.init(NM, 4, G, G - 1 - c);
            pg8::EpiBf16N<4> E{(bf16_t*)(ws + OFF_U + U_KVF_O), 1024, (const float*)(ws + OFF_U + U_SSQ_O) + 8, 1.0f / 128.0f}; pg8::gemm_phase<2>(lds, g, S, E, wv); }
        PHM(12) PHASE(pb + 10) DUPK(12) { PMARK(12); SEAM(pb + 10); phase_attn_odd(pq, wv, lds, lod); }
        PHM(13) PHASE(pb + 11) DUPK(13) { PMARK(13); SEAM(pb + 11);
            pg8::Gemm g{(const bf16_t*)(ws + OFF_U + U_MIX_O), (const bf16_t*)(ws + OFF_WOUTO + pr * SZ_WOUT), 1024, 1024}; pg8::StaticOrder S; S.init(pr == 1 ? MLAT / 256 : NM, 4, G, c);
            pg8::EpiBf16S E{(bf16_t*)(ws + OFF_EOUT), 1024, 4, nullptr, 1.0f}; pg8::gemm_phase<2>(lds, g, S, E, wv);
            { int rk, ni; if (pr == 0 && tail_share(NM * 4, G, c, rk, ni)) conv_units(p, lds, opaque_tid(wv), CV_NU_PRO + TAIL_U_SPLIT, CV_NU_PRO + CV_NU_E / 2, rk, ni); } }
        PHM(14) PHASE(pb + 12) DUPK(14) { PMARK(14); SEAM(pb + 12); phase_rowB<true>(pq, wv, lds, lod, (const bf16_t*)(ws + OFF_EOUT), pr == 1 ? MLAT : MTOT, DUP_DUMMY(14)); }
        PHM(16) PHASE(pb + 13) DUPK(16) { PMARK(16); SEAM(pb + 13);
            const MoeLayout L = moe_layout(pq, lod);
            pg8::Gemm g{ws + OFF_GBUF, ws + OFF_WEGU + (size_t)pr * 8 * (SZ_WEGU / 2), 1024, 1024};
            pg8::MoeOrder S; S.gatherA = true; S.so.init(L.tstart[8], 2 * FFE / 256, G, c);
#pragma unroll
            for (int e = 0; e < 9; ++e) S.ts[e] = L.tstart[e];
            pg8::EpiSwiGLU<FFN_DOWN_FP8 != 0> E{ws + OFF_U, FFE, 2 * FFE / 256, (const float*)(ws + OFF_GWT), (const float*)(ws + OFF_WSCE) + (size_t)pr * 8 * 2 * FFE}; pg8::gemm_phase<3>(lds, g, S, E, wv); }
        PHM(17) PHASE(pb + 14) DUPK(17) { PMARK(17); SEAM(pb + 14);
            const MoeLayout L = moe_layout(pq, lod);
            pg8::Gemm g{ws + OFF_U, ws + OFF_WEDN + (size_t)pr * 8 * (SZ_WEDN / (FFN_DOWN_FP8 ? 2 : 1)), FFE, FFE};
            pg8::MoeOrder S; S.gatherA = false; S.so.init(L.tstart[8], 4, G, c);
#pragma unroll
            for (int e = 0; e < 9; ++e) S.ts[e] = L.tstart[e];
            pg8::EpiBf16S E{(bf16_t*)(ws + OFF_EOUT), 1024, 4, (const float*)(ws + OFF_TWT), FFN_DOWN_FP8 ? 1.0f / W8_SCALE : 1.0f}; pg8::gemm_phase<FFN_DOWN_FP8 ? 1 : 2>(lds, g, S, E, wv);
            { int rk, ni; if (pr == 0 && tail_share(4 * L.tstart[8], G, c, rk, ni)) conv_units(p, lds, opaque_tid(wv), CV_NU_PRO + CV_NU_E / 2, CV_NU_PRO + CV_NU_E / 2 + TAIL_U_SPLIT, rk, ni); } }
        PHM(18) PHASE(pb + 15) DUPK(18) { PMARK(18); SEAM(pb + 15); phase_rowC<true>(pq, wv, lod, nullptr, pr == 1, DUP_DUMMY(18)); }
    }
#undef PHASE
#undef SEAM
}

extern "C" void kernel_launch(void* const* d_in, const int* in_sizes, int n_in, void* d_out, int out_size, void* d_ws, size_t ws_size, hipStream_t stream) {
    static int grid = 0;
    if (grid == 0) {
        if (n_in != 24 || out_size != MLAT * DM || ws_size < WS_END + (DUP_MASK != 0u ? (size_t)MTOT * DM * 6 : (size_t)0)) { fprintf(stderr, "kernel_launch: unexpected shapes (n_in %d, out %d, ws %zu, need %zu)\n", n_in, out_size, ws_size, (size_t)WS_END); grid = -1; return; }
        int dev = 0, cus = 0, per_cu = 0;
        if (hipGetDevice(&dev) != hipSuccess || hipDeviceGetAttribute(&cus, hipDeviceAttributeMultiprocessorCount, dev) != hipSuccess) { grid = -1; return; }
        if (hipFuncSetAttribute((const void*)fwd, hipFuncAttributeMaxDynamicSharedMemorySize, LDS_BYTES) != hipSuccess) { fprintf(stderr, "kernel_launch: hipFuncSetAttribute failed\n"); grid = -1; return; }
        if (hipOccupancyMaxActiveBlocksPerMultiprocessor(&per_cu, (const void*)fwd, NTHREADS, LDS_BYTES) != hipSuccess || per_cu < 1) { fprintf(stderr, "kernel_launch: occupancy query says %d\n", per_cu); grid = -1; return; }
        grid = cus < 256 ? cus : 256;
        if (grid != 256) fprintf(stderr, "kernel_launch: %d CUs; the row-wise phases assume 256 workgroups\n", cus);
    }
    if (grid != 256) return;
    Params p{};
    for (int i = 0; i < 24; ++i) p.in[i] = (const float*)d_in[i];
    p.out = (float*)d_out; p.ws = (unsigned char*)d_ws;
    hipMemsetAsync((char*)d_ws + OFF_CTL, 0, CTL_BYTES, stream);
#if MK_MULTI_LAUNCH
    for (int ph = 0; ph < NPHASES; ++ph) hipLaunchKernelGGL(fwd, dim3(grid), dim3(NTHREADS), LDS_BYTES, stream, p, ph, ph + 1);
#else
    hipLaunchKernelGGL(fwd, dim3(grid), dim3(NTHREADS), LDS_BYTES, stream, p, 0, NPHASES);
#endif
}
```

```cpp
#include <hip/hip_runtime.h>
#include <cstdio>
#include <cstdint>
#include <cstddef>

#ifndef FFN_DOWN_FP8
#define FFN_DOWN_FP8 1
#endif
#ifndef MK_MULTI_LAUNCH
#define MK_MULTI_LAUNCH 0
#endif

#define LAS __attribute__((address_space(3)))
typedef unsigned short bf16_t;
typedef short bf16x8 __attribute__((ext_vector_type(8)));
typedef short s16x4 __attribute__((ext_vector_type(4)));
typedef float f32x4 __attribute__((ext_vector_type(4)));
typedef float f32x2 __attribute__((ext_vector_type(2)));
typedef float f32x16 __attribute__((ext_vector_type(16)));
typedef unsigned u32x4 __attribute__((ext_vector_type(4)));
typedef unsigned u32x2 __attribute__((ext_vector_type(2)));

constexpr int DM = 1024, NB = 8, SEQ = 4096, CTXL = 256;
constexpr int MLAT = NB * SEQ, MCTX = NB * CTXL, MTOT = MLAT + MCTX;
constexpr int EVEN_IN = 2304, ODD_INP = 2048  , FFD = 2816, FFE = 3584, NEXP = 8;
constexpr int MG_ROWS = 2 * MTOT + NEXP * 256;
constexpr float EPSN = 1e-6f;
constexpr float LOG2E = 1.4426950408889634f;
constexpr int NTHREADS = 512, NWAVES = 8;
constexpr int LDS_BYTES = 147456;
constexpr int ROWS_PER_BLOCK = MTOT / 256;

constexpr size_t al256(size_t x) { return (x + 255) & ~(size_t)255; }
constexpr size_t OFF_CTL   = 0;
constexpr size_t CTL_BYTES = 65536;
constexpr size_t OFF_MOD   = OFF_CTL + CTL_BYTES;
constexpr size_t OFF_TAB   = al256(OFF_MOD + (size_t)4 * 9 * 6144 * 4);
constexpr size_t OFF_SLOT  = al256(OFF_TAB + 16384);
constexpr size_t OFF_TOK   = al256(OFF_SLOT + (size_t)MTOT * 16);
constexpr size_t OFF_TWT   = al256(OFF_TOK + (size_t)NEXP * MTOT * 4);
constexpr size_t OFF_GWT   = al256(OFF_TWT + (size_t)NEXP * MTOT * 4);
constexpr size_t OFF_GSC   = al256(OFF_GWT + (size_t)NEXP * MTOT * 4);
constexpr size_t OFF_FSC   = al256(OFF_GSC + (size_t)MG_ROWS * 4);
constexpr size_t OFF_WSCD  = al256(OFF_FSC + (size_t)MTOT * 4);
constexpr size_t OFF_WSCE  = al256(OFF_WSCD + (size_t)2 * 2 * FFD * 4);
constexpr size_t OFF_WSCI  = al256(OFF_WSCE + (size_t)16 * 2 * FFE * 4);
constexpr size_t OFF_WINE  = al256(OFF_WSCI + (size_t)(2 * EVEN_IN + 2 * ODD_INP) * 4);
constexpr size_t SZ_WINE   = (size_t)EVEN_IN * 1024 * 2;
constexpr size_t OFF_WOUTE = OFF_WINE + 2 * SZ_WINE;
constexpr size_t SZ_WOUT   = (size_t)1024 * 1024 * 2;
constexpr size_t OFF_WINO  = OFF_WOUTE + 2 * SZ_WOUT;
constexpr size_t SZ_WINO   = (size_t)ODD_INP * 1024 * 2;
constexpr size_t OFF_WQUP  = OFF_WINO + 2 * SZ_WINO;
constexpr size_t SZ_WQUP   = (size_t)768 * 256 * 2;
constexpr size_t OFF_WKVUP = OFF_WQUP + 2 * SZ_WQUP;
constexpr size_t SZ_WKVUP  = (size_t)1024 * 256 * 2;
constexpr size_t OFF_WOUTO = OFF_WKVUP + 2 * SZ_WKVUP;
constexpr size_t OFF_WGU   = OFF_WOUTO + 2 * SZ_WOUT;
constexpr size_t SZ_WGU    = (size_t)2 * FFD * 1024 * 2;
constexpr size_t OFF_WDN   = OFF_WGU + 2 * SZ_WGU;
constexpr size_t SZ_WDN    = (size_t)1024 * FFD * 2;
constexpr size_t OFF_WEGU  = OFF_WDN + 2 * SZ_WDN;
constexpr size_t SZ_WEGU   = (size_t)2 * FFE * 1024 * 2;
constexpr size_t OFF_WEDN  = OFF_WEGU + 16 * SZ_WEGU;
constexpr size_t SZ_WEDN   = (size_t)1024 * FFE * 2;
constexpr size_t OFF_XS    = al256(OFF_WEDN + 16 * SZ_WEDN);
constexpr size_t OFF_ABUF  = OFF_XS + (size_t)MTOT * 1024 * 4;
constexpr size_t OFF_U     = OFF_ABUF + (size_t)MTOT * 1024 * 2;
constexpr size_t SZ_U      = (size_t)MG_ROWS * FFE * 2;
constexpr size_t U_P_E   = 0;
constexpr size_t U_MIX_E = U_P_E + (size_t)MTOT * EVEN_IN * 2;
constexpr size_t U_Y_E   = U_MIX_E + (size_t)MTOT * 1024 * 2;
constexpr size_t U_ACT_E = 0;
constexpr size_t U_P_O   = 0;
constexpr size_t U_NRM_O = U_P_O + (size_t)MTOT * ODD_INP * 2;
constexpr size_t U_KVN_O = U_NRM_O + (size_t)MTOT * 256 * 2;
constexpr size_t U_SSQ_O = U_NRM_O;
constexpr size_t U_QF_O  = U_KVN_O + (size_t)MTOT * 256 * 2;
constexpr size_t U_KVF_O = U_QF_O + (size_t)MTOT * 768 * 2;
constexpr size_t U_MIX_O = U_KVF_O + (size_t)MTOT * 1024 * 2;
static_assert(U_MIX_O + (size_t)MTOT * 1024 * 2 <= SZ_U, "odd-layer map fits the union region");
static_assert(U_Y_E + (size_t)MTOT * 1024 * 4 <= SZ_U, "even-layer map fits the union region");
static_assert((size_t)MTOT * FFD * 2 <= U_Y_E, "dense act must not overlap F");
constexpr int    CAPR      = MTOT;
constexpr size_t OFF_GBUF  = OFF_U + SZ_U;
constexpr size_t OFF_EOUT  = OFF_GBUF + (size_t)NEXP * CAPR * 1024;
constexpr size_t WS_END    = OFF_EOUT + (size_t)MG_ROWS * 1024 * 2;

constexpr int CW_MOECNT = 4096;

struct Params { const float* in[24]; float* out; unsigned char* ws; };

__device__ __forceinline__ unsigned pk_bf16(float lo, float hi) { typedef __bf16 b2 __attribute__((ext_vector_type(2))); f32x2 v = {lo, hi}; b2 b = __builtin_convertvector(v, b2); return __builtin_bit_cast(unsigned, b); }
__device__ __forceinline__ float bf_lo(unsigned w) { return __uint_as_float(w << 16); }
__device__ __forceinline__ float bf_hi(unsigned w) { return __uint_as_float(w & 0xffff0000u); }
__device__ __forceinline__ float clamp448(float x) { return __builtin_fminf(__builtin_fmaxf(x, -448.0f), 448.0f); }
__device__ __forceinline__ unsigned pk_fp8x4(float a, float b, float c, float d) {
    int v = __builtin_amdgcn_cvt_pk_fp8_f32(clamp448(a), clamp448(b), 0, false); v = __builtin_amdgcn_cvt_pk_fp8_f32(clamp448(c), clamp448(d), v, true); return (unsigned)v; }
__device__ __forceinline__ unsigned pk_i8x4(float a, float b, float c, float d) {
    const int ia = (int)__builtin_rintf(a), ib = (int)__builtin_rintf(b), ic = (int)__builtin_rintf(c), id = (int)__builtin_rintf(d);
    return (unsigned)(ia & 0xff) | ((unsigned)(ib & 0xff) << 8) | ((unsigned)(ic & 0xff) << 16) | ((unsigned)id << 24); }
template <int CTRL> __device__ __forceinline__ float dppf(float v) { return __builtin_bit_cast(float, __builtin_amdgcn_update_dpp(0, __builtin_bit_cast(int, v), CTRL, 0xF, 0xF, true)); }
__device__ __forceinline__ float wave_max(float v) {
    v = fmaxf(v, dppf<0xB1>(v)); v = fmaxf(v, dppf<0x4E>(v)); v = fmaxf(v, dppf<0x141>(v)); v = fmaxf(v, dppf<0x140>(v));
    { const auto rr = __builtin_amdgcn_permlane16_swap(__float_as_uint(v), __float_as_uint(v), false, false); v = fmaxf(__uint_as_float(rr[0]), __uint_as_float(rr[1])); }
    { const auto rr = __builtin_amdgcn_permlane32_swap(__float_as_uint(v), __float_as_uint(v), false, false); v = fmaxf(__uint_as_float(rr[0]), __uint_as_float(rr[1])); }
    return v; }
__device__ __forceinline__ float wave_sum(float v) {
    v += dppf<0xB1>(v); v += dppf<0x4E>(v); v += dppf<0x141>(v); v += dppf<0x140>(v);
    { const auto rr = __builtin_amdgcn_permlane16_swap(__float_as_uint(v), __float_as_uint(v), false, false); v = __uint_as_float(rr[0]) + __uint_as_float(rr[1]); }
    { const auto rr = __builtin_amdgcn_permlane32_swap(__float_as_uint(v), __float_as_uint(v), false, false); v = __uint_as_float(rr[0]) + __uint_as_float(rr[1]); }
    return v; }
__device__ __forceinline__ float fast_exp2(float x) { return __builtin_amdgcn_exp2f(x); }
__device__ __forceinline__ float fast_rcp(float x) { return __builtin_amdgcn_rcpf(x); }
__device__ __forceinline__ float silu_f(float g) { return g * fast_rcp(1.0f + fast_exp2(-g * LOG2E)); }
__device__ __forceinline__ int lane_id() { int l; asm volatile("v_mbcnt_lo_u32_b32 %0, -1, 0\n\tv_mbcnt_hi_u32_b32 %0, -1, %0" : "=v"(l)); return l; }
__device__ __forceinline__ int opaque_tid(int wv) { int t = (wv << 6) | lane_id(); asm volatile("" : "+v"(t)); return t; }
__device__ __forceinline__ int crow(int r, int hi) { return (r & 3) + 8 * (r >> 2) + 4 * hi; }

#define XB_TMO      128
#define XB_XCNT(j)  (256  + 64 * (j))
#define XB_XSUB(j)  (1280 + 64 * (j))
#define XB_XGEN(j)  (2304 + 64 * (j))
#define XB_TOP      3328
#define XB_TOPGEN   3392
#define XCD_BAR_WORDS 3456
#define XB_SPIN_CAP (1u << 22)
__device__ __forceinline__ unsigned xb_ld(unsigned* p)              { return __hip_atomic_load(p, __ATOMIC_RELAXED, __HIP_MEMORY_SCOPE_AGENT); }
__device__ __forceinline__ unsigned xb_add(unsigned* p, unsigned v) { return __hip_atomic_fetch_add(p, v, __ATOMIC_RELAXED, __HIP_MEMORY_SCOPE_AGENT); }
__device__ __forceinline__ unsigned xb_xcc_id() { return (unsigned)__builtin_amdgcn_s_getreg((3 << 11) | 20) & 0xFu; }
#define XB_SPIN(cond, bar) do { unsigned _sp = 0; while (cond) { __builtin_amdgcn_s_sleep(1); \
    if ((++_sp & 255u) == 0u) { if (xb_ld(&(bar)[XB_TMO])) break; if (_sp > XB_SPIN_CAP) { atomicAdd(&(bar)[XB_TMO], 1u); break; } } } } while (0)
struct XcdBarrier { unsigned* bar; unsigned x; volatile LAS unsigned* st; int wv; };
__device__ __forceinline__ XcdBarrier xcd_barrier_post(unsigned* bar, volatile LAS unsigned* st, int wv) {
    XcdBarrier b; b.bar = bar; b.x = xb_xcc_id(); b.st = st; b.wv = wv;
    if (wv == 0 && lane_id() == 0) (void)xb_add(&bar[XB_XCNT(b.x)], 1u);
    return b;
}
__device__ __forceinline__ void xcd_barrier_complete(unsigned* bar, unsigned x, unsigned& nloc, unsigned& nx) {
    const unsigned G = gridDim.x * gridDim.y * gridDim.z;
    unsigned sum, cnt, mine, sp = 0u;
    for (;;) {
        sum = 0u; cnt = 0u; mine = 0u;
#pragma unroll
        for (unsigned j = 0; j < 16; ++j) { const unsigned c = xb_ld(&bar[XB_XCNT(j)]); sum += c; cnt += (c > 0u) ? 1u : 0u; mine = (j == x) ? c : mine; }
        if (sum == G) break;
        __builtin_amdgcn_s_sleep(1);
        if ((++sp & 255u) == 0u) { if (xb_ld(&bar[XB_TMO])) break; if (sp > XB_SPIN_CAP) { atomicAdd(&bar[XB_TMO], 1u); break; } }
    }
    nloc = mine > 0u ? mine : 1u; nx = cnt > 0u ? cnt : 1u;
}
__device__ __forceinline__ void xcd_barrier(const XcdBarrier& b) {
    asm volatile("s_waitcnt vmcnt(0)" ::: "memory");
    __syncthreads();
    if (b.wv == 0 && lane_id() == 0) {
        unsigned* bar = b.bar;
        __builtin_amdgcn_s_waitcnt(0);
        unsigned nloc = b.st[0], nx = b.st[1];
        if (nloc == 0u) { xcd_barrier_complete(bar, b.x, nloc, nx); b.st[0] = nloc; b.st[1] = nx; }
        const unsigned old = xb_add(&bar[XB_XSUB(b.x)], 1u);
        const unsigned gen = old / nloc;
        if (old + 1u == (gen + 1u) * nloc) {
            __builtin_amdgcn_fence(__ATOMIC_RELEASE, "agent");
            asm volatile("s_waitcnt vmcnt(0)" ::: "memory");
            const unsigned og = xb_add(&bar[XB_TOP], 1u);
            const unsigned tg = og / nx;
            if (og + 1u == (tg + 1u) * nx) xb_add(&bar[XB_TOPGEN], 1u);
            else XB_SPIN(xb_ld(&bar[XB_TOPGEN]) == tg, bar);
            __builtin_amdgcn_fence(__ATOMIC_ACQUIRE, "agent");
            xb_add(&bar[XB_XGEN(b.x)], 1u);
            asm volatile("s_waitcnt vmcnt(0)" ::: "memory");
        } else {
            XB_SPIN(xb_ld(&bar[XB_XGEN(b.x)]) == gen, bar);
            __builtin_amdgcn_fence(__ATOMIC_ACQUIRE, "agent");
            asm volatile("s_waitcnt vmcnt(0)" ::: "memory");
        }
    }
    __syncthreads();
}

namespace pg8 {
constexpr int BM = 256, BK = 64, HALF = 128, HTB = HALF * BK * 2, STAGE_BYTES = 8 * HTB, NXCD = 8, WGM = 8;
__host__ __device__ __forceinline__ int lds_byte(int r, int c) { const int st = (r >> 4) * 2 + (c >> 5), rr = r & 15, cc = c & 31, ob = rr * 64 + cc * 2; return st * 1024 + (ob ^ (((ob >> 9) & 1) << 5)); }
__host__ __device__ __forceinline__ void stage_rc(int b, int& R, int& C) { const int st = b / 1024, sb = b % 1024, swz = sb ^ (((sb >> 9) & 1) << 5); R = (st >> 1) * 16 + swz / 64; C = (st & 1) * 32 + (swz % 64) / 2; }
__host__ __device__ __forceinline__ int perm32(int rho) { const int n = rho >> 4, i = rho & 15; return 8 * (i >> 2) + 4 * n + (i & 3); }
typedef int v8i32 __attribute__((ext_vector_type(8))); typedef int v4i32 __attribute__((ext_vector_type(4)));
__device__ __forceinline__ v8i32 cat8(bf16x8 a, bf16x8 b) { const v4i32 x = __builtin_bit_cast(v4i32, a), y = __builtin_bit_cast(v4i32, b); return (v8i32){x[0], x[1], x[2], x[3], y[0], y[1], y[2], y[3]}; }
struct Unit { int pm, pn, pa, ro; };
struct Gemm { const void* A; const void* Bt; int lda, K; };
struct StaticOrder {
    int nM, nN, nwg, G, c;
    __device__ void init(int nM_, int nN_, int G_, int c_) { nM = nM_; nN = nN_; nwg = nM * nN; G = G_; c = c_; }
    __device__ __forceinline__ bool next(int i, Unit& u) const {
        const long L = (long)i * G + c; if (L >= nwg) return false;
        int wgid = (int)L; { const int q = nwg / NXCD, r = nwg % NXCD, xcd = wgid % NXCD, off = wgid / NXCD; wgid = (xcd < r ? xcd * (q + 1) : r * (q + 1) + (xcd - r) * q) + off; }
        const int nig = WGM * nN, gid = wgid / nig, fm = gid * WGM, gsz = (nM - fm) < WGM ? (nM - fm) : WGM;
        u.pm = fm + ((wgid % nig) % gsz); u.pn = (wgid % nig) / gsz; u.pa = u.pm; u.ro = 0; return true;
    }
};
struct MoeOrder {
    StaticOrder so; int ts[9]; bool gatherA;
    __device__ __forceinline__ bool next(int i, Unit& u) const {
        if (!so.next(i, u)) return false;
        int e = 0;
#pragma unroll
        for (int j = 1; j < 8; ++j) e += (u.pm >= ts[j]) ? 1 : 0;
        int te = 0;
#pragma unroll
        for (int j = 0; j < 8; ++j) te = (j == e) ? ts[j] : te;
        u.pn += e * so.nN; u.pa = gatherA ? e * (CAPR / 256) + (u.pm - te) : u.pm; u.ro = e * MTOT - te * 256; return true;
    }
};

template <int FMT, class Epi, class Sched>
__device__ __forceinline__ void gemm_phase(LAS unsigned char* lds, const Gemm g, const Sched& S, const Epi& E, const int wv) {
    const int tid = opaque_tid(wv), wid = __builtin_amdgcn_readfirstlane(tid >> 6), lane = tid & 63, wr = wid >> 2, wc = wid & 3, fr = lane & 15, fq = lane >> 4;
    constexpr int ESZ = FMT == 2 ? 2 : 1;
    int K_ = g.K, lda_ = g.lda; asm volatile("" : "+s"(K_), "+s"(lda_));
    const int K = K_ * ESZ, nt = K / (BK * 2), lda = lda_ * ESZ;
    unsigned voffA[2], voffB[2];
#pragma unroll
    for (int i = 0; i < 2; ++i) { int R, C; stage_rc(tid * 16 + i * 8192, R, C); const int Rb = Epi::PERM ? ((R & ~31) + perm32(R & 31)) : R;
        voffA[i] = (unsigned)(R * lda + C * 2); voffB[i] = (unsigned)(Rb * K + C * 2); }
    const size_t kstep = (size_t)(BK * 2);
    const size_t hstepA = (size_t)HALF * lda, hstepB = (size_t)HALF * K;
    const size_t tstepA = 2 * hstepA, tstepB = 2 * hstepB;
    const unsigned ldsw = (unsigned)wid * 1024u;
    const int aoff = lds_byte(wr * 64 + fr, fq * 8), boff = lds_byte(wc * 32 + fr, fq * 8);
#define PG8_SA(b, h) (((b) * 2 + (h)) * HTB)
#define PG8_SB(b, h) ((4 + (b) * 2 + (h)) * HTB)
#define PG8_STAGE(bufoff, gbase, voff) do { _Pragma("unroll") for (int _i = 0; _i < 2; ++_i) \
        __builtin_amdgcn_global_load_lds((const unsigned*)((const char*)(gbase) + (voff)[_i]), (LAS unsigned*)(lds + (bufoff) + ldsw + _i * 8192), 16, 0, 0); } while (0)
#define PG8_LD8(addr) __builtin_shufflevector(*(const LAS v4i32*)(addr), *(const LAS v4i32*)((addr) + 1024), 0, 1, 2, 3, 4, 5, 6, 7)
#define PG8_LDA(dst, b, h) do { _Pragma("unroll") for (int m = 0; m < 4; ++m) dst[m] = PG8_LD8(lds + PG8_SA(b, h) + aoff + m * 2048); } while (0)
#define PG8_LDB(dst, b, h) do { _Pragma("unroll") for (int n = 0; n < 2; ++n) dst[n] = PG8_LD8(lds + PG8_SB(b, h) + boff + n * 2048); } while (0)
#define PG8_LO(v) __builtin_bit_cast(bf16x8, __builtin_shufflevector(v, v, 0, 1, 2, 3))
#define PG8_HI(v) __builtin_bit_cast(bf16x8, __builtin_shufflevector(v, v, 4, 5, 6, 7))
#define PG8_MMA(ai, bj, At, Bt) do { __builtin_amdgcn_s_setprio(1); \
        if constexpr (FMT == 3) { _Pragma("unroll") for (int m = 0; m < 4; ++m) _Pragma("unroll") for (int n = 0; n < 2; ++n) { \
            v4i32 c_ = __builtin_bit_cast(v4i32, acc[ai][bj][m][n]); \
            c_ = __builtin_amdgcn_mfma_i32_16x16x64_i8(__builtin_shufflevector(Bt[n], Bt[n], 0, 1, 2, 3), __builtin_shufflevector(At[m], At[m], 0, 1, 2, 3), c_, 0, 0, 0); \
            c_ = __builtin_amdgcn_mfma_i32_16x16x64_i8(__builtin_shufflevector(Bt[n], Bt[n], 4, 5, 6, 7), __builtin_shufflevector(At[m], At[m], 4, 5, 6, 7), c_, 0, 0, 0); \
            acc[ai][bj][m][n] = __builtin_bit_cast(f32x4, c_); } } \
        else if constexpr (FMT == 2) { _Pragma("unroll") for (int m = 0; m < 4; ++m) _Pragma("unroll") for (int n = 0; n < 2; ++n) { \
            acc[ai][bj][m][n] = __builtin_amdgcn_mfma_f32_16x16x32_bf16(PG8_LO(Bt[n]), PG8_LO(At[m]), acc[ai][bj][m][n], 0, 0, 0); \
            acc[ai][bj][m][n] = __builtin_amdgcn_mfma_f32_16x16x32_bf16(PG8_HI(Bt[n]), PG8_HI(At[m]), acc[ai][bj][m][n], 0, 0, 0); } } \
        else { asm volatile("s_nop 1\n\t" \
            "v_mfma_f32_16x16x128_f8f6f4 %0, %8, %10, %0\n\t" "v_mfma_f32_16x16x128_f8f6f4 %1, %9, %10, %1\n\t" \
            "v_mfma_f32_16x16x128_f8f6f4 %2, %8, %11, %2\n\t" "v_mfma_f32_16x16x128_f8f6f4 %3, %9, %11, %3\n\t" \
            "v_mfma_f32_16x16x128_f8f6f4 %4, %8, %12, %4\n\t" "v_mfma_f32_16x16x128_f8f6f4 %5, %9, %12, %5\n\t" \
            "v_mfma_f32_16x16x128_f8f6f4 %6, %8, %13, %6\n\t" "v_mfma_f32_16x16x128_f8f6f4 %7, %9, %13, %7\n\t" \
            "s_nop 11" \
            : "+v"(acc[ai][bj][0][0]), "+v"(acc[ai][bj][0][1]), "+v"(acc[ai][bj][1][0]), "+v"(acc[ai][bj][1][1]), "+v"(acc[ai][bj][2][0]), "+v"(acc[ai][bj][2][1]), "+v"(acc[ai][bj][3][0]), "+v"(acc[ai][bj][3][1]) \
            : "v"(Bt[0]), "v"(Bt[1]), "v"(At[0]), "v"(At[1]), "v"(At[2]), "v"(At[3]), "v"(scl8)); } \
        __builtin_amdgcn_s_setprio(0); } while (0)
#define PG8_WAIT_V(n) asm volatile("s_waitcnt vmcnt(" #n ")" ::: "memory")
#define PG8_WAIT_L(n) asm volatile("s_waitcnt lgkmcnt(" #n ")" ::: "memory")
#define PG8_BAR __builtin_amdgcn_s_barrier()
#define PG8_SCHED __builtin_amdgcn_sched_barrier(0)
    Unit cur, nxt; int ui = 0;
    if (!S.next(0, cur)) return;
    f32x4 acc[2][2][4][2];
#pragma unroll
    for (int a = 0; a < 2; ++a)
#pragma unroll
        for (int b = 0; b < 2; ++b)
#pragma unroll
            for (int m = 0; m < 4; ++m)
#pragma unroll
                for (int n = 0; n < 2; ++n) acc[a][b][m][n] = (f32x4){0.f, 0.f, 0.f, 0.f};
    v8i32 At[4], B0[2], B1[2];
    const int scl8 = 0x7F7F7F7F;
    const char* cA = (const char*)g.A + (size_t)cur.pa * tstepA; const char* cB = (const char*)g.Bt + (size_t)cur.pn * tstepB;
    PG8_STAGE(PG8_SB(0, 0), cB, voffB); PG8_STAGE(PG8_SB(0, 1), cB + hstepB, voffB); PG8_STAGE(PG8_SA(0, 0), cA, voffA); PG8_STAGE(PG8_SA(0, 1), cA + hstepA, voffA);
    if (wr == 1) PG8_BAR;
    PG8_WAIT_V(2); PG8_BAR;
    PG8_STAGE(PG8_SB(1, 0), cB + kstep, voffB); PG8_STAGE(PG8_SA(1, 0), cA + kstep, voffA); PG8_STAGE(PG8_SB(1, 1), cB + hstepB + kstep, voffB);
    PG8_WAIT_V(6); PG8_BAR;
    for (;;) {
        const bool has_next = S.next(ui + 1, nxt);
        const char* nA = has_next ? (const char*)g.A + (size_t)nxt.pa * tstepA : cA; const char* nB = has_next ? (const char*)g.Bt + (size_t)nxt.pn * tstepB : cB;
#pragma unroll 1
        for (int t = 0; t < nt; t += 2) {
            const bool last = (t == nt - 2);
            const char* a1 = cA + (size_t)(t + 1) * kstep;
            const char* a2 = last ? nA : cA + (size_t)(t + 2) * kstep; const char* b2 = last ? nB : cB + (size_t)(t + 2) * kstep;
            const char* a3 = a2 + kstep; const char* b3 = b2 + kstep;
            PG8_LDB(B0, 0, 0); PG8_LDB(B1, 0, 1); PG8_SCHED; PG8_LDA(At, 0, 0); PG8_STAGE(PG8_SA(1, 1), a1 + hstepA, voffA);
            PG8_WAIT_V(8); PG8_WAIT_L(0); PG8_BAR; PG8_MMA(0, 0, At, B0); PG8_MMA(0, 1, At, B1); PG8_BAR; PG8_SCHED;
            PG8_LDA(At, 0, 1); PG8_STAGE(PG8_SB(0, 0), b2, voffB); PG8_STAGE(PG8_SB(0, 1), b2 + hstepB, voffB); PG8_STAGE(PG8_SA(0, 0), a2, voffA);
            PG8_WAIT_V(8); PG8_WAIT_L(0); PG8_BAR; PG8_MMA(1, 0, At, B0); PG8_MMA(1, 1, At, B1); PG8_BAR; PG8_SCHED;
            PG8_LDB(B0, 1, 0); PG8_LDB(B1, 1, 1); PG8_SCHED; PG8_LDA(At, 1, 0); PG8_STAGE(PG8_SA(0, 1), a2 + hstepA, voffA);
            PG8_WAIT_V(8); PG8_WAIT_L(0); PG8_BAR; PG8_MMA(0, 0, At, B0); PG8_MMA(0, 1, At, B1); PG8_BAR; PG8_SCHED;
            PG8_LDA(At, 1, 1); PG8_STAGE(PG8_SB(1, 0), b3, voffB); PG8_STAGE(PG8_SB(1, 1), b3 + hstepB, voffB); PG8_STAGE(PG8_SA(1, 0), a3, voffA);
            PG8_WAIT_V(8); PG8_WAIT_L(0); PG8_BAR; PG8_MMA(1, 0, At, B0); PG8_MMA(1, 1, At, B1); PG8_BAR; PG8_SCHED;
        }
        if (wr == 0) PG8_BAR;
        E(acc, cur, wr, wc, fr, fq);
        if (!has_next) break;
#pragma unroll
        for (int a = 0; a < 2; ++a)
#pragma unroll
            for (int b = 0; b < 2; ++b)
#pragma unroll
                for (int m = 0; m < 4; ++m)
#pragma unroll
                    for (int n = 0; n < 2; ++n) acc[a][b][m][n] = (f32x4){0.f, 0.f, 0.f, 0.f};
        cur = nxt; cA = nA; cB = nB; ++ui;
        if (wr == 1) PG8_BAR;
    }
    PG8_WAIT_V(0);
    PG8_BAR;
#undef PG8_SA
#undef PG8_SB
#undef PG8_STAGE
#undef PG8_LDA
#undef PG8_LD8
#undef PG8_LO
#undef PG8_HI
#undef PG8_LDB
#undef PG8_MMA
#undef PG8_WAIT_V
#undef PG8_WAIT_L
#undef PG8_BAR
#undef PG8_SCHED
}

struct EpiBf16S {
    static constexpr bool PERM = true;
    bf16_t* O; int ldc; int ncol_tiles; const float* rowscale; float scale;
    __device__ __forceinline__ void operator()(const f32x4 (&acc)[2][2][4][2], const Unit& u, int wr, int wc, int fr, int fq) const {
        const int row0 = u.pm * BM + wr * 64 + fr, col0 = (u.pn % ncol_tiles) * BM + wc * 32 + 8 * fq;
        float rsv[2][4];
#pragma unroll
        for (int ai = 0; ai < 2; ++ai)
#pragma unroll
            for (int m = 0; m < 4; ++m) rsv[ai][m] = rowscale ? rowscale[(ptrdiff_t)u.ro + row0 + ai * HALF + m * 16] * scale : scale;
#pragma unroll
        for (int ai = 0; ai < 2; ++ai)
#pragma unroll
            for (int m = 0; m < 4; ++m) { const int row = row0 + ai * HALF + m * 16; bf16_t* rowp = O + (size_t)row * ldc + col0; const float rs = rsv[ai][m];
#pragma unroll
                for (int bj = 0; bj < 2; ++bj) { const f32x4 v0 = acc[ai][bj][m][0] * rs, v1 = acc[ai][bj][m][1] * rs;
                    u32x4 w; w.x = pk_bf16(v0[0], v0[1]); w.y = pk_bf16(v0[2], v0[3]); w.z = pk_bf16(v1[0], v1[1]); w.w = pk_bf16(v1[2], v1[3]);
                    *(u32x4*)(rowp + bj * HALF) = w; } }
    }
};
struct EpiBf16 {
    static constexpr bool PERM = true;
    bf16_t* O; int ldc;
    __device__ __forceinline__ void operator()(const f32x4 (&acc)[2][2][4][2], const Unit& u, int wr, int wc, int fr, int fq) const {
        const int row0 = u.pm * BM + wr * 64 + fr, col0 = u.pn * BM + wc * 32 + 8 * fq;
#pragma unroll
        for (int ai = 0; ai < 2; ++ai)
#pragma unroll
            for (int m = 0; m < 4; ++m) { bf16_t* rowp = O + (size_t)(row0 + ai * HALF + m * 16) * ldc + col0;
#pragma unroll
                for (int bj = 0; bj < 2; ++bj) { const f32x4 v0 = acc[ai][bj][m][0], v1 = acc[ai][bj][m][1];
                    u32x4 w; w.x = pk_bf16(v0[0], v0[1]); w.y = pk_bf16(v0[2], v0[3]); w.z = pk_bf16(v1[0], v1[1]); w.w = pk_bf16(v1[2], v1[3]);
                    *(u32x4*)(rowp + bj * HALF) = w; } }
    }
};
template <int NS> struct EpiBf16N {
    static constexpr bool PERM = true;
    bf16_t* O; int ldc; const float* ssq; float invn;
    __device__ __forceinline__ void operator()(const f32x4 (&acc)[2][2][4][2], const Unit& u, int wr, int wc, int fr, int fq) const {
        const int row0 = u.pm * BM + wr * 64 + fr, col0 = u.pn * BM + wc * 32 + 8 * fq;
        float rsv[2][4];
#pragma unroll
        for (int ai = 0; ai < 2; ++ai)
#pragma unroll
            for (int m = 0; m < 4; ++m) { const float* sp = ssq + (size_t)(row0 + ai * HALF + m * 16) * 16; const f32x4 a = *(const f32x4*)sp; float t = (a[0] + a[1]) + (a[2] + a[3]);
                if (NS == 8) { const f32x4 b = *(const f32x4*)(sp + 4); t += (b[0] + b[1]) + (b[2] + b[3]); }
                rsv[ai][m] = rsqrtf(t * invn + EPSN); }
#pragma unroll
        for (int ai = 0; ai < 2; ++ai)
#pragma unroll
            for (int m = 0; m < 4; ++m) { bf16_t* rowp = O + (size_t)(row0 + ai * HALF + m * 16) * ldc + col0; const float rs = rsv[ai][m];
#pragma unroll
                for (int bj = 0; bj < 2; ++bj) { const f32x4 v0 = acc[ai][bj][m][0] * rs, v1 = acc[ai][bj][m][1] * rs;
                    u32x4 w; w.x = pk_bf16(v0[0], v0[1]); w.y = pk_bf16(v0[2], v0[3]); w.z = pk_bf16(v1[0], v1[1]); w.w = pk_bf16(v1[2], v1[3]);
                    *(u32x4*)(rowp + bj * HALF) = w; } }
    }
};
template <bool OUT8> struct EpiSwiGLU {
    static constexpr bool PERM = true;
    unsigned char* O; int ldc; int ncol_tiles; const float* rowscale; const float* colscale;
    __device__ __forceinline__ void operator()(const f32x4 (&acc)[2][2][4][2], const Unit& u, int wr, int wc, int fr, int fq) const {
        const int row0 = u.pm * BM + wr * 64 + fr, col0 = (u.pn % ncol_tiles) * HALF + wc * 32 + 8 * fq;
        const float cg = colscale[(size_t)u.pn * BM + wc * 32], cu = colscale[(size_t)u.pn * BM + HALF + wc * 32];
        const float cgl = cg * (-LOG2E), cgu = cg * cu;
        float rsv[2][4];
#pragma unroll
        for (int ai = 0; ai < 2; ++ai)
#pragma unroll
            for (int m = 0; m < 4; ++m) rsv[ai][m] = rowscale[(ptrdiff_t)u.ro + row0 + ai * HALF + m * 16];
#pragma unroll
        for (int ai = 0; ai < 2; ++ai)
#pragma unroll
            for (int m = 0; m < 4; ++m) { const int row = row0 + ai * HALF + m * 16; unsigned char* rowp = O + ((size_t)row * ldc + col0) * (OUT8 ? 1 : 2);
                const float rs = rsv[ai][m], kt = rs * cgl, iko = fast_rcp((rs * rs) * cgu);
                const v4i32 ig0 = __builtin_bit_cast(v4i32, acc[ai][0][m][0]), ig1 = __builtin_bit_cast(v4i32, acc[ai][0][m][1]), iu0 = __builtin_bit_cast(v4i32, acc[ai][1][m][0]), iu1 = __builtin_bit_cast(v4i32, acc[ai][1][m][1]);
                f32x2 g[4], uu[4], e[4], a[4];
#pragma unroll
                for (int k = 0; k < 2; ++k) { g[k] = (f32x2){(float)ig0[2 * k], (float)ig0[2 * k + 1]}; g[2 + k] = (f32x2){(float)ig1[2 * k], (float)ig1[2 * k + 1]}; uu[k] = (f32x2){(float)iu0[2 * k], (float)iu0[2 * k + 1]}; uu[2 + k] = (f32x2){(float)iu1[2 * k], (float)iu1[2 * k + 1]}; }
#pragma unroll
                for (int k = 0; k < 4; ++k) e[k] = g[k] * kt;
#pragma unroll
                for (int k = 0; k < 4; ++k) { e[k].x = fast_exp2(e[k].x); e[k].y = fast_exp2(e[k].y); }
#pragma unroll
                for (int k = 0; k < 4; ++k) a[k] = g[k] * uu[k];
#pragma unroll
                for (int k = 0; k < 4; ++k) e[k] = e[k] * iko + iko;
#pragma unroll
                for (int k = 0; k < 4; ++k) { e[k].x = fast_rcp(e[k].x); e[k].y = fast_rcp(e[k].y); }
#pragma unroll
                for (int k = 0; k < 4; ++k) a[k] = a[k] * e[k];
                if (OUT8) { u32x2 w; w.x = pk_fp8x4(a[0].x, a[0].y, a[1].x, a[1].y); w.y = pk_fp8x4(a[2].x, a[2].y, a[3].x, a[3].y); *(u32x2*)rowp = w; }
                else { u32x4 w; w.x = pk_bf16(a[0].x, a[0].y); w.y = pk_bf16(a[1].x, a[1].y); w.z = pk_bf16(a[2].x, a[2].y); w.w = pk_bf16(a[3].x, a[3].y); *(u32x4*)rowp = w; } }
    }
};
template <int MODE> struct EpiRope {
    static constexpr bool PERM = false;
    bf16_t* O; int ldc; const float* tab;
    const float* rowscale; const float* colscale;
    float* ssq;
    __device__ __forceinline__ static int kind(int gi) {
        if (MODE == 0) return (gi >= 48 && gi < 68) ? 1 + (gi & 1) : 0;
        if (MODE == 1) return gi == 12 ? 3 : ((gi >= 16 && gi < 48) ? 1 + (gi & 1) : 0);
        return (gi == 2 || gi == 5 || gi == 8 || gi == 11 || gi == 14 || gi == 17 || gi == 20 || gi == 23) ? 3 : 0;
    }
    __device__ __forceinline__ void operator()(const f32x4 (&acc)[2][2][4][2], const Unit& u, int wr, int wc, int fr, int fq) const {
        const int row0 = u.pm * BM + wr * 64 + fr;
        const bool lat = u.pm < (MLAT / BM);
        float rsv[2][4];
#pragma unroll
        for (int ai = 0; ai < 2; ++ai)
#pragma unroll
            for (int m = 0; m < 4; ++m) rsv[ai][m] = rowscale[(ptrdiff_t)u.ro + row0 + ai * HALF + m * 16];
#pragma unroll
        for (int bj = 0; bj < 2; ++bj) {
            const int gi = u.pn * 8 + bj * 4 + wc; const int kd = lat ? kind(gi) : 0;
            const int col0 = gi * 32 + 4 * fq;
            const f32x4 cs1 = *(const f32x4*)(colscale + col0), cs2 = *(const f32x4*)(colscale + col0 + 16);
#pragma unroll
            for (int ai = 0; ai < 2; ++ai)
#pragma unroll
                for (int m = 0; m < 4; ++m) {
                    const int row = row0 + ai * HALF + m * 16; bf16_t* rowp = O + (size_t)row * ldc + col0;
                    const float rsc = rsv[ai][m]; const v4i32 i1 = __builtin_bit_cast(v4i32, acc[ai][bj][m][0]), i2 = __builtin_bit_cast(v4i32, acc[ai][bj][m][1]);
                    f32x4 x1, x2;
#pragma unroll
                    for (int k = 0; k < 4; ++k) { x1[k] = (float)i1[k] * (rsc * cs1[k]); x2[k] = (float)i2[k] * (rsc * cs2[k]); }
                    if (kd != 0) {
                        const int s = row & (SEQ - 1), gr = s >> 6, gc = s & 63;
                        f32x4 cs, sn;
                        if (kd == 3) { const int pos = fq < 2 ? gr : gc; cs = *(const f32x4*)(tab + 2048 + pos * 8 + 4 * (fq & 1)); sn = *(const f32x4*)(tab + 2048 + 512 + pos * 8 + 4 * (fq & 1)); }
                        else { const int pos = kd == 1 ? gr : gc; cs = *(const f32x4*)(tab + pos * 16 + 4 * fq); sn = *(const f32x4*)(tab + 1024 + pos * 16 + 4 * fq); }
                        const f32x4 o1 = x1 * cs - x2 * sn, o2 = x2 * cs + x1 * sn; x1 = o1; x2 = o2;
                    }
                    u32x2 w0, w1; w0.x = pk_bf16(x1[0], x1[1]); w0.y = pk_bf16(x1[2], x1[3]); w1.x = pk_bf16(x2[0], x2[1]); w1.y = pk_bf16(x2[2], x2[3]);
                    if (MODE == 1 && (u.pn == 0 || (u.pn == 1 && bj == 0))) {
                        float ss = bf_lo(w0.x) * bf_lo(w0.x) + bf_hi(w0.x) * bf_hi(w0.x) + bf_lo(w0.y) * bf_lo(w0.y) + bf_hi(w0.y) * bf_hi(w0.y) + bf_lo(w1.x) * bf_lo(w1.x) + bf_hi(w1.x) * bf_hi(w1.x) + bf_lo(w1.y) * bf_lo(w1.y) + bf_hi(w1.y) * bf_hi(w1.y);
                        { const auto rr = __builtin_amdgcn_permlane16_swap(__float_as_uint(ss), __float_as_uint(ss), false, false); ss = __uint_as_float(rr[0]) + __uint_as_float(rr[1]); }
                        { const auto rr = __builtin_amdgcn_permlane32_swap(__float_as_uint(ss), __float_as_uint(ss), false, false); ss = __uint_as_float(rr[0]) + __uint_as_float(rr[1]); }
                        if (fq == 0) ssq[(size_t)row * 16 + (u.pn == 0 ? bj * 4 + wc : 8 + wc)] = ss;
                    }
                    { const auto r = __builtin_amdgcn_permlane16_swap(w0.x, w1.x, false, false); w0.x = r[0]; w1.x = r[1]; }
                    { const auto r = __builtin_amdgcn_permlane16_swap(w0.y, w1.y, false, false); w0.y = r[0]; w1.y = r[1]; }
                    *(u32x4*)(rowp + ((fq & 1) ? 12 : 0)) = (u32x4){w0.x, w0.y, w1.x, w1.y};
                    asm volatile("" ::: "memory");
                }
        }
    }
};
}

__device__ __forceinline__ unsigned char* fresh_ws() {
    static_assert(offsetof(Params, ws) == 200, "Params layout");
    unsigned long long w; const unsigned long long ka = (unsigned long long)__builtin_amdgcn_kernarg_segment_ptr();
    asm volatile("s_load_dwordx2 %0, %1, 0xc8\n\ts_waitcnt lgkmcnt(0)" : "=s"(w) : "s"(ka) : "memory");
    return (unsigned char*)(__attribute__((address_space(1))) unsigned char*)w;
}
__device__ __forceinline__ int rope_orig(int p) { return p < 8 ? p : (p < 16 ? 16 + (p - 8) : (p < 24 ? 8 + (p - 16) : p)); }

struct ConvJob { const float* src; bf16_t* dst; const float* scale; int Ksrc, Nsrc, Kdst, nb, kb, map, f8; };
constexpr float W8_SCALE = 64.0f;
constexpr int CJ_NMAT[10]  = {0, 2, 0, 2, 2, 2, 0, 2, 0, 16};
constexpr int CJ_NB[10]    = {18, 8, 16, 6, 8, 8, 44, 8, 56, 8};
constexpr int CJ_KB[10]    = {16, 16, 16, 4, 4, 16, 16, FFN_DOWN_FP8 ? 22 : 44, 16, FFN_DOWN_FP8 ? 28 : 56};
__device__ __forceinline__ int conv_tiles(int j) { return CJ_NMAT[j] * CJ_NB[j] * CJ_KB[j]; }
constexpr int conv_tiles_total() { int s = 0; for (int j = 0; j < 10; ++j) s += CJ_NMAT[j] * CJ_NB[j] * CJ_KB[j]; return s; }
__device__ __forceinline__ int conv_map(int map, int n) {
    switch (map) {
    case 0: return n;
    case 1:
        if (n < 256) return n; if (n < 384) return 768 + (n - 256); if (n < 416) return 896 + rope_orig(n - 384); if (n < 512) return -1;
        if (n < 1024) return 256 + (n - 512); if (n < 1536) return 928 + (n - 1024); return 1440 + (n - 1536);
    case 2: { const int h = n / 96, j = n % 96; return j < 64 ? n : h * 96 + 64 + rope_orig(j - 64); }
    case 3: { const int t = n >> 8, r = n & 255; return r < 128 ? t * 128 + r : FFD + t * 128 + (r - 128); }
    default: { const int t = n >> 8, r = n & 255; return r < 128 ? t * 128 + r : FFE + t * 128 + (r - 128); }
    }
}
__device__ __forceinline__ ConvJob conv_job(const Params& p, unsigned char* ws, int j, int mat) {
    ConvJob c; c.scale = nullptr; c.map = 0; c.nb = CJ_NB[j]; c.kb = CJ_KB[j]; c.f8 = FFN_DOWN_FP8 && (j == 7 || j == 9);
    switch (j) {
    case 0: c.src = p.in[7] + (size_t)mat * 1024 * EVEN_IN; c.dst = (bf16_t*)(ws + OFF_WINE + mat * SZ_WINE); c.Ksrc = 1024; c.Nsrc = EVEN_IN; c.Kdst = 1024; break;
    case 1: c.src = p.in[10] + (size_t)mat * 1024 * 1024; c.dst = (bf16_t*)(ws + OFF_WOUTE + mat * SZ_WOUT); c.Ksrc = 1024; c.Nsrc = 1024; c.Kdst = 1024; break;
    case 2: c.src = p.in[11] + (size_t)mat * 1024 * 1952; c.dst = (bf16_t*)(ws + OFF_WINO + mat * SZ_WINO); c.Ksrc = 1024; c.Nsrc = 1952; c.Kdst = 1024; c.map = 1; break;
    case 3: c.src = p.in[14] + (size_t)mat * 256 * 768; c.dst = (bf16_t*)(ws + OFF_WQUP + mat * SZ_WQUP); c.Ksrc = 256; c.Nsrc = 768; c.Kdst = 256; c.map = 2; c.scale = p.in[12] + mat * 256; break;
    case 4: c.src = p.in[15] + (size_t)mat * 128 * 1024; c.dst = (bf16_t*)(ws + OFF_WKVUP + mat * SZ_WKVUP); c.Ksrc = 128; c.Nsrc = 1024; c.Kdst = 256; c.scale = p.in[13] + mat * 128; break;
    case 5: c.src = p.in[18] + (size_t)mat * 1024 * 1024; c.dst = (bf16_t*)(ws + OFF_WOUTO + mat * SZ_WOUT); c.Ksrc = 1024; c.Nsrc = 1024; c.Kdst = 1024; break;
    case 6: c.src = p.in[19] + (size_t)mat * 1024 * 2 * FFD; c.dst = (bf16_t*)(ws + OFF_WGU + mat * SZ_WGU); c.Ksrc = 1024; c.Nsrc = 2 * FFD; c.Kdst = 1024; c.map = 3; break;
    case 7: c.src = p.in[20] + (size_t)mat * FFD * 1024; c.dst = (bf16_t*)(ws + OFF_WDN + mat * SZ_WDN); c.Ksrc = FFD; c.Nsrc = 1024; c.Kdst = FFD; break;
    case 8: c.src = p.in[22] + (size_t)mat * 1024 * 2 * FFE; c.dst = (bf16_t*)(ws + OFF_WEGU + mat * (SZ_WEGU / 2)); c.Ksrc = 1024; c.Nsrc = 2 * FFE; c.Kdst = 1024; c.map = 4; break;
    default: c.src = p.in[23] + (size_t)mat * FFE * 1024; c.dst = (bf16_t*)(ws + OFF_WEDN + mat * (SZ_WEDN / (FFN_DOWN_FP8 ? 2 : 1))); c.Ksrc = FFE; c.Nsrc = 1024; c.Kdst = FFE; break;
    }
    return c;
}

constexpr int CV_NU_D = 2 * (2 * FFD / 64), CV_NU_IE = 2 * (EVEN_IN / 64), CV_NU_IO = 2 * (ODD_INP / 64), CV_NU_E = 16 * (2 * FFE / 64), CV_NU_PRO = CV_NU_D + CV_NU_IE + CV_NU_IO, CV_NU = CV_NU_PRO + CV_NU_E;
constexpr int TAIL_U_SPLIT = 560, TAIL_T_SPLIT = 1100;
constexpr int CV_NT = conv_tiles_total(), CV_NT_E = CJ_NMAT[9] * CJ_NB[9] * CJ_KB[9], CV_NT_PRO = CV_NT - CV_NT_E;
__device__ __forceinline__ void conv_units(const Params& p, LAS unsigned char* lds, const int tid, int lo, int hi, int first, int stride) {
    unsigned char* ws = fresh_ws();
    __syncthreads();
    {
        constexpr int WP = 2052;
        LAS unsigned char* wl = lds;
        LAS float* cmx = (LAS float*)(lds + 64 * WP);
        constexpr int NU_D = CV_NU_D, NU_E = CV_NU_E, NU_IE = CV_NU_IE, NU_IO = CV_NU_IO;
        const int cq = tid & 15, rg = tid >> 4, wvn = tid >> 6, col = tid >> 3, piece = tid & 7;
        struct U8 { const float* sp; unsigned char* dst; float* wsc; int Nsrc, ok, blk; };
        auto decode = [&](int u) -> U8 {
            const int cat = u < NU_D ? 0 : (u < NU_D + NU_IE ? 2 : (u < NU_D + NU_IE + NU_IO ? 3 : 1));
            const int uu = u - (cat == 0 ? 0 : (cat == 2 ? NU_D : (cat == 3 ? NU_D + NU_IE : NU_D + NU_IE + NU_IO)));
            const int Ndst = cat == 0 ? 2 * FFD : (cat == 1 ? 2 * FFE : (cat == 2 ? EVEN_IN : ODD_INP)), nbp = Ndst / 64, mat = uu / nbp, nbi = uu % nbp;
            U8 U; U.Nsrc = cat == 3 ? 1952 : Ndst;
            const float* src = (cat == 0 ? p.in[19] : (cat == 1 ? p.in[22] : (cat == 2 ? p.in[7] : p.in[11]))) + (size_t)mat * 1024 * U.Nsrc;
            unsigned char* dstb = cat == 0 ? ws + OFF_WGU + (size_t)mat * SZ_WGU : (cat == 1 ? ws + OFF_WEGU + (size_t)mat * (SZ_WEGU / 2) : (cat == 2 ? ws + OFF_WINE + (size_t)mat * SZ_WINE : ws + OFF_WINO + (size_t)mat * SZ_WINO));
            float* wscb = (cat == 0 ? (float*)(ws + OFF_WSCD) : (cat == 1 ? (float*)(ws + OFF_WSCE) : (cat == 2 ? (float*)(ws + OFF_WSCI) : (float*)(ws + OFF_WSCI) + 2 * EVEN_IN))) + (size_t)mat * Ndst;
            const int cmap = cat == 0 ? 3 : (cat == 1 ? 4 : (cat == 2 ? 0 : 1));
            const int sc = conv_map(cmap, nbi * 64 + cq * 4);
            U.blk = cat < 2; U.ok = sc >= 0; U.sp = src + (size_t)rg * U.Nsrc + (sc >= 0 ? sc : 0); U.dst = dstb + (size_t)(nbi * 64) * 1024; U.wsc = wscb + nbi * 64; return U; };
        auto ldg = [&](const float*& ptr, size_t step, int ok, f32x4 (&v)[8]) {
#pragma unroll
            for (int i = 0; i < 8; ++i) { v[i] = ok ? __builtin_nontemporal_load((const f32x4*)ptr) : (f32x4){0.f, 0.f, 0.f, 0.f}; ptr += step; } };
        auto consume = [&](int q, const f32x4 (&v)[8], f32x4& cm) {
#pragma unroll
            for (int i = 0; i < 8; ++i) { cm = __builtin_elementwise_max(cm, __builtin_elementwise_abs(v[i]));
                const unsigned w0 = pk_bf16(v[i][0], v[i][1]), w1 = pk_bf16(v[i][2], v[i][3]);
                LAS unsigned short* bp = (LAS unsigned short*)(wl + (cq * 4) * WP + ((q * 8 + i) * 32 + rg) * 2);
                bp[0] = (unsigned short)w0; bp[WP / 2] = (unsigned short)(w0 >> 16); bp[WP] = (unsigned short)w1; bp[3 * (WP / 2)] = (unsigned short)(w1 >> 16); } };
        int u = lo + first;
        if (u < hi) {
            U8 U = decode(u);
            f32x4 q0[8], q1[8], q2[8], q3[8];
            const float* lp = U.sp; size_t lstep = (size_t)32 * U.Nsrc; int lok = U.ok;
            ldg(lp, lstep, lok, q0); ldg(lp, lstep, lok, q1);
#pragma unroll 1
            for (;;) {
                const int un = u + stride; const bool hn = un < hi;
                U8 Un = U; if (hn) Un = decode(un);
                f32x4 cm = (f32x4){0.f, 0.f, 0.f, 0.f};
                ldg(lp, lstep, lok, q2); consume(0, q0, cm);
                ldg(lp, lstep, lok, q3); consume(1, q1, cm);
                lp = Un.sp; lstep = (size_t)32 * Un.Nsrc; lok = Un.ok;
                if (hn) ldg(lp, lstep, lok, q0);
                consume(2, q2, cm);
                if (hn) ldg(lp, lstep, lok, q1);
                consume(3, q3, cm);
#pragma unroll
                for (int c = 0; c < 4; ++c) { float v = cm[c];
                    { const auto rr = __builtin_amdgcn_permlane16_swap(__float_as_uint(v), __float_as_uint(v), false, false); v = fmaxf(__uint_as_float(rr[0]), __uint_as_float(rr[1])); }
                    { const auto rr = __builtin_amdgcn_permlane32_swap(__float_as_uint(v), __float_as_uint(v), false, false); v = fmaxf(__uint_as_float(rr[0]), __uint_as_float(rr[1])); }
                    cm[c] = v; }
                if ((tid & 63) < 16) *(LAS f32x4*)(cmx + wvn * 64 + cq * 4) = cm;
                __syncthreads();
                float mx = 0.f;
#pragma unroll
                for (int w = 0; w < 8; ++w) mx = fmaxf(mx, cmx[w * 64 + col]);
                if (U.blk) {
                    mx = wave_max(mx); if ((tid & 63) == 0) cmx[512 + wvn] = mx; __syncthreads();
#pragma unroll
                    for (int w = 0; w < 8; ++w) mx = fmaxf(mx, cmx[512 + w]);
                }
                mx = mx > 0.f ? mx : 1.0f;
                const float inv = 127.0f / mx;
                if (piece == 0) U.wsc[col] = mx * (1.0f / 127.0f);
#pragma unroll 2
                for (int it = 0; it < 8; ++it) {
                    const int k0 = it * 128 + piece * 16;
                    const LAS unsigned* rp = (const LAS unsigned*)(wl + col * WP + k0 * 2);
                    unsigned w[8];
#pragma unroll
                    for (int j = 0; j < 8; ++j) w[j] = rp[j];
                    u32x4 o;
#pragma unroll
                    for (int j = 0; j < 4; ++j) o[j] = pk_i8x4(bf_lo(w[2 * j]) * inv, bf_hi(w[2 * j]) * inv, bf_lo(w[2 * j + 1]) * inv, bf_hi(w[2 * j + 1]) * inv);
                    *(u32x4*)(U.dst + (size_t)col * 1024 + k0) = o;
                }
                __syncthreads();
                if (!hn) break;
                U = Un; u = un;
            }
        }
    }
    __syncthreads();
}

__device__ __forceinline__ void conv_tiles_run(const Params& p, LAS unsigned char* lds, const int tid, int lo, int hi, int first, int stride) {
    unsigned char* ws = fresh_ws();
    const int ng = tid & 31, kgq = tid >> 5;
    const int orow = tid >> 2, oq = tid & 3;
    {
        __syncthreads();
        struct TileRef { ConvJob c; int nbi, kbi; };
        auto decode = [&](int t) -> TileRef {
            int j = 0, rem = t;
#pragma unroll 1
            for (; j < 9; ++j) { const int n = conv_tiles(j); if (rem < n) break; rem -= n; }
            const int per = CJ_NB[j] * CJ_KB[j], mat = rem / per, r2 = rem % per;
            TileRef T; T.c = conv_job(p, ws, j, mat); T.kbi = r2 / T.c.nb; T.nbi = r2 % T.c.nb; return T; };
        auto issue = [&](const TileRef& T, f32x4 (&v)[8], float (&ks)[8]) {
            const int n0 = T.nbi * 128 + ng * 4, k0 = T.kbi * (T.c.f8 ? 128 : 64) + kgq * 4, sc = conv_map(T.c.map, n0);
#pragma unroll
            for (int r = 0; r < 8; ++r) { const int k = k0 + (r >> 2) * 64 + (r & 3);
                if ((r < 4 || T.c.f8) && sc >= 0 && k < T.c.Ksrc) { v[r] = __builtin_nontemporal_load((const f32x4*)(T.c.src + (size_t)k * T.c.Nsrc + sc)); ks[r] = T.c.scale ? T.c.scale[k] : 1.0f; } else { v[r] = (f32x4){0.f, 0.f, 0.f, 0.f}; ks[r] = 0.f; } } };
        auto finish = [&](const TileRef& T, const f32x4 (&v)[8], const float (&ks)[8], int buf) {
            LAS unsigned char* tl = lds + buf * 32768;
            if (T.c.f8) {
#pragma unroll
                for (int h = 0; h < 2; ++h)
#pragma unroll
                    for (int cc = 0; cc < 4; ++cc) *(LAS unsigned*)(tl + (ng * 4 + cc) * 144 + h * 64 + kgq * 4) = pk_fp8x4(v[4 * h][cc] * (ks[4 * h] * W8_SCALE), v[4 * h + 1][cc] * (ks[4 * h + 1] * W8_SCALE), v[4 * h + 2][cc] * (ks[4 * h + 2] * W8_SCALE), v[4 * h + 3][cc] * (ks[4 * h + 3] * W8_SCALE));
                __syncthreads();
                unsigned char* dp = (unsigned char*)T.c.dst + (size_t)(T.nbi * 128 + orow) * T.c.Kdst + T.kbi * 128 + oq * 32;
                *(u32x4*)dp = *(const LAS u32x4*)(tl + orow * 144 + oq * 32); *(u32x4*)(dp + 16) = *(const LAS u32x4*)(tl + orow * 144 + oq * 32 + 16);
            } else {
#pragma unroll
                for (int cc = 0; cc < 4; ++cc) { u32x2 w; w.x = pk_bf16(v[0][cc] * ks[0], v[1][cc] * ks[1]); w.y = pk_bf16(v[2][cc] * ks[2], v[3][cc] * ks[3]); *(LAS u32x2*)(tl + (ng * 4 + cc) * 144 + kgq * 8) = w; }
                __syncthreads();
                bf16_t* dp = T.c.dst + (size_t)(T.nbi * 128 + orow) * T.c.Kdst + T.kbi * 64 + oq * 16;
                *(u32x4*)dp = *(const LAS u32x4*)(tl + orow * 144 + oq * 32); *(u32x4*)(dp + 8) = *(const LAS u32x4*)(tl + orow * 144 + oq * 32 + 16);
            } };
        int t = lo + first;
        if (t < hi) {
            TileRef TA = decode(t), TB = TA; f32x4 va[8], vb[8]; float sa[8], sb[8];
            issue(TA, va, sa);
#pragma unroll 1
            for (;;) {
                int tn = t + stride; bool hn = tn < hi;
                if (hn) { TB = decode(tn); issue(TB, vb, sb); }
                finish(TA, va, sa, 0);
                if (!hn) break;
                t = tn; tn = t + stride; hn = tn < hi;
                if (hn) { TA = decode(tn); issue(TA, va, sa); }
                finish(TB, vb, sb, 1);
                if (!hn) break;
                t = tn;
            }
        }
    }
    __syncthreads();
}

__device__ __forceinline__ void phase_prologue(const Params& p, const int wv, LAS unsigned char* lds) {
    const int tid = opaque_tid(wv);
    unsigned char* ws = p.ws;
    if (blockIdx.x == 0) {
        float* tab = (float*)(ws + OFF_TAB);
        for (int i = tid; i < 1024; i += NTHREADS) { const int pos = i >> 4, f = i & 15; const float inv = 1.0f / powf(10000.0f, (float)(2 * f) / 32.0f); const float ang = (float)pos * inv; tab[i] = cosf(ang); tab[1024 + i] = sinf(ang); }
        for (int i = tid; i < 512; i += NTHREADS) { const int pos = i >> 3, f = i & 7; const float inv = 1.0f / powf(10000.0f, (float)(2 * f) / 16.0f); const float ang = (float)pos * inv; tab[2048 + i] = cosf(ang); tab[2048 + 512 + i] = sinf(ang); }
    }
    {
        LAS float* sv = (LAS float*)lds;
        LAS float* red = (LAS float*)(lds + 36864);
        for (int i = tid; i < 9 * 1024; i += NTHREADS) { const int r = i >> 10, k = i & 1023; const float c = r < 8 ? p.in[1][r * 1024 + k] : p.in[3][k]; sv[i] = c / (1.0f + expf(-c)); }
        __syncthreads();
        for (int u = blockIdx.x; u < 384; u += gridDim.x) {
            const int layer = u / 96, cg = u % 96, cq = tid & 15, kg = tid >> 4;
            f32x4 acc[9];
#pragma unroll
            for (int r = 0; r < 9; ++r) acc[r] = (f32x4){0.f, 0.f, 0.f, 0.f};
            const float* wp = p.in[4] + ((size_t)layer * 1024 + kg * 32) * 6144 + cg * 64 + cq * 4;
#pragma unroll 8
            for (int kk = 0; kk < 32; ++kk) {
                const f32x4 w = __builtin_nontemporal_load((const f32x4*)(wp + (size_t)kk * 6144));
#pragma unroll
                for (int r = 0; r < 9; ++r) acc[r] += w * sv[r * 1024 + kg * 32 + kk];
            }
#pragma unroll
            for (int r = 0; r < 9; ++r) *(LAS f32x4*)(red + (kg * 9 + r) * 64 + cq * 4) = acc[r];
            __syncthreads();
            float* mod = (float*)(ws + OFF_MOD);
            for (int i = tid; i < 9 * 64; i += NTHREADS) { const int r = i >> 6, cc = i & 63; float sacc = 0.f;
#pragma unroll
                for (int g = 0; g < 32; ++g) sacc += red[(g * 9 + r) * 64 + cc];
                mod[((size_t)layer * 9 + r) * 6144 + cg * 64 + cc] = sacc + p.in[5][layer * 6144 + cg * 64 + cc]; }
            __syncthreads();
        }
    }
    conv_units(p, lds, tid, 0, CV_NU_PRO, (int)((blockIdx.x + (gridDim.x >> 1)) % gridDim.x), (int)gridDim.x);
    conv_tiles_run(p, lds, tid, 0, CV_NT_PRO, (int)(gridDim.x - 1 - blockIdx.x), (int)gridDim.x);
}

__device__ __forceinline__ void ld16(const float* p, int lane, float (&v)[16]) {
#pragma unroll
    for (int j = 0; j < 2; ++j) { const f32x4 a = *(const f32x4*)(p + 8 * lane + 512 * j), b = *(const f32x4*)(p + 8 * lane + 512 * j + 4);
        v[8 * j] = a[0]; v[8 * j + 1] = a[1]; v[8 * j + 2] = a[2]; v[8 * j + 3] = a[3]; v[8 * j + 4] = b[0]; v[8 * j + 5] = b[1]; v[8 * j + 6] = b[2]; v[8 * j + 7] = b[3]; }
}
__device__ __forceinline__ void ld16_nt(const float* p, int lane, float (&v)[16]) {
#pragma unroll
    for (int j = 0; j < 2; ++j) { const f32x4 a = __builtin_nontemporal_load((const f32x4*)(p + 8 * lane + 512 * j)), b = __builtin_nontemporal_load((const f32x4*)(p + 8 * lane + 512 * j + 4));
        v[8 * j] = a[0]; v[8 * j + 1] = a[1]; v[8 * j + 2] = a[2]; v[8 * j + 3] = a[3]; v[8 * j + 4] = b[0]; v[8 * j + 5] = b[1]; v[8 * j + 6] = b[2]; v[8 * j + 7] = b[3]; }
}
__device__ __forceinline__ void st16_f32_nt(float* p, int lane, const float (&v)[16]) {
#pragma unroll
    for (int j = 0; j < 2; ++j) { __builtin_nontemporal_store((f32x4){v[8 * j], v[8 * j + 1], v[8 * j + 2], v[8 * j + 3]}, (f32x4*)(p + 8 * lane + 512 * j)); __builtin_nontemporal_store((f32x4){v[8 * j + 4], v[8 * j + 5], v[8 * j + 6], v[8 * j + 7]}, (f32x4*)(p + 8 * lane + 512 * j + 4)); }
}
__device__ __forceinline__ void ld16_bf16(const bf16_t* p, int lane, float (&v)[16]) {
#pragma unroll
    for (int j = 0; j < 2; ++j) { const u32x4 w = *(const u32x4*)(p + 8 * lane + 512 * j);
#pragma unroll
        for (int k = 0; k < 4; ++k) { v[8 * j + 2 * k] = bf_lo(w[k]); v[8 * j + 2 * k + 1] = bf_hi(w[k]); } }
}
__device__ __forceinline__ void st16_f32(float* p, int lane, const float (&v)[16]) {
#pragma unroll
    for (int j = 0; j < 2; ++j) { *(f32x4*)(p + 8 * lane + 512 * j) = (f32x4){v[8 * j], v[8 * j + 1], v[8 * j + 2], v[8 * j + 3]}; *(f32x4*)(p + 8 * lane + 512 * j + 4) = (f32x4){v[8 * j + 4], v[8 * j + 5], v[8 * j + 6], v[8 * j + 7]}; }
}
__device__ __forceinline__ void st16_bf16(bf16_t* p, int lane, const float (&v)[16]) {
#pragma unroll
    for (int j = 0; j < 2; ++j) { u32x4 w; w.x = pk_bf16(v[8 * j], v[8 * j + 1]); w.y = pk_bf16(v[8 * j + 2], v[8 * j + 3]); w.z = pk_bf16(v[8 * j + 4], v[8 * j + 5]); w.w = pk_bf16(v[8 * j + 6], v[8 * j + 7]); *(u32x4*)(p + 8 * lane + 512 * j) = w; }
}
__device__ __forceinline__ float st16_i8_lds(LAS unsigned char* p, int lane, const float (&v)[16]) {
    float mx = 0.f;
#pragma unroll
    for (int k = 0; k < 16; ++k) mx = fmaxf(mx, fabsf(v[k]));
    mx = wave_max(mx); mx = mx > 0.f ? mx : 1.0f;
    const float inv = 127.0f / mx;
#pragma unroll
    for (int j = 0; j < 2; ++j) { u32x2 w; w.x = pk_i8x4(v[8 * j] * inv, v[8 * j + 1] * inv, v[8 * j + 2] * inv, v[8 * j + 3] * inv); w.y = pk_i8x4(v[8 * j + 4] * inv, v[8 * j + 5] * inv, v[8 * j + 6] * inv, v[8 * j + 7] * inv);
        *(LAS u32x2*)(p + 8 * lane + 512 * j) = w; }
    return mx * (1.0f / 127.0f);
}
__device__ __forceinline__ float st16_i8(unsigned char* p, int lane, const float (&v)[16]) {
    float mx = 0.f;
#pragma unroll
    for (int k = 0; k < 16; ++k) mx = fmaxf(mx, fabsf(v[k]));
    mx = wave_max(mx); mx = mx > 0.f ? mx : 1.0f;
    const float inv = 127.0f / mx;
#pragma unroll
    for (int j = 0; j < 2; ++j) { u32x2 w; w.x = pk_i8x4(v[8 * j] * inv, v[8 * j + 1] * inv, v[8 * j + 2] * inv, v[8 * j + 3] * inv); w.y = pk_i8x4(v[8 * j + 4] * inv, v[8 * j + 5] * inv, v[8 * j + 6] * inv, v[8 * j + 7] * inv);
        *(u32x2*)(p + 8 * lane + 512 * j) = w; }
    return mx * (1.0f / 127.0f);
}
__device__ __forceinline__ float sumsq16(const float (&v)[16]) { float s = 0.f;
#pragma unroll
    for (int i = 0; i < 16; ++i) s += v[i] * v[i];
    return wave_sum(s); }
__device__ __forceinline__ const float* modp(const Params& p, int layer, int bidx, int which) { return (const float*)(p.ws + OFF_MOD) + (((size_t)layer * 9 + bidx) * 6 + which) * 1024; }
__device__ __forceinline__ const float* xin_row(const Params& p, int row) { return row < MLAT ? p.in[0] + (size_t)row * DM : p.in[2] + (size_t)(row - MLAT) * DM; }
__device__ __forceinline__ int row_bidx(int row) { return row < MLAT ? (row >> 12) : 8; }

__device__ __forceinline__ void phase_h0(const Params& p, const int wv) {
    const int tid = opaque_tid(wv), lane = tid & 63, wave = tid >> 6;
    bf16_t* abuf = (bf16_t*)(p.ws + OFF_ABUF);
    float gs[16], sh[16];
    int cur = -1;
    const int row0 = blockIdx.x * ROWS_PER_BLOCK + wave;
    constexpr int NI = ROWS_PER_BLOCK / NWAVES;
    float Xb[3][16];
    auto step = [&](int i, float (&x)[16], float (&xn2)[16]) -> bool {
        if (i >= NI) return false;
        const int row = row0 + NWAVES * i, bidx = row_bidx(row);
        if (i + 2 < NI) ld16_nt(xin_row(p, row + 2 * NWAVES), lane, xn2);
        if (bidx != cur) { cur = bidx; float t[16]; ld16(modp(p, 0, bidx, 1), lane, gs); ld16(p.in[6], lane, t);
#pragma unroll
            for (int k = 0; k < 16; ++k) gs[k] = t[k] * (1.0f + gs[k]);
            ld16(modp(p, 0, bidx, 0), lane, sh); }
        const float rstd = rsqrtf(sumsq16(x) * (1.0f / DM) + EPSN);
#pragma unroll
        for (int k = 0; k < 16; ++k) x[k] = x[k] * rstd * gs[k] + sh[k];
        { const float fs = st16_i8((unsigned char*)abuf + (size_t)row * DM, lane, x); if (lane == 0) ((float*)(p.ws + OFF_FSC))[row] = fs; }
        return true;
    };
    ld16_nt(xin_row(p, row0), lane, Xb[0]); ld16_nt(xin_row(p, row0 + NWAVES), lane, Xb[1]);
#pragma unroll 1
    for (int i = 0; i < NI; i += 3) {
        if (!step(i, Xb[0], Xb[2])) break;
        if (!step(i + 1, Xb[1], Xb[0])) break;
        if (!step(i + 2, Xb[2], Xb[1])) break;
    }
}

template <bool ODD>
__device__ __forceinline__ void phase_rowB(const Params& p, const int wv, LAS unsigned char* lds, int layer, const bf16_t* Y, int nrows, bool dummy = false) {
    const int tid = opaque_tid(wv), lane = tid & 63, wave = tid >> 6;
    const bf16_t* xs_in = (const bf16_t*)(p.ws + OFF_XS); bf16_t* xs = (bf16_t*)(p.ws + (dummy ? WS_END : OFF_XS)); bf16_t* abuf = (bf16_t*)(p.ws + (dummy ? WS_END + (size_t)MTOT * DM * 4 : OFF_ABUF));
    const float* ng = p.in[6] + (size_t)layer * 4 * DM;
    float mg1[16], gs2[16], m3[16];
    LAS float* wrt = (LAS float*)lds;
    LAS int* lcnt = (LAS int*)(lds + 32768);
    LAS int* lbase = (LAS int*)(lds + 32768 + 64);
    LAS int* rinfo = (LAS int*)(lds + 32768 + 128);
    LAS float* rwt = (LAS float*)(lds + 32768 + 128 + ROWS_PER_BLOCK * 16);
    LAS unsigned char* stash = lds + 40960;
    if (ODD) {
        const float* wr = p.in[21] + (size_t)(layer >> 1) * DM * NEXP;
        for (int i = tid; i < DM * NEXP; i += NTHREADS) wrt[i] = wr[i];
        if (tid < 8) lcnt[tid] = 0;
        __syncthreads();
    }
    int cur = -1;
    const int row0 = blockIdx.x * ROWS_PER_BLOCK + wave;
    constexpr int NI = ROWS_PER_BLOCK / NWAVES;
    float Yb[3][16], Xb[3][16];
    auto issue = [&](int row, float (&yy)[16], float (&xx)[16]) { ld16_bf16(Y + (size_t)row * DM, lane, yy); if (layer == 0) ld16_nt(xin_row(p, row), lane, xx); else ld16_bf16(xs_in + (size_t)row * DM, lane, xx); };
    auto step = [&](int i, float (&y)[16], float (&x)[16], float (&yn2)[16], float (&xn2)[16]) -> bool {
        const int lrow = wave + NWAVES * i, row = row0 + NWAVES * i, bidx = row_bidx(row);
        if (i >= NI || row >= nrows) return false;
        if (i + 2 < NI && row + 2 * NWAVES < nrows) issue(row + 2 * NWAVES, yn2, xn2);
        if (bidx != cur) { cur = bidx; float t[16]; ld16(modp(p, layer, bidx, 2), lane, mg1); ld16(ng + DM, lane, t);
#pragma unroll
            for (int k = 0; k < 16; ++k) mg1[k] *= t[k];
            ld16(modp(p, layer, bidx, 4), lane, gs2); ld16(ng + 2 * DM, lane, t);
#pragma unroll
            for (int k = 0; k < 16; ++k) gs2[k] = t[k] * (1.0f + gs2[k]);
            ld16(modp(p, layer, bidx, 3), lane, m3); }
        const float rsy = rsqrtf(sumsq16(y) * (1.0f / DM) + EPSN);
#pragma unroll
        for (int k = 0; k < 16; ++k) x[k] = x[k] + mg1[k] * (y[k] * rsy);
        st16_bf16(xs + (size_t)row * DM, lane, x);
        const float rs1 = rsqrtf(sumsq16(x) * (1.0f / DM) + EPSN);
#pragma unroll
        for (int k = 0; k < 16; ++k) y[k] = x[k] * rs1 * gs2[k] + m3[k];
        float fs;
        if (ODD) fs = st16_i8_lds(stash + (size_t)(i < 9 ? wave * 9 + i : wave * 8 + (i - 9)) * 1024, lane, y);
        else { fs = st16_i8((unsigned char*)abuf + (size_t)row * DM, lane, y); if (lane == 0 && !dummy) ((float*)(p.ws + OFF_FSC))[row] = fs; }
        if (ODD) {
            float lg[8];
#pragma unroll
            for (int e = 0; e < 8; ++e) lg[e] = 0.f;
#pragma unroll
            for (int j = 0; j < 4; ++j)
#pragma unroll
                for (int q = 0; q < 4; ++q) { const int col = 8 * lane + 512 * (j >> 1) + 4 * (j & 1) + q; const f32x4 wa = *(const LAS f32x4*)(wrt + col * 8), wb = *(const LAS f32x4*)(wrt + col * 8 + 4); const float f = y[4 * j + q];
                    lg[0] += f * wa[0]; lg[1] += f * wa[1]; lg[2] += f * wa[2]; lg[3] += f * wa[3]; lg[4] += f * wb[0]; lg[5] += f * wb[1]; lg[6] += f * wb[2]; lg[7] += f * wb[3]; }
#pragma unroll
            for (int e = 0; e < 8; ++e) lg[e] = wave_sum(lg[e]);
            int e0 = 0; float l0 = lg[0];
#pragma unroll
            for (int e = 1; e < 8; ++e) if (lg[e] > l0) { l0 = lg[e]; e0 = e; }
            int e1 = e0 == 0 ? 1 : 0; float l1 = -INFINITY;
#pragma unroll
            for (int e = 0; e < 8; ++e) if (e != e0 && lg[e] > l1) { l1 = lg[e]; e1 = e; }
            if (lane == 0) {
                const float w1 = 1.0f / (1.0f + expf(l0 - l1)), w0 = 1.0f - w1;
                const int i0 = __hip_atomic_fetch_add(lcnt + e0, 1, __ATOMIC_RELAXED, __HIP_MEMORY_SCOPE_WORKGROUP);
                const int i1 = __hip_atomic_fetch_add(lcnt + e1, 1, __ATOMIC_RELAXED, __HIP_MEMORY_SCOPE_WORKGROUP);
                rinfo[lrow * 4 + 0] = e0; rinfo[lrow * 4 + 1] = e1; rinfo[lrow * 4 + 2] = i0; rinfo[lrow * 4 + 3] = i1; rwt[lrow * 3] = w0; rwt[lrow * 3 + 1] = w1; rwt[lrow * 3 + 2] = fs;
            }
        }
        return true;
    };
    auto flush = [&](int i_lo, int i_hi) {
        __syncthreads();
        unsigned* cnt = (unsigned*)(p.ws + OFF_CTL) + CW_MOECNT + (layer >> 1) * 64;
        if (tid < 8) lbase[tid] = (int)__hip_atomic_fetch_add(cnt + tid, (unsigned)lcnt[tid], __ATOMIC_RELAXED, __HIP_MEMORY_SCOPE_AGENT);
        __syncthreads();
        int* slot = (int*)(p.ws + OFF_SLOT); float* twt = (float*)(p.ws + OFF_TWT); float* tsc = (float*)(p.ws + OFF_GWT); unsigned char* gbuf = p.ws + OFF_GBUF;
        for (int i = i_lo; i < i_hi; ++i) {
            const int lrow = wave + NWAVES * i, row = row0 + NWAVES * i;
            if (row >= nrows) break;
            const int e0 = rinfo[lrow * 4], e1 = rinfo[lrow * 4 + 1], s0 = lbase[e0] + rinfo[lrow * 4 + 2], s1 = lbase[e1] + rinfo[lrow * 4 + 3];
            const u32x4 v = *(const LAS u32x4*)(stash + (size_t)(i < 9 ? wave * 9 + i : wave * 8 + (i - 9)) * 1024 + lane * 16);
            *(u32x4*)(gbuf + ((size_t)e0 * CAPR + s0) * 1024 + lane * 16) = v;
            *(u32x4*)(gbuf + ((size_t)e1 * CAPR + s1) * 1024 + lane * 16) = v;
            if (lane == 0) { *(int4*)(slot + (size_t)row * 4) = make_int4(e0, s0, e1, s1);
                twt[(size_t)e0 * MTOT + s0] = rwt[lrow * 3]; twt[(size_t)e1 * MTOT + s1] = rwt[lrow * 3 + 1]; tsc[(size_t)e0 * MTOT + s0] = rwt[lrow * 3 + 2]; tsc[(size_t)e1 * MTOT + s1] = rwt[lrow * 3 + 2]; }
        }
        __syncthreads();
        if (tid < 8) lcnt[tid] = 0;
        __syncthreads();
    };
    if (row0 < nrows) issue(row0, Yb[0], Xb[0]);
    if (row0 + NWAVES < nrows) issue(row0 + NWAVES, Yb[1], Xb[1]);
    bool live = true;
#pragma unroll 1
    for (int i = 0; i < 9 && live; i += 3) {
        if (!step(i, Yb[0], Xb[0], Yb[2], Xb[2])) { live = false; break; }
        if (!step(i + 1, Yb[1], Xb[1], Yb[0], Xb[0])) { live = false; break; }
        if (!step(i + 2, Yb[2], Xb[2], Yb[1], Xb[1])) { live = false; break; }
    }
    if (ODD && !dummy) flush(0, 9);
#pragma unroll 1
    for (int i = 9; i < NI && live; i += 3) {
        if (!step(i, Yb[0], Xb[0], Yb[2], Xb[2])) break;
        if (!step(i + 1, Yb[1], Xb[1], Yb[0], Xb[0])) break;
        if (!step(i + 2, Yb[2], Xb[2], Yb[1], Xb[1])) break;
    }
    if (ODD && !dummy) flush(9, NI);
}

struct MoeLayout { int cnt[8], ustart[9], tstart[9]; };
__device__ __forceinline__ MoeLayout moe_layout(const Params& p, int layer) {
    unsigned* cnt = (unsigned*)(p.ws + OFF_CTL) + CW_MOECNT + (layer >> 1) * 64;
    MoeLayout L; int u = 0, t = 0;
#pragma unroll
    for (int e = 0; e < 8; ++e) { const int c = __builtin_amdgcn_readfirstlane((int)__hip_atomic_load(cnt + e, __ATOMIC_RELAXED, __HIP_MEMORY_SCOPE_AGENT)); L.cnt[e] = c; L.ustart[e] = u; L.tstart[e] = t; u += c; t += (c + 255) >> 8; }
    L.ustart[8] = u; L.tstart[8] = t; return L;
}

template <bool MOE>
__device__ __forceinline__ void phase_rowC(const Params& p, const int wv, int layer, const bf16_t* F, bool last, bool dummy = false) {
    const int tid = opaque_tid(wv), lane = tid & 63, wave = tid >> 6;
    const bf16_t* xs_in = (const bf16_t*)(p.ws + OFF_XS); bf16_t* xs = (bf16_t*)(p.ws + (dummy ? WS_END : OFF_XS)); bf16_t* abuf = (bf16_t*)(p.ws + (dummy ? WS_END + (size_t)MTOT * DM * 4 : OFF_ABUF));
    float* outp = dummy ? (float*)xs : p.out;
    const float* ng = p.in[6] + (size_t)layer * 4 * DM;
    float mg3[16], gsn[16], sh[16];
    const int nrows = last ? MLAT : MTOT;
    const bf16_t* eout = (const bf16_t*)(p.ws + OFF_EOUT);
    constexpr int NI = ROWS_PER_BLOCK / NWAVES;
    const int row0 = blockIdx.x * ROWS_PER_BLOCK + wave;
    int my0 = 0, my1 = 0;
    if (MOE) {
        const MoeLayout L = moe_layout(p, layer);
        const int r = row0 + NWAVES * lane;
        if (lane < NI && r < nrows) {
            const int4 si = *(const int4*)((const int*)(p.ws + OFF_SLOT) + (size_t)r * 4);
            int t0 = 0, t1 = 0;
#pragma unroll
            for (int j = 0; j < 8; ++j) { t0 = (j == si.x) ? L.tstart[j] : t0; t1 = (j == si.z) ? L.tstart[j] : t1; }
            my0 = t0 * 256 + si.y; my1 = t1 * 256 + si.w;
        }
    }
    float Fb[3][16], Gb[3][16], Xb[3][16];
    auto issue = [&](int i, int row, float (&ff)[16], float (&gg)[16], float (&xx)[16]) {
        if (MOE) { const int a0 = __builtin_amdgcn_readlane(my0, i), a1 = __builtin_amdgcn_readlane(my1, i); ld16_bf16(eout + (size_t)a0 * DM, lane, ff); ld16_bf16(eout + (size_t)a1 * DM, lane, gg); }
        else ld16_bf16(F + (size_t)row * DM, lane, ff);
        ld16_bf16(xs_in + (size_t)row * DM, lane, xx);
    };
    int cur = -1;
    auto step = [&](int i, float (&f)[16], float (&f1)[16], float (&x)[16], float (&fn2)[16], float (&gn2)[16], float (&xn2)[16]) -> bool {
        const int row = row0 + NWAVES * i, bidx = row_bidx(row);
        if (i >= NI || row >= nrows) return false;
        constexpr int AHEAD = MOE ? 1 : 2;
        if (i + AHEAD < NI && row + AHEAD * NWAVES < nrows) issue(i + AHEAD, row + AHEAD * NWAVES, fn2, gn2, xn2);
        if (MOE) {
#pragma unroll
            for (int k = 0; k < 16; ++k) f[k] += f1[k];
        }
        if (bidx != cur) { cur = bidx; float t[16]; ld16(modp(p, layer, bidx, 5), lane, mg3); ld16(ng + 3 * DM, lane, t);
#pragma unroll
            for (int k = 0; k < 16; ++k) mg3[k] *= t[k];
            if (!last) { ld16(modp(p, layer + 1, bidx, 1), lane, gsn); ld16(ng + 4 * DM, lane, t);
#pragma unroll
                for (int k = 0; k < 16; ++k) gsn[k] = t[k] * (1.0f + gsn[k]);
                ld16(modp(p, layer + 1, bidx, 0), lane, sh); } }
        const float rsf = rsqrtf(sumsq16(f) * (1.0f / DM) + EPSN);
#pragma unroll
        for (int k = 0; k < 16; ++k) x[k] = x[k] + mg3[k] * (f[k] * rsf);
        if (last) st16_f32_nt(outp + (size_t)row * DM, lane, x);
        else {
            st16_bf16(xs + (size_t)row * DM, lane, x);
            const float rs2 = rsqrtf(sumsq16(x) * (1.0f / DM) + EPSN);
#pragma unroll
            for (int k = 0; k < 16; ++k) f[k] = x[k] * rs2 * gsn[k] + sh[k];
            { const float fs = st16_i8((unsigned char*)abuf + (size_t)row * DM, lane, f); if (lane == 0 && !dummy) ((float*)(p.ws + OFF_FSC))[row] = fs; }
        }
        return true;
    };
    if (row0 < nrows) issue(0, row0, Fb[0], Gb[0], Xb[0]);
    if constexpr (MOE) {
#pragma unroll 1
        for (int i = 0; i < NI; i += 2) {
            if (!step(i, Fb[0], Gb[0], Xb[0], Fb[1], Gb[1], Xb[1])) break;
            if (!step(i + 1, Fb[1], Gb[1], Xb[1], Fb[0], Gb[0], Xb[0])) break;
        }
    } else {
        if (row0 + NWAVES < nrows) issue(1, row0 + NWAVES, Fb[1], Gb[1], Xb[1]);
#pragma unroll 1
        for (int i = 0; i < NI; i += 3) {
            if (!step(i, Fb[0], Gb[0], Xb[0], Fb[2], Gb[2], Xb[2])) break;
            if (!step(i + 1, Fb[1], Gb[1], Xb[1], Fb[0], Gb[0], Xb[0])) break;
            if (!step(i + 2, Fb[2], Gb[2], Xb[2], Fb[1], Gb[1], Xb[1])) break;
        }
    }
}

__device__ __forceinline__ void phase_conv(const Params& p, const int wv, int layer) {
    const int tid = opaque_tid(wv), lane = tid & 63, wave = tid >> 6;
    const bf16_t* P = (const bf16_t*)(p.ws + OFF_U + U_P_E); bf16_t* mix = (bf16_t*)(p.ws + OFF_U + U_MIX_E);
    const float* cw = p.in[8] + (size_t)(layer >> 1) * 3 * 512;
    float w0[8], w1[8], w2[8];
#pragma unroll
    for (int k = 0; k < 8; ++k) { w0[k] = cw[8 * lane + k]; w1[k] = cw[512 + 8 * lane + k]; w2[k] = cw[1024 + 8 * lane + k]; }
    const int bA = (int)(blockIdx.x & 7), isA = bA < 2, nit = isA ? 14 : 18;
    const int jb = (int)(blockIdx.x >> 3) * 6 + (bA - 2), oa = jb / 3, orow = (14 + jb % 3) * 2048 + ((oa >> 1) * 8 + (oa & 1)) * 8 + wave;
#pragma unroll 1
    for (int it = 0; it < nit; ++it) {
        const int row = it < 17 ? it * 2048 + (int)blockIdx.x * NWAVES + wave : orow;
        const int pos = row < MLAT ? (row & (SEQ - 1)) : ((row - MLAT) & (CTXL - 1)), len = row < MLAT ? SEQ : CTXL;
        const bf16_t* pr = P + (size_t)row * EVEN_IN + 8 * lane;
        const u32x4 bg = *(const u32x4*)pr;
        float acc[8];
#pragma unroll
        for (int k = 0; k < 8; ++k) acc[k] = 0.f;
#pragma unroll
        for (int d = -1; d <= 1; ++d) {
            if (pos + d < 0 || pos + d >= len) continue;
            const bf16_t* q = pr + (ptrdiff_t)d * EVEN_IN;
            const u32x4 cg = *(const u32x4*)(q + 512), uu = *(const u32x4*)(q + 1024);
            const float* w = d < 0 ? w0 : (d == 0 ? w1 : w2);
#pragma unroll
            for (int k = 0; k < 4; ++k) { acc[2 * k] += w[2 * k] * bf_lo(cg[k]) * bf_lo(uu[k]); acc[2 * k + 1] += w[2 * k + 1] * bf_hi(cg[k]) * bf_hi(uu[k]); }
        }
        u32x4 o;
#pragma unroll
        for (int k = 0; k < 4; ++k) o[k] = pk_bf16(bf_lo(bg[k]) * acc[2 * k], bf_hi(bg[k]) * acc[2 * k + 1]);
        *(u32x4*)(mix + (size_t)row * DM + 8 * lane) = o;
    }
}

__device__ __forceinline__ float max3f(float a, float b, float c) { return __builtin_fmaxf(__builtin_fmaxf(a, b), c); }
__device__ __forceinline__ float xhalf_max(float v) { const auto rr = __builtin_amdgcn_permlane32_swap(__float_as_uint(v), __float_as_uint(v), false, false); return fmaxf(__uint_as_float(rr[0]), __uint_as_float(rr[1])); }
__device__ __forceinline__ float xhalf_sum(float v) { const auto rr = __builtin_amdgcn_permlane32_swap(__float_as_uint(v), __float_as_uint(v), false, false); return __uint_as_float(rr[0]) + __uint_as_float(rr[1]); }
struct NoMask { __device__ __forceinline__ void operator()(f32x16&, f32x16&) const {} };
struct BandMask {
    int kp0, qp, hi;
    __device__ __forceinline__ void operator()(f32x16& s0, f32x16& s1) const {
#pragma unroll
        for (int r = 0; r < 16; ++r) { const int d0 = kp0 + crow(r, hi) - qp, d1 = d0 + 32; if (d0 > 128 || d0 < -128) s0[r] = -INFINITY; if (d1 > 128 || d1 < -128) s1[r] = -INFINITY; }
    }
};
#define ABAR() asm volatile("s_waitcnt lgkmcnt(0)\n\ts_barrier" ::: "memory")
template <int KP, int NKS>
__device__ __forceinline__ void attn_X(const LAS unsigned char* Kt, const bf16x8 (&qf)[NKS], const f32x16& negm, f32x16& s0, f32x16& s1, int lane) {
    const int r32 = lane & 31, hi = lane >> 5;
    const LAS unsigned char* kp = Kt + r32 * KP + hi * 16;
#pragma unroll
    for (int s = 0; s < NKS; ++s) {
        const bf16x8 k0 = *(const LAS bf16x8*)(kp + s * 32), k1 = *(const LAS bf16x8*)(kp + 32 * KP + s * 32);
        s0 = __builtin_amdgcn_mfma_f32_32x32x16_bf16(k0, qf[s], s == 0 ? negm : s0, 0, 0, 0);
        s1 = __builtin_amdgcn_mfma_f32_32x32x16_bf16(k1, qf[s], s == 0 ? negm : s1, 0, 0, 0);
    }
}
template <int NDB, class Mask>
__device__ __forceinline__ void attn_Y(f32x16& s0, f32x16& s1, u32x4 (&pw)[4], f32x16 (&o)[NDB], f32x16& negm, float& m, float& l, bool first, const Mask& mask) {
    constexpr float THR = 8.0f;
    mask(s0, s1);
    float a = max3f(s0[0], s0[1], s1[0]), b = max3f(s0[2], s0[3], s1[1]); a = max3f(a, s1[2], s1[3]);
#pragma unroll
    for (int r = 4; r < 16; r += 4) { a = max3f(a, s0[r], s0[r + 1]); b = max3f(b, s0[r + 2], s0[r + 3]); a = max3f(a, s1[r], s1[r + 1]); b = max3f(b, s1[r + 2], s1[r + 3]); }
    const float rm = xhalf_max(fmaxf(a, b));
    if (first || __any(rm > THR)) {
        const float dl = first ? fmaxf(rm, -64.0f) : fmaxf(rm, 0.f), f = fast_exp2(-dl);
        m += dl; l *= f;
#pragma unroll
        for (int r = 0; r < 16; ++r) { s0[r] -= dl; s1[r] -= dl; float nm_ = -m; asm volatile("" : "+v"(nm_)); negm[r] = nm_; }
        asm volatile("s_nop 7" ::: "memory");
#pragma unroll
        for (int d = 0; d < NDB; ++d)
#pragma unroll
            for (int r = 0; r < 16; ++r) o[d][r] *= f;
    }
    float ps = 0.f;
#pragma unroll
    for (int r = 0; r < 16; ++r) { s0[r] = fast_exp2(s0[r]); s1[r] = fast_exp2(s1[r]); ps += s0[r] + s1[r]; }
    l += ps;
#pragma unroll
    for (int ks = 0; ks < 2; ++ks) {
        pw[ks] = (u32x4){pk_bf16(s0[8 * ks], s0[8 * ks + 1]), pk_bf16(s0[8 * ks + 2], s0[8 * ks + 3]), pk_bf16(s0[8 * ks + 4], s0[8 * ks + 5]), pk_bf16(s0[8 * ks + 6], s0[8 * ks + 7])};
        pw[2 + ks] = (u32x4){pk_bf16(s1[8 * ks], s1[8 * ks + 1]), pk_bf16(s1[8 * ks + 2], s1[8 * ks + 3]), pk_bf16(s1[8 * ks + 4], s1[8 * ks + 5]), pk_bf16(s1[8 * ks + 6], s1[8 * ks + 7])};
    }
}
template <int VP, int NDB>
__device__ __forceinline__ void attn_Z(const LAS unsigned char* Vt, const u32x4 (&pw)[4], f32x16 (&o)[NDB], int lane) {
    const int hi = lane >> 5;
    const LAS unsigned char* vp = Vt + (4 * hi + ((lane & 15) >> 2)) * VP + ((lane >> 4) & 1) * 32 + (lane & 3) * 8;
    if constexpr (NDB <= 4) {
        s16x4 lo[NDB], hh[NDB], lon[NDB], hhn[NDB];
#pragma unroll
        for (int d = 0; d < NDB; ++d) { lo[d] = __builtin_bit_cast(s16x4, __builtin_amdgcn_ds_read_tr16_b64_v4i16((LAS s16x4*)(vp + d * 64))); hh[d] = __builtin_bit_cast(s16x4, __builtin_amdgcn_ds_read_tr16_b64_v4i16((LAS s16x4*)(vp + d * 64 + 8 * VP))); }
#pragma unroll
        for (int st = 0; st < 4; ++st) {
            __builtin_amdgcn_sched_barrier(0);
            if (st < 3) {
#pragma unroll
                for (int d = 0; d < NDB; ++d) { const LAS unsigned char* a = vp + (16 * (st + 1)) * VP + d * 64;
                    lon[d] = __builtin_bit_cast(s16x4, __builtin_amdgcn_ds_read_tr16_b64_v4i16((LAS s16x4*)a)); hhn[d] = __builtin_bit_cast(s16x4, __builtin_amdgcn_ds_read_tr16_b64_v4i16((LAS s16x4*)(a + 8 * VP))); }
            }
            const bf16x8 pf = __builtin_bit_cast(bf16x8, pw[st]);
#pragma unroll
            for (int d = 0; d < NDB; ++d) { const bf16x8 vf = {lo[d][0], lo[d][1], lo[d][2], lo[d][3], hh[d][0], hh[d][1], hh[d][2], hh[d][3]}; o[d] = __builtin_amdgcn_mfma_f32_32x32x16_bf16(vf, pf, o[d], 0, 0, 0); }
#pragma unroll
            for (int d = 0; d < NDB; ++d) { lo[d] = lon[d]; hh[d] = hhn[d]; }
        }
    } else {
#pragma unroll
        for (int st = 0; st < 4; ++st) {
            __builtin_amdgcn_sched_barrier(0);
            const bf16x8 pf = __builtin_bit_cast(bf16x8, pw[st]);
#pragma unroll
            for (int d = 0; d < NDB; ++d) { const LAS unsigned char* a = vp + (16 * st) * VP + d * 64;
                const s16x4 lo = __builtin_bit_cast(s16x4, __builtin_amdgcn_ds_read_tr16_b64_v4i16((LAS s16x4*)a)), hh = __builtin_bit_cast(s16x4, __builtin_amdgcn_ds_read_tr16_b64_v4i16((LAS s16x4*)(a + 8 * VP)));
                const bf16x8 vf = {lo[0], lo[1], lo[2], lo[3], hh[0], hh[1], hh[2], hh[3]}; o[d] = __builtin_amdgcn_mfma_f32_32x32x16_bf16(vf, pf, o[d], 0, 0, 0); }
        }
    }
}
template <int KP, int VP, int NKS, int NDB, class GLK, class GLV, class STK, class STV, class MaskF>
__device__ __forceinline__ void attn_run1(LAS unsigned char* lds, int KB, int SB, int kcoff, const bf16x8 (&qf)[NKS], f32x16 (&o)[NDB], float& m, float& l, int NT, int lane,
                                          GLK glk, GLV glv, STK stk, STV stv, MaskF maskf) {
    f32x16 s0, s1, negm; u32x4 pw[4];
    m = 0.f;
#pragma unroll
    for (int r = 0; r < 16; ++r) negm[r] = 0.f;
    glk(0); glv(0); stk(0); stv(0); ABAR();
#pragma unroll 1
    for (int t = 0; t < NT; ++t) {
        if (t + 1 < NT) { glk(t + 1); glv(t + 1); }
        const LAS unsigned char* Kt = lds + (t & 1) * SB;
        attn_X<KP, NKS>(Kt + kcoff, qf, negm, s0, s1, lane);
        __builtin_amdgcn_sched_barrier(0);
        attn_Y<NDB>(s0, s1, pw, o, negm, m, l, t == 0, [&](f32x16& x0, f32x16& x1) { maskf(t, x0, x1); });
        __builtin_amdgcn_sched_barrier(0);
        attn_Z<VP, NDB>(Kt + KB, pw, o, lane);
        if (t + 1 < NT) { stk((t + 1) & 1); stv((t + 1) & 1); }
        ABAR();
    }
}

template <int NDB, class Mask>
__device__ __forceinline__ void attn_Y1(f32x16& s0, f32x16& s1, f32x16 (&o)[NDB], f32x16& negm, float& m, float& l, bool first, const Mask& mask) {
    constexpr float THR = 8.0f;
    mask(s0, s1);
    float a = max3f(s0[0], s0[1], s1[0]), b = max3f(s0[2], s0[3], s1[1]); a = max3f(a, s1[2], s1[3]);
#pragma unroll
    for (int r = 4; r < 16; r += 4) { a = max3f(a, s0[r], s0[r + 1]); b = max3f(b, s0[r + 2], s0[r + 3]); a = max3f(a, s1[r], s1[r + 1]); b = max3f(b, s1[r + 2], s1[r + 3]); }
    const float rm = xhalf_max(fmaxf(a, b));
    if (first || __any(rm > THR)) {
        const float dl = first ? fmaxf(rm, -64.0f) : fmaxf(rm, 0.f), f = fast_exp2(-dl);
        m += dl; l *= f;
#pragma unroll
        for (int r = 0; r < 16; ++r) { s0[r] -= dl; s1[r] -= dl; float nm_ = -m; asm volatile("" : "+v"(nm_)); negm[r] = nm_; }
        asm volatile("s_nop 7" ::: "memory");
#pragma unroll
        for (int d = 0; d < NDB; ++d)
#pragma unroll
            for (int r = 0; r < 16; ++r) o[d][r] *= f;
    }
}
__device__ __forceinline__ void attn_Y2(f32x16& s0, f32x16& s1, u32x4 (&pw)[4], float& l) {
    float ps = 0.f;
#pragma unroll
    for (int r = 0; r < 16; ++r) { s0[r] = fast_exp2(s0[r]); s1[r] = fast_exp2(s1[r]); ps += s0[r] + s1[r]; }
    l += ps;
#pragma unroll
    for (int ks = 0; ks < 2; ++ks) {
        pw[ks] = (u32x4){pk_bf16(s0[8 * ks], s0[8 * ks + 1]), pk_bf16(s0[8 * ks + 2], s0[8 * ks + 3]), pk_bf16(s0[8 * ks + 4], s0[8 * ks + 5]), pk_bf16(s0[8 * ks + 6], s0[8 * ks + 7])};
        pw[2 + ks] = (u32x4){pk_bf16(s1[8 * ks], s1[8 * ks + 1]), pk_bf16(s1[8 * ks + 2], s1[8 * ks + 3]), pk_bf16(s1[8 * ks + 4], s1[8 * ks + 5]), pk_bf16(s1[8 * ks + 6], s1[8 * ks + 7])};
    }
}
template <int KP, int VP, int NKS, int NDB, int VPM  , class GLK, class GLV, class STK, class STV, class MaskF>
__device__ __forceinline__ void attn_run2(LAS unsigned char* lds, int KB, int SB, int kcoff, const bf16x8 (&qf)[NKS], f32x16 (&o)[NDB], float& m, float& l, int NT, int lane,
                                          GLK glk, GLV glv, STK stk, STV stv, MaskF maskf) {
    f32x16 sa0, sa1, sb0, sb1, negm; u32x4 pw[4];
    m = 0.f;
#pragma unroll
    for (int r = 0; r < 16; ++r) negm[r] = 0.f;
    glk(0); stk(0); glv(0); stv(0);
    if (NT > 1) { glk(1); stk(1); }
    ABAR();
    attn_X<KP, NKS>(lds + kcoff, qf, negm, sa0, sa1, lane);
    auto step = [&](int t, f32x16& c0, f32x16& c1, f32x16& n0, f32x16& n1) {
        if (t + 2 < NT) glk(t + 2);
        if (t + 1 < NT) glv(t + 1);
        attn_Y1<NDB>(c0, c1, o, negm, m, l, t == 0, [&](f32x16& x0, f32x16& x1) { maskf(t, x0, x1); });
        if (t + 1 < NT) attn_X<KP, NKS>(lds + ((t + 1) & 1) * SB + kcoff, qf, negm, n0, n1, lane);
        attn_Y2(c0, c1, pw, l);
        __builtin_amdgcn_sched_group_barrier(0x100, 2 * NKS, 0);
#pragma unroll
        for (int i = 0; i < 2 * NKS; ++i) { __builtin_amdgcn_sched_group_barrier(0x008, 1, 0); __builtin_amdgcn_sched_group_barrier(0x002, VPM, 0); }
        __builtin_amdgcn_sched_barrier(0);
        attn_Z<VP, NDB>(lds + (t & 1) * SB + KB, pw, o, lane);
        if (t + 2 < NT) stk(t & 1);
        if (t + 1 < NT) stv((t + 1) & 1);
        ABAR();
    };
#pragma unroll 1
    for (int t = 0; t < NT; t += 2) {
        step(t, sa0, sa1, sb0, sb1);
        if (t + 1 < NT) step(t + 1, sb0, sb1, sa0, sa1);
    }
}

__device__ __forceinline__ void store_row_pairs(bf16_t* p32, const u32x2 (&w)[4], int hi) {
#pragma unroll
    for (int k = 0; k < 4; k += 2) {
        u32x2 a = w[k], b = w[k + 1];
        { const auto r = __builtin_amdgcn_permlane32_swap(a.x, b.x, false, false); a.x = r[0]; b.x = r[1]; }
        { const auto r = __builtin_amdgcn_permlane32_swap(a.y, b.y, false, false); a.y = r[0]; b.y = r[1]; }
        *(u32x4*)(p32 + 8 * k + 8 * hi) = (u32x4){a.x, a.y, b.x, b.y};
    }
}
__device__ __forceinline__ bf16x8 load_q(const bf16_t* p, float qs) {
    const u32x4 w = *(const u32x4*)p; u32x4 o;
#pragma unroll
    for (int k = 0; k < 4; ++k) o[k] = pk_bf16(bf_lo(w[k]) * qs, bf_hi(w[k]) * qs);
    return __builtin_bit_cast(bf16x8, o);
}
__device__ __forceinline__ int attn_vcu() { return (int)((blockIdx.x & 7) * (gridDim.x >> 3) + (blockIdx.x >> 3)); }

__device__ __forceinline__ void swa_unit(const Params& p, const int wv, LAS unsigned char* lds, int layer, int b, int g, int q0, bool ctxq) {
    constexpr int KP = 144, VP = 192, KB = 64 * KP, SB = KB + 64 * VP;
    const int tid = opaque_tid(wv), lane = tid & 63, wave = __builtin_amdgcn_readfirstlane(tid >> 6), r32 = lane & 31, hi = lane >> 5;
    const bf16_t* P = (const bf16_t*)(p.ws + OFF_U + U_P_E); bf16_t* mix = (bf16_t*)(p.ws + OFF_U + U_MIX_E);
    const int hd = 4 * g + (wave >> 1);
    const int qrow = (ctxq ? MLAT + b * CTXL : b * SEQ) + q0 + 32 * (wave & 1) + r32;
    const float qs = 0.125f * LOG2E;
    bf16x8 qf[4];
#pragma unroll
    for (int s = 0; s < 4; ++s) qf[s] = load_q(P + (size_t)qrow * EVEN_IN + 1536 + hd * 64 + 16 * s + 8 * hi, qs);
    f32x16 o[2];
#pragma unroll
    for (int d = 0; d < 2; ++d)
#pragma unroll
        for (int r = 0; r < 16; ++r) o[d][r] = 0.f;
    float m = -1e30f, l = 0.f;
    int ilo = 0, nlat = 0;
    if (!ctxq) { ilo = q0 >= 128 ? 0 : (128 - q0) / 64; int ihi = (SEQ + 64 - q0) / 64; ihi = ihi > 4 ? 4 : ihi; nlat = ihi - ilo + 1; }
    const int NT = nlat + 4;
    const int ki = tid >> 3, kc = tid & 7;
    u32x4 rk, rv;
    auto krow = [&](int t) { return t < nlat ? b * SEQ + q0 - 128 + 64 * (ilo + t) + ki : MLAT + b * CTXL + 64 * (t - nlat) + ki; };
    auto glk = [&](int t) { rk = *(const u32x4*)(P + (size_t)krow(t) * EVEN_IN + 2048 + g * 64 + kc * 8); };
    auto glv = [&](int t) { rv = *(const u32x4*)(P + (size_t)krow(t) * EVEN_IN + 2176 + g * 64 + kc * 8); };
    auto stk = [&](int buf) { *(LAS u32x4*)(lds + buf * SB + ki * KP + kc * 16) = rk; };
    auto stv = [&](int buf) { *(LAS u32x4*)(lds + buf * SB + KB + ki * VP + kc * 16) = rv; };
    const int qp = q0 + 32 * (wave & 1) + r32;
    attn_run1<KP, VP, 4, 2>(lds, KB, SB, 0, qf, o, m, l, NT, lane, glk, glv, stk, stv,
        [&](int t, f32x16& x0, f32x16& x1) { if (t < nlat) { BandMask bm; bm.kp0 = q0 - 128 + 64 * (ilo + t); bm.qp = qp; bm.hi = hi; bm(x0, x1); } });
    l = xhalf_sum(l);
    l += fast_exp2(p.in[9][(layer >> 1) * 8 + hd] * LOG2E - m);
    const float inv = 1.0f / l;
    bf16_t* orow = mix + (size_t)qrow * DM + 512 + hd * 64;
#pragma unroll
    for (int d = 0; d < 2; ++d) { u32x2 w[4];
#pragma unroll
        for (int gq = 0; gq < 4; ++gq) { w[gq].x = pk_bf16(o[d][4 * gq] * inv, o[d][4 * gq + 1] * inv); w[gq].y = pk_bf16(o[d][4 * gq + 2] * inv, o[d][4 * gq + 3] * inv); }
        store_row_pairs(orow + 32 * d, w, hi); }
}
__device__ __forceinline__ void phase_swa(const Params& p, const int wv, LAS unsigned char* lds, int layer) {
    const int v = attn_vcu();
    for (int u = v; u < 1024 + 64; u += gridDim.x) {
        if (u < 1024) swa_unit(p, wv, lds, layer, u >> 7, (u >> 6) & 1, (u & 63) * 64, false);
        else { const int c = u - 1024; swa_unit(p, wv, lds, layer, c >> 3, (c >> 2) & 1, (c & 3) * 64, true); }
    }
}

__device__ __forceinline__ void mla_unit(const Params& p, const int wv, LAS unsigned char* lds, int b, int h, int qrow0, int nl) {
    constexpr int KP = 208, VP = 192, KB = 64 * KP, SB = KB + 64 * VP;
    const int tid = opaque_tid(wv), lane = tid & 63, wave = __builtin_amdgcn_readfirstlane(tid >> 6), r32 = lane & 31, hi = lane >> 5;
    const bf16_t* P = (const bf16_t*)(p.ws + OFF_U + U_P_O); const bf16_t* QF = (const bf16_t*)(p.ws + OFF_U + U_QF_O); const bf16_t* KVF = (const bf16_t*)(p.ws + OFF_U + U_KVF_O);
    bf16_t* mix = (bf16_t*)(p.ws + OFF_U + U_MIX_O);
    const int qrow = qrow0 + 32 * wave + r32;
    const float qs = 0.10206207261596575f * LOG2E;
    bf16x8 qf[6];
#pragma unroll
    for (int s = 0; s < 4; ++s) qf[s] = load_q(QF + (size_t)qrow * 768 + h * 96 + 16 * s + 8 * hi, qs);
    {
        const u32x4 a = *(const u32x4*)(QF + (size_t)qrow * 768 + h * 96 + 64 + 8 * hi), bq = *(const u32x4*)(QF + (size_t)qrow * 768 + h * 96 + 80 + 8 * hi);
        float x1[8], x2[8];
#pragma unroll
        for (int k = 0; k < 4; ++k) { x1[2 * k] = bf_lo(a[k]); x1[2 * k + 1] = bf_hi(a[k]); x2[2 * k] = bf_lo(bq[k]); x2[2 * k + 1] = bf_hi(bq[k]); }
        if (nl > 0) {
            const float* tab = (const float*)(p.ws + OFF_TAB) + 2048; const int sp = qrow & (SEQ - 1), pos = hi ? (sp & 63) : (sp >> 6);
#pragma unroll
            for (int k = 0; k < 8; ++k) { const float cs = tab[pos * 8 + k], sn = tab[512 + pos * 8 + k]; const float o1 = x1[k] * cs - x2[k] * sn, o2 = x2[k] * cs + x1[k] * sn; x1[k] = o1; x2[k] = o2; }
        }
        u32x4 w1, w2;
#pragma unroll
        for (int k = 0; k < 4; ++k) { w1[k] = pk_bf16(x1[2 * k] * qs, x1[2 * k + 1] * qs); w2[k] = pk_bf16(x2[2 * k] * qs, x2[2 * k + 1] * qs); }
        qf[4] = __builtin_bit_cast(bf16x8, w1); qf[5] = __builtin_bit_cast(bf16x8, w2);
    }
    f32x16 o[2];
#pragma unroll
    for (int d = 0; d < 2; ++d)
#pragma unroll
        for (int r = 0; r < 16; ++r) o[d][r] = 0.f;
    float m = -1e30f, l = 0.f;
    const int NT = nl + 4;
    const int ki = tid >> 3, kc = tid & 7, ki2 = (tid >> 2) & 63, kc2 = tid & 3;
    u32x4 rk, rv, rp;
    auto krow = [&](int t, int i) { return t < nl ? b * SEQ + 64 * t + i : MLAT + b * CTXL + 64 * (t - nl) + i; };
    auto glk = [&](int t) { rk = *(const u32x4*)(KVF + (size_t)krow(t, ki) * 1024 + h * 128 + kc * 8); if (tid < 256) rp = *(const u32x4*)(P + (size_t)krow(t, ki2) * ODD_INP + 384 + kc2 * 8); };
    auto glv = [&](int t) { rv = *(const u32x4*)(KVF + (size_t)krow(t, ki) * 1024 + h * 128 + 64 + kc * 8); };
    auto stk = [&](int buf) { *(LAS u32x4*)(lds + buf * SB + ki * KP + kc * 16) = rk; if (tid < 256) *(LAS u32x4*)(lds + buf * SB + ki2 * KP + 128 + kc2 * 16) = rp; };
    auto stv = [&](int buf) { *(LAS u32x4*)(lds + buf * SB + KB + ki * VP + kc * 16) = rv; };
    attn_run2<KP, VP, 6, 2, 7>(lds, KB, SB, 0, qf, o, m, l, NT, lane, glk, glv, stk, stv, [](int, f32x16&, f32x16&) {});
    l = xhalf_sum(l);
    const float inv = 1.0f / l;
    bf16_t* orow = mix + (size_t)qrow * DM + h * 64;
#pragma unroll
    for (int d = 0; d < 2; ++d) { u32x2 w[4];
#pragma unroll
        for (int gq = 0; gq < 4; ++gq) { w[gq].x = pk_bf16(o[d][4 * gq] * inv, o[d][4 * gq + 1] * inv); w[gq].y = pk_bf16(o[d][4 * gq + 2] * inv, o[d][4 * gq + 3] * inv); }
        store_row_pairs(orow + 32 * d, w, hi); }
}

__device__ __forceinline__ void diff_unit(const Params& p, const int wv, LAS unsigned char* lds, int layer, int b, int h, int qrow0, int nl, float lam, float lam_init) {
    constexpr int KP = 272, VP = 320, KB = 64 * KP, SB = KB + 64 * VP, XP = 528;
    const int tid = opaque_tid(wv), lane = tid & 63, wave = __builtin_amdgcn_readfirstlane(tid >> 6), r32 = lane & 31, hi = lane >> 5;
    const bf16_t* P = (const bf16_t*)(p.ws + OFF_U + U_P_O); bf16_t* mix = (bf16_t*)(p.ws + OFF_U + U_MIX_O);
    const int comp = wave >> 2, qrow = qrow0 + 32 * (wave & 3) + r32;
    const float qs = 0.125f * LOG2E;
    bf16x8 qf[4];
#pragma unroll
    for (int s = 0; s < 4; ++s) qf[s] = load_q(P + (size_t)qrow * ODD_INP + 512 + h * 128 + comp * 64 + 16 * s + 8 * hi, qs);
    f32x16 o[4];
#pragma unroll
    for (int d = 0; d < 4; ++d)
#pragma unroll
        for (int r = 0; r < 16; ++r) o[d][r] = 0.f;
    float m = -1e30f, l = 0.f;
    const int NT = nl + 4;
    const int ki = tid >> 3, kc = tid & 7;
    u32x4 rk0, rk1, rv0, rv1;
    auto krow = [&](int t) { return t < nl ? b * SEQ + 64 * t + ki : MLAT + b * CTXL + 64 * (t - nl) + ki; };
    auto glk = [&](int t) { const bf16_t* pr = P + (size_t)krow(t) * ODD_INP + 1024 + h * 128 + kc * 8; rk0 = *(const u32x4*)pr; rk1 = *(const u32x4*)(pr + 64); };
    auto glv = [&](int t) { const bf16_t* pr = P + (size_t)krow(t) * ODD_INP + 1536 + h * 128 + kc * 8; rv0 = *(const u32x4*)pr; rv1 = *(const u32x4*)(pr + 64); };
    auto stk = [&](int buf) { LAS unsigned char* kb = lds + buf * SB + ki * KP + kc * 16; *(LAS u32x4*)kb = rk0; *(LAS u32x4*)(kb + 128) = rk1; };
    auto stv = [&](int buf) { LAS unsigned char* vb = lds + buf * SB + KB + ki * VP + kc * 16; *(LAS u32x4*)vb = rv0; *(LAS u32x4*)(vb + 128) = rv1; };
    attn_run2<KP, VP, 4, 4, 10>(lds, KB, SB, comp * 128, qf, o, m, l, NT, lane, glk, glv, stk, stv, [](int, f32x16&, f32x16&) {});
    l = xhalf_sum(l);
    const float inv = 1.0f / l;
    LAS unsigned char* xrow = lds + (32 * (wave & 3) + r32) * XP;
    if (comp == 1) {
#pragma unroll
        for (int d = 0; d < 4; ++d)
#pragma unroll
            for (int gq = 0; gq < 4; ++gq) *(LAS f32x4*)(xrow + (32 * d + 8 * gq + 4 * hi) * 4) = (f32x4){o[d][4 * gq] * inv, o[d][4 * gq + 1] * inv, o[d][4 * gq + 2] * inv, o[d][4 * gq + 3] * inv};
    }
    __syncthreads();
    if (comp == 0) {
        float ss = 0.f;
#pragma unroll
        for (int d = 0; d < 4; ++d)
#pragma unroll
            for (int gq = 0; gq < 4; ++gq) { const f32x4 o2 = *(const LAS f32x4*)(xrow + (32 * d + 8 * gq + 4 * hi) * 4);
#pragma unroll
                for (int k = 0; k < 4; ++k) { const float v = o[d][4 * gq + k] * inv - lam * o2[k]; o[d][4 * gq + k] = v; ss += v * v; } }
        ss = xhalf_sum(ss);
        const float omli = __uint_as_float(__builtin_amdgcn_readfirstlane(__float_as_uint(layer == 1 ? 1.0f - 0.35550906f : 1.0f - 0.55605820f)));
        const float rs = rsqrtf(ss * (1.0f / 128.0f) + EPSN) * omli;
        const float* sg = p.in[17] + (size_t)(layer >> 1) * 128;
        bf16_t* orow = mix + (size_t)qrow * DM + 512 + h * 128;
#pragma unroll
        for (int d = 0; d < 4; ++d) { u32x2 w[4];
#pragma unroll
            for (int gq = 0; gq < 4; ++gq) { const int c = 32 * d + 8 * gq + 4 * hi; const f32x4 gg = *(const f32x4*)(sg + c);
                w[gq].x = pk_bf16(o[d][4 * gq] * rs * gg[0], o[d][4 * gq + 1] * rs * gg[1]); w[gq].y = pk_bf16(o[d][4 * gq + 2] * rs * gg[2], o[d][4 * gq + 3] * rs * gg[3]); }
            store_row_pairs(orow + 32 * d, w, hi); }
    }
    __syncthreads();
}
__device__ __forceinline__ void phase_attn_odd(const Params& p, const int wv, LAS unsigned char* lds, int layer) {
    const int v = attn_vcu();
    const bool need_ctx = layer < 3;
    const float* lp = p.in[16] + (size_t)(layer >> 1) * 256; const int ln = opaque_tid(wv) & 63;
    const float lam_init = layer == 1 ? 0.35550906f : 0.55605820f;
    const float lam = __uint_as_float(__builtin_amdgcn_readfirstlane(__float_as_uint(expf(wave_sum(lp[ln] * lp[64 + ln])) - expf(wave_sum(lp[128 + ln] * lp[192 + ln])) + lam_init)));
    const int n_mla = 1024 + (need_ctx ? 64 : 0);
#ifndef NO_MLA
    for (int u = v; u < n_mla; u += gridDim.x) {
        if (u < 1024) { const int bh = u >> 4, qb = u & 15; mla_unit(p, wv, lds, bh >> 3, bh & 7, (bh >> 3) * SEQ + qb * 256, 64); }
        else { const int c = u - 1024; mla_unit(p, wv, lds, c >> 3, c & 7, MLAT + (c >> 3) * CTXL, 0); }
    }
#endif
#ifndef NO_DIFF
    for (int u = v; u < n_mla + 64; u += gridDim.x) {
        if (u < 1024) { const int bh = u >> 5, qb = u & 31; diff_unit(p, wv, lds, layer, bh >> 2, bh & 3, (bh >> 2) * SEQ + qb * 128, 64, lam, lam_init); }
        else if (u >= 1024 + 64) { const int c = u - 1024 - 64, bh = c >> 1; diff_unit(p, wv, lds, layer, bh >> 2, bh & 3, MLAT + (bh >> 2) * CTXL + (c & 1) * 128, 0, lam, lam_init); }
    }
#endif
}

__device__ __forceinline__ bool tail_share(int nwg, int G, int c, int& rank, int& nidle) {
    const int rmax = (nwg + G - 1) / G; int busy = nwg - (rmax - 1) * G; busy = busy >= G ? 0 : busy;
    rank = c - busy; nidle = G - busy; return c >= busy;
}

constexpr int NPH_PAIR = 16, NPHASES = 2 + 2 * NPH_PAIR;
__global__ void __launch_bounds__(NTHREADS, 2) fwd(Params p, int lo, int hi) {
    extern __shared__ __attribute__((aligned(16))) unsigned char smem_raw[];
    LAS unsigned char* lds = (LAS unsigned char*)smem_raw;
    volatile LAS unsigned* xbw = (volatile LAS unsigned*)(lds + LDS_BYTES - 16);
    unsigned char* ws = p.ws;
    const int wv = __builtin_amdgcn_readfirstlane((int)(threadIdx.x >> 6));
    XcdBarrier bar; bar.bar = (unsigned*)(ws + OFF_CTL); bar.x = 0; bar.st = xbw; bar.wv = wv;
    if (hi - lo > 1) {
        if (wv == 0 && lane_id() == 0) { xbw[0] = 0u; xbw[1] = 0u; xbw[2] = 0u; xbw[3] = 0u; }
        __syncthreads();
        bar = xcd_barrier_post((unsigned*)(ws + OFF_CTL), xbw, wv);
    }
    const int G = gridDim.x, c = blockIdx.x;
    constexpr int NM = MTOT / 256;
#ifndef PH_MASK
#define PH_MASK 0xFFFFFFFFu
#endif
#define PHASE(id) if (lo <= (id) && (id) < hi)
#ifndef DUP_MASK
#define DUP_MASK 0u
#endif
#define DUPK(k) _Pragma("unroll 1") for (int dup_ = 0; dup_ < ((((DUP_MASK) >> (k)) & 1u) ? 2 : 1); ++dup_)
#define DUP_DUMMY(k) (((((DUP_MASK) >> (k)) & 1u) != 0u) && dup_ == 0)
#define PMARK(k) asm volatile("; PHASE_MARK " #k ::: "memory")
#define PHM(k) if constexpr ((PH_MASK >> (k)) & 1u)
#define SEAM(id) do { if ((id) > lo) xcd_barrier(bar); } while (0)
    PHM(0) PHASE(0) DUPK(0) { PMARK(0); phase_prologue(p, wv, lds); }
    PHM(1) PHASE(1) DUPK(1) { PMARK(1); SEAM(1); phase_h0(p, wv); }
    for (int pr = 0; pr < 2; ++pr) {
        Params pq = p; pq.ws = fresh_ws();
        unsigned char* ws = pq.ws;
        const int le = 2 * pr, lod = 2 * pr + 1, pb = 2 + pr * NPH_PAIR;
        const bf16_t* abuf = (const bf16_t*)(ws + OFF_ABUF);
        PHM(2) PHASE(pb + 0) DUPK(2) { PMARK(2); SEAM(pb + 0);
            pg8::Gemm g{abuf, ws + OFF_WINE + pr * SZ_WINE, 1024, 1024}; pg8::StaticOrder S; S.init(NM, EVEN_IN / 256, G, c);
            pg8::EpiRope<0> E{(bf16_t*)(ws + OFF_U + U_P_E), EVEN_IN, (const float*)(ws + OFF_TAB), (const float*)(ws + OFF_FSC), (const float*)(ws + OFF_WSCI) + (size_t)pr * EVEN_IN, nullptr}; pg8::gemm_phase<3>(lds, g, S, E, wv); }
        PHM(3) PHASE(pb + 1) DUPK(3) { PMARK(3); SEAM(pb + 1); phase_conv(pq, wv, le); phase_swa(pq, wv, lds, le); }
        PHM(4) PHASE(pb + 2) DUPK(4) { PMARK(4); SEAM(pb + 2);
            pg8::Gemm g{(const bf16_t*)(ws + OFF_U + U_MIX_E), (const bf16_t*)(ws + OFF_WOUTE + pr * SZ_WOUT), 1024, 1024}; pg8::StaticOrder S; S.init(NM, 4, G, c);
            pg8::EpiBf16S E{(bf16_t*)(ws + OFF_U + U_Y_E), 1024, 4, nullptr, 1.0f}; pg8::gemm_phase<2>(lds, g, S, E, wv);
            { int rk, ni; if (tail_share(NM * 4, G, c, rk, ni)) conv_tiles_run(p, lds, opaque_tid(wv), CV_NT_PRO + pr * (CV_NT_E / 2), CV_NT_PRO + pr * (CV_NT_E / 2) + TAIL_T_SPLIT, rk, ni); } }
        PHM(5) PHASE(pb + 3) DUPK(5) { PMARK(5); SEAM(pb + 3); phase_rowB<false>(pq, wv, lds, le, (const bf16_t*)(ws + OFF_U + U_Y_E), MTOT, DUP_DUMMY(5)); }
        PHM(6) PHASE(pb + 4) DUPK(6) { PMARK(6); SEAM(pb + 4);
            pg8::Gemm g{abuf, ws + OFF_WGU + pr * SZ_WGU, 1024, 1024}; pg8::StaticOrder S; S.init(NM, 2 * FFD / 256, G, c);
            pg8::EpiSwiGLU<FFN_DOWN_FP8 != 0> E{ws + OFF_U + U_ACT_E, FFD, 2 * FFD / 256, (const float*)(ws + OFF_FSC), (const float*)(ws + OFF_WSCD) + (size_t)pr * 2 * FFD}; pg8::gemm_phase<3>(lds, g, S, E, wv); }
        PHM(7) PHASE(pb + 5) DUPK(7) { PMARK(7); SEAM(pb + 5);
            pg8::Gemm g{ws + OFF_U + U_ACT_E, ws + OFF_WDN + pr * SZ_WDN, FFD, FFD}; pg8::StaticOrder S; S.init(NM, 4, G, c);
            pg8::EpiBf16S E{(bf16_t*)(ws + OFF_U + U_Y_E), 1024, 4, nullptr, FFN_DOWN_FP8 ? 1.0f / W8_SCALE : 1.0f}; pg8::gemm_phase<FFN_DOWN_FP8 ? 1 : 2>(lds, g, S, E, wv);
            { int rk, ni; if (tail_share(NM * 4, G, c, rk, ni)) {
                if (pr == 0) conv_units(p, lds, opaque_tid(wv), CV_NU_PRO, CV_NU_PRO + TAIL_U_SPLIT, rk, ni); else conv_units(p, lds, opaque_tid(wv), CV_NU_PRO + CV_NU_E / 2 + TAIL_U_SPLIT, CV_NU, rk, ni); } } }
        PHM(8) PHASE(pb + 6) DUPK(8) { PMARK(8); SEAM(pb + 6); phase_rowC<false>(pq, wv, le, (const bf16_t*)(ws + OFF_U + U_Y_E), false, DUP_DUMMY(8)); }
        PHM(9) PHASE(pb + 7) DUPK(9) { PMARK(9); SEAM(pb + 7);
            pg8::Gemm g{abuf, ws + OFF_WINO + pr * SZ_WINO, 1024, 1024}; pg8::StaticOrder S; S.init(NM, ODD_INP / 256, G, c);
            pg8::EpiRope<1> E{(bf16_t*)(ws + OFF_U + U_P_O), ODD_INP, (const float*)(ws + OFF_TAB), (const float*)(ws + OFF_FSC), (const float*)(ws + OFF_WSCI) + 2 * EVEN_IN + (size_t)pr * ODD_INP, (float*)(ws + OFF_U + U_SSQ_O)}; pg8::gemm_phase<3>(lds, g, S, E, wv);
            { int rk, ni; if (tail_share(NM * (ODD_INP / 256), G, c, rk, ni)) conv_tiles_run(p, lds, opaque_tid(wv), CV_NT_PRO + pr * (CV_NT_E / 2) + TAIL_T_SPLIT, CV_NT_PRO + (pr + 1) * (CV_NT_E / 2), rk, ni); } }
        PHM(11) PHASE(pb + 8) DUPK(11) { PMARK(11); SEAM(pb + 8);
            pg8::Gemm g{(const bf16_t*)(ws + OFF_U + U_P_O), (const bf16_t*)(ws + OFF_WQUP + pr * SZ_WQUP), ODD_INP, 256}; pg8::StaticOrder S; S.init(NM, 3, G, c);
            pg8::EpiBf16N<8> E{(bf16_t*)(ws + OFF_U + U_QF_O), 768, (const float*)(ws + OFF_U + U_SSQ_O), 1.0f / 256.0f}; pg8::gemm_phase<2>(lds, g, S, E, wv); }
        PHM(19) PHASE(pb + 9) DUPK(19) { PMARK(19);
            pg8::Gemm g{(const bf16_t*)(ws + OFF_U + U_P_O) + 256, (const bf16_t*)(ws + OFF_WKVUP + pr * SZ_WKVUP), ODD_INP, 256}; pg8::StaticOrder S; S.init(NM, 4, G, G - 1 - c);
            pg8::EpiBf16N<4> E{(bf16_t*)(ws + OFF_U + U_KVF_O), 1024, (const float*)(ws + OFF_U + U_SSQ_O) + 8, 1.0f / 128.0f}; pg8::gemm_phase<2>(lds, g, S, E, wv); }
        PHM(12) PHASE(pb + 10) DUPK(12) { PMARK(12); SEAM(pb + 10); phase_attn_odd(pq, wv, lds, lod); }
        PHM(13) PHASE(pb + 11) DUPK(13) { PMARK(13); SEAM(pb + 11);
            pg8::Gemm g{(const bf16_t*)(ws + OFF_U + U_MIX_O), (const bf16_t*)(ws + OFF_WOUTO + pr * SZ_WOUT), 1024, 1024}; pg8::StaticOrder S; S.init(pr == 1 ? MLAT / 256 : NM, 4, G, c);
            pg8::EpiBf16S E{(bf16_t*)(ws + OFF_EOUT), 1024, 4, nullptr, 1.0f}; pg8::gemm_phase<2>(lds, g, S, E, wv);
            { int rk, ni; if (pr == 0 && tail_share(NM * 4, G, c, rk, ni)) conv_units(p, lds, opaque_tid(wv), CV_NU_PRO + TAIL_U_SPLIT, CV_NU_PRO + CV_NU_E / 2, rk, ni); } }
        PHM(14) PHASE(pb + 12) DUPK(14) { PMARK(14); SEAM(pb + 12); phase_rowB<true>(pq, wv, lds, lod, (const bf16_t*)(ws + OFF_EOUT), pr == 1 ? MLAT : MTOT, DUP_DUMMY(14)); }
        PHM(16) PHASE(pb + 13) DUPK(16) { PMARK(16); SEAM(pb + 13);
            const MoeLayout L = moe_layout(pq, lod);
            pg8::Gemm g{ws + OFF_GBUF, ws + OFF_WEGU + (size_t)pr * 8 * (SZ_WEGU / 2), 1024, 1024};
            pg8::MoeOrder S; S.gatherA = true; S.so.init(L.tstart[8], 2 * FFE / 256, G, c);
#pragma unroll
            for (int e = 0; e < 9; ++e) S.ts[e] = L.tstart[e];
            pg8::EpiSwiGLU<FFN_DOWN_FP8 != 0> E{ws + OFF_U, FFE, 2 * FFE / 256, (const float*)(ws + OFF_GWT), (const float*)(ws + OFF_WSCE) + (size_t)pr * 8 * 2 * FFE}; pg8::gemm_phase<3>(lds, g, S, E, wv); }
        PHM(17) PHASE(pb + 14) DUPK(17) { PMARK(17); SEAM(pb + 14);
            const MoeLayout L = moe_layout(pq, lod);
            pg8::Gemm g{ws + OFF_U, ws + OFF_WEDN + (size_t)pr * 8 * (SZ_WEDN / (FFN_DOWN_FP8 ? 2 : 1)), FFE, FFE};
            pg8::MoeOrder S; S.gatherA = false; S.so.init(L.tstart[8], 4, G, c);
#pragma unroll
            for (int e = 0; e < 9; ++e) S.ts[e] = L.tstart[e];
            pg8::EpiBf16S E{(bf16_t*)(ws + OFF_EOUT), 1024, 4, (const float*)(ws + OFF_TWT), FFN_DOWN_FP8 ? 1.0f / W8_SCALE : 1.0f}; pg8::gemm_phase<FFN_DOWN_FP8 ? 1 : 2>(lds, g, S, E, wv);
            { int rk, ni; if (pr == 0 && tail_share(4 * L.tstart[8], G, c, rk, ni)) conv_units(p, lds, opaque_tid(wv), CV_NU_PRO + CV_NU_E / 2, CV_NU_PRO + CV_NU_E / 2 + TAIL_U_SPLIT, rk, ni); } }
        PHM(18) PHASE(pb + 15) DUPK(18) { PMARK(18); SEAM(pb + 15); phase_rowC<true>(pq, wv, lod, nullptr, pr == 1, DUP_DUMMY(18)); }
    }
#undef PHASE
#undef SEAM
}

extern "C" void kernel_launch(void* const* d_in, const int* in_sizes, int n_in, void* d_out, int out_size, void* d_ws, size_t ws_size, hipStream_t stream) {
    static int grid = 0;
    if (grid == 0) {
        if (n_in != 24 || out_size != MLAT * DM || ws_size < WS_END + (DUP_MASK != 0u ? (size_t)MTOT * DM * 6 : (size_t)0)) { fprintf(stderr, "kernel_launch: unexpected shapes (n_in %d, out %d, ws %zu, need %zu)\n", n_in, out_size, ws_size, (size_t)WS_END); grid = -1; return; }
        int dev = 0, cus = 0, per_cu = 0;
        if (hipGetDevice(&dev) != hipSuccess || hipDeviceGetAttribute(&cus, hipDeviceAttributeMultiprocessorCount, dev) != hipSuccess) { grid = -1; return; }
        if (hipFuncSetAttribute((const void*)fwd, hipFuncAttributeMaxDynamicSharedMemorySize, LDS_BYTES) != hipSuccess) { fprintf(stderr, "kernel_launch: hipFuncSetAttribute failed\n"); grid = -1; return; }
        if (hipOccupancyMaxActiveBlocksPerMultiprocessor(&per_cu, (const void*)fwd, NTHREADS, LDS_BYTES) != hipSuccess || per_cu < 1) { fprintf(stderr, "kernel_launch: occupancy query says %d\n", per_cu); grid = -1; return; }
        grid = cus < 256 ? cus : 256;
        if (grid != 256) fprintf(stderr, "kernel_launch: %d CUs; the row-wise phases assume 256 workgroups\n", cus);
    }
    if (grid != 256) return;
    Params p{};
    for (int i = 0; i < 24; ++i) p.in[i] = (const float*)d_in[i];
    p.out = (float*)d_out; p.ws = (unsigned char*)d_ws;
    hipMemsetAsync((char*)d_ws + OFF_CTL, 0, CTL_BYTES, stream);
#if MK_MULTI_LAUNCH
    for (int ph = 0; ph < NPHASES; ++ph) hipLaunchKernelGGL(fwd, dim3(grid), dim3(NTHREADS), LDS_BYTES, stream, p, ph, ph + 1);
#else
    hipLaunchKernelGGL(fwd, dim3(grid), dim3(NTHREADS), LDS_BYTES, stream, p, 0, NPHASES);
#endif
}
```

```cpp
#include <hip/hip_runtime.h>
#include <cstdio>
#include <cstdint>
#include <cstddef>

#ifndef FFN_DOWN_FP8
#define FFN_DOWN_FP8 1
#endif
#ifndef MK_MULTI_LAUNCH
#define MK_MULTI_LAUNCH 0
#endif

#define LAS __attribute__((address_space(3)))
typedef unsigned short bf16_t;
typedef short bf16x8 __attribute__((ext_vector_type(8)));
typedef short s16x4 __attribute__((ext_vector_type(4)));
typedef float f32x4 __attribute__((ext_vector_type(4)));
typedef float f32x2 __attribute__((ext_vector_type(2)));
typedef float f32x16 __attribute__((ext_vector_type(16)));
typedef unsigned u32x4 __attribute__((ext_vector_type(4)));
typedef unsigned u32x2 __attribute__((ext_vector_type(2)));

constexpr int DM = 1024, NB = 8, SEQ = 4096, CTXL = 256;
constexpr int MLAT = NB * SEQ, MCTX = NB * CTXL, MTOT = MLAT + MCTX;
constexpr int EVEN_IN = 2304, ODD_INP = 2048  , FFD = 2816, FFE = 3584, NEXP = 8;
constexpr int MG_ROWS = 2 * MTOT + NEXP * 256;
constexpr float EPSN = 1e-6f;
constexpr float LOG2E = 1.4426950408889634f;
constexpr int NTHREADS = 512, NWAVES = 8;
constexpr int LDS_BYTES = 147456;
constexpr int ROWS_PER_BLOCK = MTOT / 256;

constexpr size_t al256(size_t x) { return (x + 255) & ~(size_t)255; }
constexpr size_t OFF_CTL   = 0;
constexpr size_t CTL_BYTES = 65536;
constexpr size_t OFF_MOD   = OFF_CTL + CTL_BYTES;
constexpr size_t OFF_TAB   = al256(OFF_MOD + (size_t)4 * 9 * 6144 * 4);
constexpr size_t OFF_SLOT  = al256(OFF_TAB + 16384);
constexpr size_t OFF_TOK   = al256(OFF_SLOT + (size_t)MTOT * 16);
constexpr size_t OFF_TWT   = al256(OFF_TOK + (size_t)NEXP * MTOT * 4);
constexpr size_t OFF_GWT   = al256(OFF_TWT + (size_t)NEXP * MTOT * 4);
constexpr size_t OFF_GSC   = al256(OFF_GWT + (size_t)NEXP * MTOT * 4);
constexpr size_t OFF_FSC   = al256(OFF_GSC + (size_t)MG_ROWS * 4);
constexpr size_t OFF_WSCD  = al256(OFF_FSC + (size_t)MTOT * 4);
constexpr size_t OFF_WSCE  = al256(OFF_WSCD + (size_t)2 * 2 * FFD * 4);
constexpr size_t OFF_WSCI  = al256(OFF_WSCE + (size_t)16 * 2 * FFE * 4);
constexpr size_t OFF_WINE  = al256(OFF_WSCI + (size_t)(2 * EVEN_IN + 2 * ODD_INP) * 4);
constexpr size_t SZ_WINE   = (size_t)EVEN_IN * 1024 * 2;
constexpr size_t OFF_WOUTE = OFF_WINE + 2 * SZ_WINE;
constexpr size_t SZ_WOUT   = (size_t)1024 * 1024 * 2;
constexpr size_t OFF_WINO  = OFF_WOUTE + 2 * SZ_WOUT;
constexpr size_t SZ_WINO   = (size_t)ODD_INP * 1024 * 2;
constexpr size_t OFF_WQUP  = OFF_WINO + 2 * SZ_WINO;
constexpr size_t SZ_WQUP   = (size_t)768 * 256 * 2;
constexpr size_t OFF_WKVUP = OFF_WQUP + 2 * SZ_WQUP;
constexpr size_t SZ_WKVUP  = (size_t)1024 * 256 * 2;
constexpr size_t OFF_WOUTO = OFF_WKVUP + 2 * SZ_WKVUP;
constexpr size_t OFF_WGU   = OFF_WOUTO + 2 * SZ_WOUT;
constexpr size_t SZ_WGU    = (size_t)2 * FFD * 1024 * 2;
constexpr size_t OFF_WDN   = OFF_WGU + 2 * SZ_WGU;
constexpr size_t SZ_WDN    = (size_t)1024 * FFD * 2;
constexpr size_t OFF_WEGU  = OFF_WDN + 2 * SZ_WDN;
constexpr size_t SZ_WEGU   = (size_t)2 * FFE * 1024 * 2;
constexpr size_t OFF_WEDN  = OFF_WEGU + 16 * SZ_WEGU;
constexpr size_t SZ_WEDN   = (size_t)1024 * FFE * 2;
constexpr size_t OFF_XS    = al256(OFF_WEDN + 16 * SZ_WEDN);
constexpr size_t OFF_ABUF  = OFF_XS + (size_t)MTOT * 1024 * 4;
constexpr size_t OFF_U     = OFF_ABUF + (size_t)MTOT * 1024 * 2;
constexpr size_t SZ_U      = (size_t)MG_ROWS * FFE * 2;
constexpr size_t U_P_E   = 0;
constexpr size_t U_MIX_E = U_P_E + (size_t)MTOT * EVEN_IN * 2;
constexpr size_t U_Y_E   = U_MIX_E + (size_t)MTOT * 1024 * 2;
constexpr size_t U_ACT_E = 0;
constexpr size_t U_P_O   = 0;
constexpr size_t U_NRM_O = U_P_O + (size_t)MTOT * ODD_INP * 2;
constexpr size_t U_KVN_O = U_NRM_O + (size_t)MTOT * 256 * 2;
constexpr size_t U_SSQ_O = U_NRM_O;
constexpr size_t U_QF_O  = U_KVN_O + (size_t)MTOT * 256 * 2;
constexpr size_t U_KVF_O = U_QF_O + (size_t)MTOT * 768 * 2;
constexpr size_t U_MIX_O = U_KVF_O + (size_t)MTOT * 1024 * 2;
static_assert(U_MIX_O + (size_t)MTOT * 1024 * 2 <= SZ_U, "odd-layer map fits the union region");
static_assert(U_Y_E + (size_t)MTOT * 1024 * 4 <= SZ_U, "even-layer map fits the union region");
static_assert((size_t)MTOT * FFD * 2 <= U_Y_E, "dense act must not overlap F");
constexpr int    CAPR      = MTOT;
constexpr size_t OFF_GBUF  = OFF_U + SZ_U;
constexpr size_t OFF_EOUT  = OFF_GBUF + (size_t)NEXP * CAPR * 1024;
constexpr size_t WS_END    = OFF_EOUT + (size_t)MG_ROWS * 1024 * 2;

constexpr int CW_MOECNT = 4096;

struct Params { const float* in[24]; float* out; unsigned char* ws; };

__device__ __forceinline__ unsigned pk_bf16(float lo, float hi) { typedef __bf16 b2 __attribute__((ext_vector_type(2))); f32x2 v = {lo, hi}; b2 b = __builtin_convertvector(v, b2); return __builtin_bit_cast(unsigned, b); }
__device__ __forceinline__ float bf_lo(unsigned w) { return __uint_as_float(w << 16); }
__device__ __forceinline__ float bf_hi(unsigned w) { return __uint_as_float(w & 0xffff0000u); }
__device__ __forceinline__ float clamp448(float x) { return __builtin_fminf(__builtin_fmaxf(x, -448.0f), 448.0f); }
__device__ __forceinline__ unsigned pk_fp8x4(float a, float b, float c, float d) {
    int v = __builtin_amdgcn_cvt_pk_fp8_f32(clamp448(a), clamp448(b), 0, false); v = __builtin_amdgcn_cvt_pk_fp8_f32(clamp448(c), clamp448(d), v, true); return (unsigned)v; }
__device__ __forceinline__ unsigned pk_i8x4(float a, float b, float c, float d) {
    const int ia = (int)__builtin_rintf(a), ib = (int)__builtin_rintf(b), ic = (int)__builtin_rintf(c), id = (int)__builtin_rintf(d);
    return (unsigned)(ia & 0xff) | ((unsigned)(ib & 0xff) << 8) | ((unsigned)(ic & 0xff) << 16) | ((unsigned)id << 24); }
template <int CTRL> __device__ __forceinline__ float dppf(float v) { return __builtin_bit_cast(float, __builtin_amdgcn_update_dpp(0, __builtin_bit_cast(int, v), CTRL, 0xF, 0xF, true)); }
__device__ __forceinline__ float wave_max(float v) {
    v = fmaxf(v, dppf<0xB1>(v)); v = fmaxf(v, dppf<0x4E>(v)); v = fmaxf(v, dppf<0x141>(v)); v = fmaxf(v, dppf<0x140>(v));
    { const auto rr = __builtin_amdgcn_permlane16_swap(__float_as_uint(v), __float_as_uint(v), false, false); v = fmaxf(__uint_as_float(rr[0]), __uint_as_float(rr[1])); }
    { const auto rr = __builtin_amdgcn_permlane32_swap(__float_as_uint(v), __float_as_uint(v), false, false); v = fmaxf(__uint_as_float(rr[0]), __uint_as_float(rr[1])); }
    return v; }
__device__ __forceinline__ float wave_sum(float v) {
    v += dppf<0xB1>(v); v += dppf<0x4E>(v); v += dppf<0x141>(v); v += dppf<0x140>(v);
    { const auto rr = __builtin_amdgcn_permlane16_swap(__float_as_uint(v), __float_as_uint(v), false, false); v = __uint_as_float(rr[0]) + __uint_as_float(rr[1]); }
    { const auto rr = __builtin_amdgcn_permlane32_swap(__float_as_uint(v), __float_as_uint(v), false, false); v = __uint_as_float(rr[0]) + __uint_as_float(rr[1]); }
    return v; }
__device__ __forceinline__ float fast_exp2(float x) { return __builtin_amdgcn_exp2f(x); }
__device__ __forceinline__ float fast_rcp(float x) { return __builtin_amdgcn_rcpf(x); }
__device__ __forceinline__ float silu_f(float g) { return g * fast_rcp(1.0f + fast_exp2(-g * LOG2E)); }
__device__ __forceinline__ int lane_id() { int l; asm volatile("v_mbcnt_lo_u32_b32 %0, -1, 0\n\tv_mbcnt_hi_u32_b32 %0, -1, %0" : "=v"(l)); return l; }
__device__ __forceinline__ int opaque_tid(int wv) { int t = (wv << 6) | lane_id(); asm volatile("" : "+v"(t)); return t; }
__device__ __forceinline__ int crow(int r, int hi) { return (r & 3) + 8 * (r >> 2) + 4 * hi; }

#define XB_TMO      128
#define XB_XCNT(j)  (256  + 64 * (j))
#define XB_XSUB(j)  (1280 + 64 * (j))
#define XB_XGEN(j)  (2304 + 64 * (j))
#define XB_TOP      3328
#define XB_TOPGEN   3392
#define XCD_BAR_WORDS 3456
#define XB_SPIN_CAP (1u << 22)
__device__ __forceinline__ unsigned xb_ld(unsigned* p)              { return __hip_atomic_load(p, __ATOMIC_RELAXED, __HIP_MEMORY_SCOPE_AGENT); }
__device__ __forceinline__ unsigned xb_add(unsigned* p, unsigned v) { return __hip_atomic_fetch_add(p, v, __ATOMIC_RELAXED, __HIP_MEMORY_SCOPE_AGENT); }
__device__ __forceinline__ unsigned xb_xcc_id() { return (unsigned)__builtin_amdgcn_s_getreg((3 << 11) | 20) & 0xFu; }
#define XB_SPIN(cond, bar) do { unsigned _sp = 0; while (cond) { __builtin_amdgcn_s_sleep(1); \
    if ((++_sp & 255u) == 0u) { if (xb_ld(&(bar)[XB_TMO])) break; if (_sp > XB_SPIN_CAP) { atomicAdd(&(bar)[XB_TMO], 1u); break; } } } } while (0)
struct XcdBarrier { unsigned* bar; unsigned x; volatile LAS unsigned* st; int wv; };
__device__ __forceinline__ XcdBarrier xcd_barrier_post(unsigned* bar, volatile LAS unsigned* st, int wv) {
    XcdBarrier b; b.bar = bar; b.x = xb_xcc_id(); b.st = st; b.wv = wv;
    if (wv == 0 && lane_id() == 0) (void)xb_add(&bar[XB_XCNT(b.x)], 1u);
    return b;
}
__device__ __forceinline__ void xcd_barrier_complete(unsigned* bar, unsigned x, unsigned& nloc, unsigned& nx) {
    const unsigned G = gridDim.x * gridDim.y * gridDim.z;
    unsigned sum, cnt, mine, sp = 0u;
    for (;;) {
        sum = 0u; cnt = 0u; mine = 0u;
#pragma unroll
        for (unsigned j = 0; j < 16; ++j) { const unsigned c = xb_ld(&bar[XB_XCNT(j)]); sum += c; cnt += (c > 0u) ? 1u : 0u; mine = (j == x) ? c : mine; }
        if (sum == G) break;
        __builtin_amdgcn_s_sleep(1);
        if ((++sp & 255u) == 0u) { if (xb_ld(&bar[XB_TMO])) break; if (sp > XB_SPIN_CAP) { atomicAdd(&bar[XB_TMO], 1u); break; } }
    }
    nloc = mine > 0u ? mine : 1u; nx = cnt > 0u ? cnt : 1u;
}
__device__ __forceinline__ void xcd_barrier(const XcdBarrier& b) {
    asm volatile("s_waitcnt vmcnt(0)" ::: "memory");
    __syncthreads();
    if (b.wv == 0 && lane_id() == 0) {
        unsigned* bar = b.bar;
        __builtin_amdgcn_s_waitcnt(0);
        unsigned nloc = b.st[0], nx = b.st[1];
        if (nloc == 0u) { xcd_barrier_complete(bar, b.x, nloc, nx); b.st[0] = nloc; b.st[1] = nx; }
        const unsigned old = xb_add(&bar[XB_XSUB(b.x)], 1u);
        const unsigned gen = old / nloc;
        if (old + 1u == (gen + 1u) * nloc) {
            __builtin_amdgcn_fence(__ATOMIC_RELEASE, "agent");
            asm volatile("s_waitcnt vmcnt(0)" ::: "memory");
            const unsigned og = xb_add(&bar[XB_TOP], 1u);
            const unsigned tg = og / nx;
            if (og + 1u == (tg + 1u) * nx) xb_add(&bar[XB_TOPGEN], 1u);
            else XB_SPIN(xb_ld(&bar[XB_TOPGEN]) == tg, bar);
            __builtin_amdgcn_fence(__ATOMIC_ACQUIRE, "agent");
            xb_add(&bar[XB_XGEN(b.x)], 1u);
            asm volatile("s_waitcnt vmcnt(0)" ::: "memory");
        } else {
            XB_SPIN(xb_ld(&bar[XB_XGEN(b.x)]) == gen, bar);
            __builtin_amdgcn_fence(__ATOMIC_ACQUIRE, "agent");
            asm volatile("s_waitcnt vmcnt(0)" ::: "memory");
        }
    }
    __syncthreads();
}

namespace pg8 {
constexpr int BM = 256, BK = 64, HALF = 128, HTB = HALF * BK * 2, STAGE_BYTES = 8 * HTB, NXCD = 8, WGM = 8;
__host__ __device__ __forceinline__ int lds_byte(int r, int c) { const int st = (r >> 4) * 2 + (c >> 5), rr = r & 15, cc = c & 31, ob = rr * 64 + cc * 2; return st * 1024 + (ob ^ (((ob >> 9) & 1) << 5)); }
__host__ __device__ __forceinline__ void stage_rc(int b, int& R, int& C) { const int st = b / 1024, sb = b % 1024, swz = sb ^ (((sb >> 9) & 1) << 5); R = (st >> 1) * 16 + swz / 64; C = (st & 1) * 32 + (swz % 64) / 2; }
__host__ __device__ __forceinline__ int perm32(int rho) { const int n = rho >> 4, i = rho & 15; return 8 * (i >> 2) + 4 * n + (i & 3); }
typedef int v8i32 __attribute__((ext_vector_type(8))); typedef int v4i32 __attribute__((ext_vector_type(4)));
__device__ __forceinline__ v8i32 cat8(bf16x8 a, bf16x8 b) { const v4i32 x = __builtin_bit_cast(v4i32, a), y = __builtin_bit_cast(v4i32, b); return (v8i32){x[0], x[1], x[2], x[3], y[0], y[1], y[2], y[3]}; }
struct Unit { int pm, pn, pa, ro; };
struct Gemm { const void* A; const void* Bt; int lda, K; };
struct StaticOrder {
    int nM, nN, nwg, G, c;
    __device__ void init(int nM_, int nN_, int G_, int c_) { nM = nM_; nN = nN_; nwg = nM * nN; G = G_; c = c_; }
    __device__ __forceinline__ bool next(int i, Unit& u) const {
        const long L = (long)i * G + c; if (L >= nwg) return false;
        int wgid = (int)L; { const int q = nwg / NXCD, r = nwg % NXCD, xcd = wgid % NXCD, off = wgid / NXCD; wgid = (xcd < r ? xcd * (q + 1) : r * (q + 1) + (xcd - r) * q) + off; }
        const int nig = WGM * nN, gid = wgid / nig, fm = gid * WGM, gsz = (nM - fm) < WGM ? (nM - fm) : WGM;
        u.pm = fm + ((wgid % nig) % gsz); u.pn = (wgid % nig) / gsz; u.pa = u.pm; u.ro = 0; return true;
    }
};
struct MoeOrder {
    StaticOrder so; int ts[9]; bool gatherA;
    __device__ __forceinline__ bool next(int i, Unit& u) const {
        if (!so.next(i, u)) return false;
        int e = 0;
#pragma unroll
        for (int j = 1; j < 8; ++j) e += (u.pm >= ts[j]) ? 1 : 0;
        int te = 0;
#pragma unroll
        for (int j = 0; j < 8; ++j) te = (j == e) ? ts[j] : te;
        u.pn += e * so.nN; u.pa = gatherA ? e * (CAPR / 256) + (u.pm - te) : u.pm; u.ro = e * MTOT - te * 256; return true;
    }
};

template <int FMT, class Epi, class Sched>
__device__ __forceinline__ void gemm_phase(LAS unsigned char* lds, const Gemm g, const Sched& S, const Epi& E, const int wv) {
    const int tid = opaque_tid(wv), wid = __builtin_amdgcn_readfirstlane(tid >> 6), lane = tid & 63, wr = wid >> 2, wc = wid & 3, fr = lane & 15, fq = lane >> 4;
    constexpr int ESZ = FMT == 2 ? 2 : 1;
    int K_ = g.K, lda_ = g.lda; asm volatile("" : "+s"(K_), "+s"(lda_));
    const int K = K_ * ESZ, nt = K / (BK * 2), lda = lda_ * ESZ;
    unsigned voffA[2], voffB[2];
#pragma unroll
    for (int i = 0; i < 2; ++i) { int R, C; stage_rc(tid * 16 + i * 8192, R, C); const int Rb = Epi::PERM ? ((R & ~31) + perm32(R & 31)) : R;
        voffA[i] = (unsigned)(R * lda + C * 2); voffB[i] = (unsigned)(Rb * K + C * 2); }
    const size_t kstep = (size_t)(BK * 2);
    const size_t hstepA = (size_t)HALF * lda, hstepB = (size_t)HALF * K;
    const size_t tstepA = 2 * hstepA, tstepB = 2 * hstepB;
    const unsigned ldsw = (unsigned)wid * 1024u;
    const int aoff = lds_byte(wr * 64 + fr, fq * 8), boff = lds_byte(wc * 32 + fr, fq * 8);
#define PG8_SA(b, h) (((b) * 2 + (h)) * HTB)
#define PG8_SB(b, h) ((4 + (b) * 2 + (h)) * HTB)
#define PG8_STAGE(bufoff, gbase, voff) do { _Pragma("unroll") for (int _i = 0; _i < 2; ++_i) \
        __builtin_amdgcn_global_load_lds((const unsigned*)((const char*)(gbase) + (voff)[_i]), (LAS unsigned*)(lds + (bufoff) + ldsw + _i * 8192), 16, 0, 0); } while (0)
#define PG8_LD8(addr) __builtin_shufflevector(*(const LAS v4i32*)(addr), *(const LAS v4i32*)((addr) + 1024), 0, 1, 2, 3, 4, 5, 6, 7)
#define PG8_LDA(dst, b, h) do { _Pragma("unroll") for (int m = 0; m < 4; ++m) dst[m] = PG8_LD8(lds + PG8_SA(b, h) + aoff + m * 2048); } while (0)
#define PG8_LDB(dst, b, h) do { _Pragma("unroll") for (int n = 0; n < 2; ++n) dst[n] = PG8_LD8(lds + PG8_SB(b, h) + boff + n * 2048); } while (0)
#define PG8_LO(v) __builtin_bit_cast(bf16x8, __builtin_shufflevector(v, v, 0, 1, 2, 3))
#define PG8_HI(v) __builtin_bit_cast(bf16x8, __builtin_shufflevector(v, v, 4, 5, 6, 7))
#define PG8_MMA(ai, bj, At, Bt) do { __builtin_amdgcn_s_setprio(1); \
        if constexpr (FMT == 3) { _Pragma("unroll") for (int m = 0; m < 4; ++m) _Pragma("unroll") for (int n = 0; n < 2; ++n) { \
            v4i32 c_ = __builtin_bit_cast(v4i32, acc[ai][bj][m][n]); \
            c_ = __builtin_amdgcn_mfma_i32_16x16x64_i8(__builtin_shufflevector(Bt[n], Bt[n], 0, 1, 2, 3), __builtin_shufflevector(At[m], At[m], 0, 1, 2, 3), c_, 0, 0, 0); \
            c_ = __builtin_amdgcn_mfma_i32_16x16x64_i8(__builtin_shufflevector(Bt[n], Bt[n], 4, 5, 6, 7), __builtin_shufflevector(At[m], At[m], 4, 5, 6, 7), c_, 0, 0, 0); \
            acc[ai][bj][m][n] = __builtin_bit_cast(f32x4, c_); } } \
        else if constexpr (FMT == 2) { _Pragma("unroll") for (int m = 0; m < 4; ++m) _Pragma("unroll") for (int n = 0; n < 2; ++n) { \
            acc[ai][bj][m][n] = __builtin_amdgcn_mfma_f32_16x16x32_bf16(PG8_LO(Bt[n]), PG8_LO(At[m]), acc[ai][bj][m][n], 0, 0, 0); \
            acc[ai][bj][m][n] = __builtin_amdgcn_mfma_f32_16x16x32_bf16(PG8_HI(Bt[n]), PG8_HI(At[m]), acc[ai][bj][m][n], 0, 0, 0); } } \
        else { asm volatile("s_nop 1\n\t" \
            "v_mfma_f32_16x16x128_f8f6f4 %0, %8, %10, %0\n\t" "v_mfma_f32_16x16x128_f8f6f4 %1, %9, %10, %1\n\t" \
            "v_mfma_f32_16x16x128_f8f6f4 %2, %8, %11, %2\n\t" "v_mfma_f32_16x16x128_f8f6f4 %3, %9, %11, %3\n\t" \
            "v_mfma_f32_16x16x128_f8f6f4 %4, %8, %12, %4\n\t" "v_mfma_f32_16x16x128_f8f6f4 %5, %9, %12, %5\n\t" \
            "v_mfma_f32_16x16x128_f8f6f4 %6, %8, %13, %6\n\t" "v_mfma_f32_16x16x128_f8f6f4 %7, %9, %13, %7\n\t" \
            "s_nop 11" \
            : "+v"(acc[ai][bj][0][0]), "+v"(acc[ai][bj][0][1]), "+v"(acc[ai][bj][1][0]), "+v"(acc[ai][bj][1][1]), "+v"(acc[ai][bj][2][0]), "+v"(acc[ai][bj][2][1]), "+v"(acc[ai][bj][3][0]), "+v"(acc[ai][bj][3][1]) \
            : "v"(Bt[0]), "v"(Bt[1]), "v"(At[0]), "v"(At[1]), "v"(At[2]), "v"(At[3]), "v"(scl8)); } \
        __builtin_amdgcn_s_setprio(0); } while (0)
#define PG8_WAIT_V(n) asm volatile("s_waitcnt vmcnt(" #n ")" ::: "memory")
#define PG8_WAIT_L(n) asm volatile("s_waitcnt lgkmcnt(" #n ")" ::: "memory")
#define PG8_BAR __builtin_amdgcn_s_barrier()
#define PG8_SCHED __builtin_amdgcn_sched_barrier(0)
    Unit cur, nxt; int ui = 0;
    if (!S.next(0, cur)) return;
    f32x4 acc[2][2][4][2];
#pragma unroll
    for (int a = 0; a < 2; ++a)
#pragma unroll
        for (int b = 0; b < 2; ++b)
#pragma unroll
            for (int m = 0; m < 4; ++m)
#pragma unroll
                for (int n = 0; n < 2; ++n) acc[a][b][m][n] = (f32x4){0.f, 0.f, 0.f, 0.f};
    v8i32 At[4], B0[2], B1[2];
    const int scl8 = 0x7F7F7F7F;
    const char* cA = (const char*)g.A + (size_t)cur.pa * tstepA; const char* cB = (const char*)g.Bt + (size_t)cur.pn * tstepB;
    PG8_STAGE(PG8_SB(0, 0), cB, voffB); PG8_STAGE(PG8_SB(0, 1), cB + hstepB, voffB); PG8_STAGE(PG8_SA(0, 0), cA, voffA); PG8_STAGE(PG8_SA(0, 1), cA + hstepA, voffA);
    if (wr == 1) PG8_BAR;
    PG8_WAIT_V(2); PG8_BAR;
    PG8_STAGE(PG8_SB(1, 0), cB + kstep, voffB); PG8_STAGE(PG8_SA(1, 0), cA + kstep, voffA); PG8_STAGE(PG8_SB(1, 1), cB + hstepB + kstep, voffB);
    PG8_WAIT_V(6); PG8_BAR;
    for (;;) {
        const bool has_next = S.next(ui + 1, nxt);
        const char* nA = has_next ? (const char*)g.A + (size_t)nxt.pa * tstepA : cA; const char* nB = has_next ? (const char*)g.Bt + (size_t)nxt.pn * tstepB : cB;
#pragma unroll 1
        for (int t = 0; t < nt; t += 2) {
            const bool last = (t == nt - 2);
            const char* a1 = cA + (size_t)(t + 1) * kstep;
            const char* a2 = last ? nA : cA + (size_t)(t + 2) * kstep; const char* b2 = last ? nB : cB + (size_t)(t + 2) * kstep;
            const char* a3 = a2 + kstep; const char* b3 = b2 + kstep;
            PG8_LDB(B0, 0, 0); PG8_LDB(B1, 0, 1); PG8_SCHED; PG8_LDA(At, 0, 0); PG8_STAGE(PG8_SA(1, 1), a1 + hstepA, voffA);
            PG8_WAIT_V(8); PG8_WAIT_L(0); PG8_BAR; PG8_MMA(0, 0, At, B0); PG8_MMA(0, 1, At, B1); PG8_BAR; PG8_SCHED;
            PG8_LDA(At, 0, 1); PG8_STAGE(PG8_SB(0, 0), b2, voffB); PG8_STAGE(PG8_SB(0, 1), b2 + hstepB, voffB); PG8_STAGE(PG8_SA(0, 0), a2, voffA);
            PG8_WAIT_V(8); PG8_WAIT_L(0); PG8_BAR; PG8_MMA(1, 0, At, B0); PG8_MMA(1, 1, At, B1); PG8_BAR; PG8_SCHED;
            PG8_LDB(B0, 1, 0); PG8_LDB(B1, 1, 1); PG8_SCHED; PG8_LDA(At, 1, 0); PG8_STAGE(PG8_SA(0, 1), a2 + hstepA, voffA);
            PG8_WAIT_V(8); PG8_WAIT_L(0); PG8_BAR; PG8_MMA(0, 0, At, B0); PG8_MMA(0, 1, At, B1); PG8_BAR; PG8_SCHED;
            PG8_LDA(At, 1, 1); PG8_STAGE(PG8_SB(1, 0), b3, voffB); PG8_STAGE(PG8_SB(1, 1), b3 + hstepB, voffB); PG8_STAGE(PG8_SA(1, 0), a3, voffA);
            PG8_WAIT_V(8); PG8_WAIT_L(0); PG8_BAR; PG8_MMA(1, 0, At, B0); PG8_MMA(1, 1, At, B1); PG8_BAR; PG8_SCHED;
        }
        if (wr == 0) PG8_BAR;
        E(acc, cur, wr, wc, fr, fq);
        if (!has_next) break;
#pragma unroll
        for (int a = 0; a < 2; ++a)
#pragma unroll
            for (int b = 0; b < 2; ++b)
#pragma unroll
                for (int m = 0; m < 4; ++m)
#pragma unroll
                    for (int n = 0; n < 2; ++n) acc[a][b][m][n] = (f32x4){0.f, 0.f, 0.f, 0.f};
        cur = nxt; cA = nA; cB = nB; ++ui;
        if (wr == 1) PG8_BAR;
    }
    PG8_WAIT_V(0);
    PG8_BAR;
#undef PG8_SA
#undef PG8_SB
#undef PG8_STAGE
#undef PG8_LDA
#undef PG8_LD8
#undef PG8_LO
#undef PG8_HI
#undef PG8_LDB
#undef PG8_MMA
#undef PG8_WAIT_V
#undef PG8_WAIT_L
#undef PG8_BAR
#undef PG8_SCHED
}

struct EpiBf16S {
    static constexpr bool PERM = true;
    bf16_t* O; int ldc; int ncol_tiles; const float* rowscale; float scale;
    __device__ __forceinline__ void operator()(const f32x4 (&acc)[2][2][4][2], const Unit& u, int wr, int wc, int fr, int fq) const {
        const int row0 = u.pm * BM + wr * 64 + fr, col0 = (u.pn % ncol_tiles) * BM + wc * 32 + 8 * fq;
        float rsv[2][4];
#pragma unroll
        for (int ai = 0; ai < 2; ++ai)
#pragma unroll
            for (int m = 0; m < 4; ++m) rsv[ai][m] = rowscale ? rowscale[(ptrdiff_t)u.ro + row0 + ai * HALF + m * 16] * scale : scale;
#pragma unroll
        for (int ai = 0; ai < 2; ++ai)
#pragma unroll
            for (int m = 0; m < 4; ++m) { const int row = row0 + ai * HALF + m * 16; bf16_t* rowp = O + (size_t)row * ldc + col0; const float rs = rsv[ai][m];
#pragma unroll
                for (int bj = 0; bj < 2; ++bj) { const f32x4 v0 = acc[ai][bj][m][0] * rs, v1 = acc[ai][bj][m][1] * rs;
                    u32x4 w; w.x = pk_bf16(v0[0], v0[1]); w.y = pk_bf16(v0[2], v0[3]); w.z = pk_bf16(v1[0], v1[1]); w.w = pk_bf16(v1[2], v1[3]);
                    *(u32x4*)(rowp + bj * HALF) = w; } }
    }
};
struct EpiBf16 {
    static constexpr bool PERM = true;
    bf16_t* O; int ldc;
    __device__ __forceinline__ void operator()(const f32x4 (&acc)[2][2][4][2], const Unit& u, int wr, int wc, int fr, int fq) const {
        const int row0 = u.pm * BM + wr * 64 + fr, col0 = u.pn * BM + wc * 32 + 8 * fq;
#pragma unroll
        for (int ai = 0; ai < 2; ++ai)
#pragma unroll
            for (int m = 0; m < 4; ++m) { bf16_t* rowp = O + (size_t)(row0 + ai * HALF + m * 16) * ldc + col0;
#pragma unroll
                for (int bj = 0; bj < 2; ++bj) { const f32x4 v0 = acc[ai][bj][m][0], v1 = acc[ai][bj][m][1];
                    u32x4 w; w.x = pk_bf16(v0[0], v0[1]); w.y = pk_bf16(v0[2], v0[3]); w.z = pk_bf16(v1[0], v1[1]); w.w = pk_bf16(v1[2], v1[3]);
                    *(u32x4*)(rowp + bj * HALF) = w; } }
    }
};
template <int NS> struct EpiBf16N {
    static constexpr bool PERM = true;
    bf16_t* O; int ldc; const float* ssq; float invn;
    __device__ __forceinline__ void operator()(const f32x4 (&acc)[2][2][4][2], const Unit& u, int wr, int wc, int fr, int fq) const {
        const int row0 = u.pm * BM + wr * 64 + fr, col0 = u.pn * BM + wc * 32 + 8 * fq;
        float rsv[2][4];
#pragma unroll
        for (int ai = 0; ai < 2; ++ai)
#pragma unroll
            for (int m = 0; m < 4; ++m) { const float* sp = ssq + (size_t)(row0 + ai * HALF + m * 16) * 16; const f32x4 a = *(const f32x4*)sp; float t = (a[0] + a[1]) + (a[2] + a[3]);
                if (NS == 8) { const f32x4 b = *(const f32x4*)(sp + 4); t += (b[0] + b[1]) + (b[2] + b[3]); }
                rsv[ai][m] = rsqrtf(t * invn + EPSN); }
#pragma unroll
        for (int ai = 0; ai < 2; ++ai)
#pragma unroll
            for (int m = 0; m < 4; ++m) { bf16_t* rowp = O + (size_t)(row0 + ai * HALF + m * 16) * ldc + col0; const float rs = rsv[ai][m];
#pragma unroll
                for (int bj = 0; bj < 2; ++bj) { const f32x4 v0 = acc[ai][bj][m][0] * rs, v1 = acc[ai][bj][m][1] * rs;
                    u32x4 w; w.x = pk_bf16(v0[0], v0[1]); w.y = pk_bf16(v0[2], v0[3]); w.z = pk_bf16(v1[0], v1[1]); w.w = pk_bf16(v1[2], v1[3]);
                    *(u32x4*)(rowp + bj * HALF) = w; } }
    }
};
template <bool OUT8> struct EpiSwiGLU {
    static constexpr bool PERM = true;
    unsigned char* O; int ldc; int ncol_tiles; const float* rowscale; const float* colscale;
    __device__ __forceinline__ void operator()(const f32x4 (&acc)[2][2][4][2], const Unit& u, int wr, int wc, int fr, int fq) const {
        const int row0 = u.pm * BM + wr * 64 + fr, col0 = (u.pn % ncol_tiles) * HALF + wc * 32 + 8 * fq;
        const float cg = colscale[(size_t)u.pn * BM + wc * 32], cu = colscale[(size_t)u.pn * BM + HALF + wc * 32];
        const float cgl = cg * (-LOG2E), cgu = cg * cu;
        float rsv[2][4];
#pragma unroll
        for (int ai = 0; ai < 2; ++ai)
#pragma unroll
            for (int m = 0; m < 4; ++m) rsv[ai][m] = rowscale[(ptrdiff_t)u.ro + row0 + ai * HALF + m * 16];
#pragma unroll
        for (int ai = 0; ai < 2; ++ai)
#pragma unroll
            for (int m = 0; m < 4; ++m) { const int row = row0 + ai * HALF + m * 16; unsigned char* rowp = O + ((size_t)row * ldc + col0) * (OUT8 ? 1 : 2);
                const float rs = rsv[ai][m], kt = rs * cgl, iko = fast_rcp((rs * rs) * cgu);
                const v4i32 ig0 = __builtin_bit_cast(v4i32, acc[ai][0][m][0]), ig1 = __builtin_bit_cast(v4i32, acc[ai][0][m][1]), iu0 = __builtin_bit_cast(v4i32, acc[ai][1][m][0]), iu1 = __builtin_bit_cast(v4i32, acc[ai][1][m][1]);
                f32x2 g[4], uu[4], e[4], a[4];
#pragma unroll
                for (int k = 0; k < 2; ++k) { g[k] = (f32x2){(float)ig0[2 * k], (float)ig0[2 * k + 1]}; g[2 + k] = (f32x2){(float)ig1[2 * k], (float)ig1[2 * k + 1]}; uu[k] = (f32x2){(float)iu0[2 * k], (float)iu0[2 * k + 1]}; uu[2 + k] = (f32x2){(float)iu1[2 * k], (float)iu1[2 * k + 1]}; }
#pragma unroll
                for (int k = 0; k < 4; ++k) e[k] = g[k] * kt;
#pragma unroll
                for (int k = 0; k < 4; ++k) { e[k].x = fast_exp2(e[k].x); e[k].y = fast_exp2(e[k].y); }
#pragma unroll
                for (int k = 0; k < 4; ++k) a[k] = g[k] * uu[k];
#pragma unroll
                for (int k = 0; k < 4; ++k) e[k] = e[k] * iko + iko;
#pragma unroll
                for (int k = 0; k < 4; ++k) { e[k].x = fast_rcp(e[k].x); e[k].y = fast_rcp(e[k].y); }
#pragma unroll
                for (int k = 0; k < 4; ++k) a[k] = a[k] * e[k];
                if (OUT8) { u32x2 w; w.x = pk_fp8x4(a[0].x, a[0].y, a[1].x, a[1].y); w.y = pk_fp8x4(a[2].x, a[2].y, a[3].x, a[3].y); *(u32x2*)rowp = w; }
                else { u32x4 w; w.x = pk_bf16(a[0].x, a[0].y); w.y = pk_bf16(a[1].x, a[1].y); w.z = pk_bf16(a[2].x, a[2].y); w.w = pk_bf16(a[3].x, a[3].y); *(u32x4*)rowp = w; } }
    }
};
template <int MODE> struct EpiRope {
    static constexpr bool PERM = false;
    bf16_t* O; int ldc; const float* tab;
    const float* rowscale; const float* colscale;
    float* ssq;
    __device__ __forceinline__ static int kind(int gi) {
        if (MODE == 0) return (gi >= 48 && gi < 68) ? 1 + (gi & 1) : 0;
        if (MODE == 1) return gi == 12 ? 3 : ((gi >= 16 && gi < 48) ? 1 + (gi & 1) : 0);
        return (gi == 2 || gi == 5 || gi == 8 || gi == 11 || gi == 14 || gi == 17 || gi == 20 || gi == 23) ? 3 : 0;
    }
    __device__ __forceinline__ void operator()(const f32x4 (&acc)[2][2][4][2], const Unit& u, int wr, int wc, int fr, int fq) const {
        const int row0 = u.pm * BM + wr * 64 + fr;
        const bool lat = u.pm < (MLAT / BM);
        float rsv[2][4];
#pragma unroll
        for (int ai = 0; ai < 2; ++ai)
#pragma unroll
            for (int m = 0; m < 4; ++m) rsv[ai][m] = rowscale[(ptrdiff_t)u.ro + row0 + ai * HALF + m * 16];
#pragma unroll
        for (int bj = 0; bj < 2; ++bj) {
            const int gi = u.pn * 8 + bj * 4 + wc; const int kd = lat ? kind(gi) : 0;
            const int col0 = gi * 32 + 4 * fq;
            const f32x4 cs1 = *(const f32x4*)(colscale + col0), cs2 = *(const f32x4*)(colscale + col0 + 16);
#pragma unroll
            for (int ai = 0; ai < 2; ++ai)
#pragma unroll
                for (int m = 0; m < 4; ++m) {
                    const int row = row0 + ai * HALF + m * 16; bf16_t* rowp = O + (size_t)row * ldc + col0;
                    const float rsc = rsv[ai][m]; const v4i32 i1 = __builtin_bit_cast(v4i32, acc[ai][bj][m][0]), i2 = __builtin_bit_cast(v4i32, acc[ai][bj][m][1]);
                    f32x4 x1, x2;
#pragma unroll
                    for (int k = 0; k < 4; ++k) { x1[k] = (float)i1[k] * (rsc * cs1[k]); x2[k] = (float)i2[k] * (rsc * cs2[k]); }
                    if (kd != 0) {
                        const int s = row & (SEQ - 1), gr = s >> 6, gc = s & 63;
                        f32x4 cs, sn;
                        if (kd == 3) { const int pos = fq < 2 ? gr : gc; cs = *(const f32x4*)(tab + 2048 + pos * 8 + 4 * (fq & 1)); sn = *(const f32x4*)(tab + 2048 + 512 + pos * 8 + 4 * (fq & 1)); }
                        else { const int pos = kd == 1 ? gr : gc; cs = *(const f32x4*)(tab + pos * 16 + 4 * fq); sn = *(const f32x4*)(tab + 1024 + pos * 16 + 4 * fq); }
                        const f32x4 o1 = x1 * cs - x2 * sn, o2 = x2 * cs + x1 * sn; x1 = o1; x2 = o2;
                    }
                    u32x2 w0, w1; w0.x = pk_bf16(x1[0], x1[1]); w0.y = pk_bf16(x1[2], x1[3]); w1.x = pk_bf16(x2[0], x2[1]); w1.y = pk_bf16(x2[2], x2[3]);
                    if (MODE == 1 && (u.pn == 0 || (u.pn == 1 && bj == 0))) {
                        float ss = bf_lo(w0.x) * bf_lo(w0.x) + bf_hi(w0.x) * bf_hi(w0.x) + bf_lo(w0.y) * bf_lo(w0.y) + bf_hi(w0.y) * bf_hi(w0.y) + bf_lo(w1.x) * bf_lo(w1.x) + bf_hi(w1.x) * bf_hi(w1.x) + bf_lo(w1.y) * bf_lo(w1.y) + bf_hi(w1.y) * bf_hi(w1.y);
                        { const auto rr = __builtin_amdgcn_permlane16_swap(__float_as_uint(ss), __float_as_uint(ss), false, false); ss = __uint_as_float(rr[0]) + __uint_as_float(rr[1]); }
                        { const auto rr = __builtin_amdgcn_permlane32_swap(__float_as_uint(ss), __float_as_uint(ss), false, false); ss = __uint_as_float(rr[0]) + __uint_as_float(rr[1]); }
                        if (fq == 0) ssq[(size_t)row * 16 + (u.pn == 0 ? bj * 4 + wc : 8 + wc)] = ss;
                    }
                    { const auto r = __builtin_amdgcn_permlane16_swap(w0.x, w1.x, false, false); w0.x = r[0]; w1.x = r[1]; }
                    { const auto r = __builtin_amdgcn_permlane16_swap(w0.y, w1.y, false, false); w0.y = r[0]; w1.y = r[1]; }
                    *(u32x4*)(rowp + ((fq & 1) ? 12 : 0)) = (u32x4){w0.x, w0.y, w1.x, w1.y};
                    asm volatile("" ::: "memory");
                }
        }
    }
};
}

__device__ __forceinline__ unsigned char* fresh_ws() {
    static_assert(offsetof(Params, ws) == 200, "Params layout");
    unsigned long long w; const unsigned long long ka = (unsigned long long)__builtin_amdgcn_kernarg_segment_ptr();
    asm volatile("s_load_dwordx2 %0, %1, 0xc8\n\ts_waitcnt lgkmcnt(0)" : "=s"(w) : "s"(ka) : "memory");
    return (unsigned char*)(__attribute__((address_space(1))) unsigned char*)w;
}
__device__ __forceinline__ int rope_orig(int p) { return p < 8 ? p : (p < 16 ? 16 + (p - 8) : (p < 24 ? 8 + (p - 16) : p)); }

struct ConvJob { const float* src; bf16_t* dst; const float* scale; int Ksrc, Nsrc, Kdst, nb, kb, map, f8; };
constexpr float W8_SCALE = 64.0f;
constexpr int CJ_NMAT[10]  = {0, 2, 0, 2, 2, 2, 0, 2, 0, 16};
constexpr int CJ_NB[10]    = {18, 8, 16, 6, 8, 8, 44, 8, 56, 8};
constexpr int CJ_KB[10]    = {16, 16, 16, 4, 4, 16, 16, FFN_DOWN_FP8 ? 22 : 44, 16, FFN_DOWN_FP8 ? 28 : 56};
__device__ __forceinline__ int conv_tiles(int j) { return CJ_NMAT[j] * CJ_NB[j] * CJ_KB[j]; }
constexpr int conv_tiles_total() { int s = 0; for (int j = 0; j < 10; ++j) s += CJ_NMAT[j] * CJ_NB[j] * CJ_KB[j]; return s; }
__device__ __forceinline__ int conv_map(int map, int n) {
    switch (map) {
    case 0: return n;
    case 1:
        if (n < 256) return n; if (n < 384) return 768 + (n - 256); if (n < 416) return 896 + rope_orig(n - 384); if (n < 512) return -1;
        if (n < 1024) return 256 + (n - 512); if (n < 1536) return 928 + (n - 1024); return 1440 + (n - 1536);
    case 2: { const int h = n / 96, j = n % 96; return j < 64 ? n : h * 96 + 64 + rope_orig(j - 64); }
    case 3: { const int t = n >> 8, r = n & 255; return r < 128 ? t * 128 + r : FFD + t * 128 + (r - 128); }
    default: { const int t = n >> 8, r = n & 255; return r < 128 ? t * 128 + r : FFE + t * 128 + (r - 128); }
    }
}
__device__ __forceinline__ ConvJob conv_job(const Params& p, unsigned char* ws, int j, int mat) {
    ConvJob c; c.scale = nullptr; c.map = 0; c.nb = CJ_NB[j]; c.kb = CJ_KB[j]; c.f8 = FFN_DOWN_FP8 && (j == 7 || j == 9);
    switch (j) {
    case 0: c.src = p.in[7] + (size_t)mat * 1024 * EVEN_IN; c.dst = (bf16_t*)(ws + OFF_WINE + mat * SZ_WINE); c.Ksrc = 1024; c.Nsrc = EVEN_IN; c.Kdst = 1024; break;
    case 1: c.src = p.in[10] + (size_t)mat * 1024 * 1024; c.dst = (bf16_t*)(ws + OFF_WOUTE + mat * SZ_WOUT); c.Ksrc = 1024; c.Nsrc = 1024; c.Kdst = 1024; break;
    case 2: c.src = p.in[11] + (size_t)mat * 1024 * 1952; c.dst = (bf16_t*)(ws + OFF_WINO + mat * SZ_WINO); c.Ksrc = 1024; c.Nsrc = 1952; c.Kdst = 1024; c.map = 1; break;
    case 3: c.src = p.in[14] + (size_t)mat * 256 * 768; c.dst = (bf16_t*)(ws + OFF_WQUP + mat * SZ_WQUP); c.Ksrc = 256; c.Nsrc = 768; c.Kdst = 256; c.map = 2; c.scale = p.in[12] + mat * 256; break;
    case 4: c.src = p.in[15] + (size_t)mat * 128 * 1024; c.dst = (bf16_t*)(ws + OFF_WKVUP + mat * SZ_WKVUP); c.Ksrc = 128; c.Nsrc = 1024; c.Kdst = 256; c.scale = p.in[13] + mat * 128; break;
    case 5: c.src = p.in[18] + (size_t)mat * 1024 * 1024; c.dst = (bf16_t*)(ws + OFF_WOUTO + mat * SZ_WOUT); c.Ksrc = 1024; c.Nsrc = 1024; c.Kdst = 1024; break;
    case 6: c.src = p.in[19] + (size_t)mat * 1024 * 2 * FFD; c.dst = (bf16_t*)(ws + OFF_WGU + mat * SZ_WGU); c.Ksrc = 1024; c.Nsrc = 2 * FFD; c.Kdst = 1024; c.map = 3; break;
    case 7: c.src = p.in[20] + (size_t)mat * FFD * 1024; c.dst = (bf16_t*)(ws + OFF_WDN + mat * SZ_WDN); c.Ksrc = FFD; c.Nsrc = 1024; c.Kdst = FFD; break;
    case 8: c.src = p.in[22] + (size_t)mat * 1024 * 2 * FFE; c.dst = (bf16_t*)(ws + OFF_WEGU + mat * (SZ_WEGU / 2)); c.Ksrc = 1024; c.Nsrc = 2 * FFE; c.Kdst = 1024; c.map = 4; break;
    default: c.src = p.in[23] + (size_t)mat * FFE * 1024; c.dst = (bf16_t*)(ws + OFF_WEDN + mat * (SZ_WEDN / (FFN_DOWN_FP8 ? 2 : 1))); c.Ksrc = FFE; c.Nsrc = 1024; c.Kdst = FFE; break;
    }
    return c;
}

constexpr int CV_NU_D = 2 * (2 * FFD / 64), CV_NU_IE = 2 * (EVEN_IN / 64), CV_NU_IO = 2 * (ODD_INP / 64), CV_NU_E = 16 * (2 * FFE / 64), CV_NU_PRO = CV_NU_D + CV_NU_IE + CV_NU_IO, CV_NU = CV_NU_PRO + CV_NU_E;
constexpr int TAIL_U_SPLIT = 560, TAIL_T_SPLIT = 1100;
constexpr int CV_NT = conv_tiles_total(), CV_NT_E = CJ_NMAT[9] * CJ_NB[9] * CJ_KB[9], CV_NT_PRO = CV_NT - CV_NT_E;
__device__ __forceinline__ void conv_units(const Params& p, LAS unsigned char* lds, const int tid, int lo, int hi, int first, int stride) {
    unsigned char* ws = fresh_ws();
    __syncthreads();
    {
        constexpr int WP = 2052;
        LAS unsigned char* wl = lds;
        LAS float* cmx = (LAS float*)(lds + 64 * WP);
        constexpr int NU_D = CV_NU_D, NU_E = CV_NU_E, NU_IE = CV_NU_IE, NU_IO = CV_NU_IO;
        const int cq = tid & 15, rg = tid >> 4, wvn = tid >> 6, col = tid >> 3, piece = tid & 7;
        struct U8 { const float* sp; unsigned char* dst; float* wsc; int Nsrc, ok, blk; };
        auto decode = [&](int u) -> U8 {
            const int cat = u < NU_D ? 0 : (u < NU_D + NU_IE ? 2 : (u < NU_D + NU_IE + NU_IO ? 3 : 1));
            const int uu = u - (cat == 0 ? 0 : (cat == 2 ? NU_D : (cat == 3 ? NU_D + NU_IE : NU_D + NU_IE + NU_IO)));
            const int Ndst = cat == 0 ? 2 * FFD : (cat == 1 ? 2 * FFE : (cat == 2 ? EVEN_IN : ODD_INP)), nbp = Ndst / 64, mat = uu / nbp, nbi = uu % nbp;
            U8 U; U.Nsrc = cat == 3 ? 1952 : Ndst;
            const float* src = (cat == 0 ? p.in[19] : (cat == 1 ? p.in[22] : (cat == 2 ? p.in[7] : p.in[11]))) + (size_t)mat * 1024 * U.Nsrc;
            unsigned char* dstb = cat == 0 ? ws + OFF_WGU + (size_t)mat * SZ_WGU : (cat == 1 ? ws + OFF_WEGU + (size_t)mat * (SZ_WEGU / 2) : (cat == 2 ? ws + OFF_WINE + (size_t)mat * SZ_WINE : ws + OFF_WINO + (size_t)mat * SZ_WINO));
            float* wscb = (cat == 0 ? (float*)(ws + OFF_WSCD) : (cat == 1 ? (float*)(ws + OFF_WSCE) : (cat == 2 ? (float*)(ws + OFF_WSCI) : (float*)(ws + OFF_WSCI) + 2 * EVEN_IN))) + (size_t)mat * Ndst;
            const int cmap = cat == 0 ? 3 : (cat == 1 ? 4 : (cat == 2 ? 0 : 1));
            const int sc = conv_map(cmap, nbi * 64 + cq * 4);
            U.blk = cat < 2; U.ok = sc >= 0; U.sp = src + (size_t)rg * U.Nsrc + (sc >= 0 ? sc : 0); U.dst = dstb + (size_t)(nbi * 64) * 1024; U.wsc = wscb + nbi * 64; return U; };
        auto ldg = [&](const float*& ptr, size_t step, int ok, f32x4 (&v)[8]) {
#pragma unroll
            for (int i = 0; i < 8; ++i) { v[i] = ok ? __builtin_nontemporal_load((const f32x4*)ptr) : (f32x4){0.f, 0.f, 0.f, 0.f}; ptr += step; } };
        auto consume = [&](int q, const f32x4 (&v)[8], f32x4& cm) {
#pragma unroll
            for (int i = 0; i < 8; ++i) { cm = __builtin_elementwise_max(cm, __builtin_elementwise_abs(v[i]));
                const unsigned w0 = pk_bf16(v[i][0], v[i][1]), w1 = pk_bf16(v[i][2], v[i][3]);
                LAS unsigned short* bp = (LAS unsigned short*)(wl + (cq * 4) * WP + ((q * 8 + i) * 32 + rg) * 2);
                bp[0] = (unsigned short)w0; bp[WP / 2] = (unsigned short)(w0 >> 16); bp[WP] = (unsigned short)w1; bp[3 * (WP / 2)] = (unsigned short)(w1 >> 16); } };
        int u = lo + first;
        if (u < hi) {
            U8 U = decode(u);
            f32x4 q0[8], q1[8], q2[8], q3[8];
            const float* lp = U.sp; size_t lstep = (size_t)32 * U.Nsrc; int lok = U.ok;
            ldg(lp, lstep, lok, q0); ldg(lp, lstep, lok, q1);
#pragma unroll 1
            for (;;) {
                const int un = u + stride; const bool hn = un < hi;
                U8 Un = U; if (hn) Un = decode(un);
                f32x4 cm = (f32x4){0.f, 0.f, 0.f, 0.f};
                ldg(lp, lstep, lok, q2); consume(0, q0, cm);
                ldg(lp, lstep, lok, q3); consume(1, q1, cm);
                lp = Un.sp; lstep = (size_t)32 * Un.Nsrc; lok = Un.ok;
                if (hn) ldg(lp, lstep, lok, q0);
                consume(2, q2, cm);
                if (hn) ldg(lp, lstep, lok, q1);
                consume(3, q3, cm);
#pragma unroll
                for (int c = 0; c < 4; ++c) { float v = cm[c];
                    { const auto rr = __builtin_amdgcn_permlane16_swap(__float_as_uint(v), __float_as_uint(v), false, false); v = fmaxf(__uint_as_float(rr[0]), __uint_as_float(rr[1])); }
                    { const auto rr = __builtin_amdgcn_permlane32_swap(__float_as_uint(v), __float_as_uint(v), false, false); v = fmaxf(__uint_as_float(rr[0]), __uint_as_float(rr[1])); }
                    cm[c] = v; }
                if ((tid & 63) < 16) *(LAS f32x4*)(cmx + wvn * 64 + cq * 4) = cm;
                __syncthreads();
                float mx = 0.f;
#pragma unroll
                for (int w = 0; w < 8; ++w) mx = fmaxf(mx, cmx[w * 64 + col]);
                if (U.blk) {
                    mx = wave_max(mx); if ((tid & 63) == 0) cmx[512 + wvn] = mx; __syncthreads();
#pragma unroll
                    for (int w = 0; w < 8; ++w) mx = fmaxf(mx, cmx[512 + w]);
                }
                mx = mx > 0.f ? mx : 1.0f;
                const float inv = 127.0f / mx;
                if (piece == 0) U.wsc[col] = mx * (1.0f / 127.0f);
#pragma unroll 2
                for (int it = 0; it < 8; ++it) {
                    const int k0 = it * 128 + piece * 16;
                    const LAS unsigned* rp = (const LAS unsigned*)(wl + col * WP + k0 * 2);
                    unsigned w[8];
#pragma unroll
                    for (int j = 0; j < 8; ++j) w[j] = rp[j];
                    u32x4 o;
#pragma unroll
                    for (int j = 0; j < 4; ++j) o[j] = pk_i8x4(bf_lo(w[2 * j]) * inv, bf_hi(w[2 * j]) * inv, bf_lo(w[2 * j + 1]) * inv, bf_hi(w[2 * j + 1]) * inv);
                    *(u32x4*)(U.dst + (size_t)col * 1024 + k0) = o;
                }
                __syncthreads();
                if (!hn) break;
                U = Un; u = un;
            }
        }
    }
    __syncthreads();
}

__device__ __forceinline__ void conv_tiles_run(const Params& p, LAS unsigned char* lds, const int tid, int lo, int hi, int first, int stride) {
    unsigned char* ws = fresh_ws();
    const int ng = tid & 31, kgq = tid >> 5;
    const int orow = tid >> 2, oq = tid & 3;
    {
        __syncthreads();
        struct TileRef { ConvJob c; int nbi, kbi; };
        auto decode = [&](int t) -> TileRef {
            int j = 0, rem = t;
#pragma unroll 1
            for (; j < 9; ++j) { const int n = conv_tiles(j); if (rem < n) break; rem -= n; }
            const int per = CJ_NB[j] * CJ_KB[j], mat = rem / per, r2 = rem % per;
            TileRef T; T.c = conv_job(p, ws, j, mat); T.kbi = r2 / T.c.nb; T.nbi = r2 % T.c.nb; return T; };
        auto issue = [&](const TileRef& T, f32x4 (&v)[8], float (&ks)[8]) {
            const int n0 = T.nbi * 128 + ng * 4, k0 = T.kbi * (T.c.f8 ? 128 : 64) + kgq * 4, sc = conv_map(T.c.map, n0);
#pragma unroll
            for (int r = 0; r < 8; ++r) { const int k = k0 + (r >> 2) * 64 + (r & 3);
                if ((r < 4 || T.c.f8) && sc >= 0 && k < T.c.Ksrc) { v[r] = __builtin_nontemporal_load((const f32x4*)(T.c.src + (size_t)k * T.c.Nsrc + sc)); ks[r] = T.c.scale ? T.c.scale[k] : 1.0f; } else { v[r] = (f32x4){0.f, 0.f, 0.f, 0.f}; ks[r] = 0.f; } } };
        auto finish = [&](const TileRef& T, const f32x4 (&v)[8], const float (&ks)[8], int buf) {
            LAS unsigned char* tl = lds + buf * 32768;
            if (T.c.f8) {
#pragma unroll
                for (int h = 0; h < 2; ++h)
#pragma unroll
                    for (int cc = 0; cc < 4; ++cc) *(LAS unsigned*)(tl + (ng * 4 + cc) * 144 + h * 64 + kgq * 4) = pk_fp8x4(v[4 * h][cc] * (ks[4 * h] * W8_SCALE), v[4 * h + 1][cc] * (ks[4 * h + 1] * W8_SCALE), v[4 * h + 2][cc] * (ks[4 * h + 2] * W8_SCALE), v[4 * h + 3][cc] * (ks[4 * h + 3] * W8_SCALE));
                __syncthreads();
                unsigned char* dp = (unsigned char*)T.c.dst + (size_t)(T.nbi * 128 + orow) * T.c.Kdst + T.kbi * 128 + oq * 32;
                *(u32x4*)dp = *(const LAS u32x4*)(tl + orow * 144 + oq * 32); *(u32x4*)(dp + 16) = *(const LAS u32x4*)(tl + orow * 144 + oq * 32 + 16);
            } else {
#pragma unroll
                for (int cc = 0; cc < 4; ++cc) { u32x2 w; w.x = pk_bf16(v[0][cc] * ks[0], v[1][cc] * ks[1]); w.y = pk_bf16(v[2][cc] * ks[2], v[3][cc] * ks[3]); *(LAS u32x2*)(tl + (ng * 4 + cc) * 144 + kgq * 8) = w; }
                __syncthreads();
                bf16_t* dp = T.c.dst + (size_t)(T.nbi * 128 + orow) * T.c.Kdst + T.kbi * 64 + oq * 16;
                *(u32x4*)dp = *(const LAS u32x4*)(tl + orow * 144 + oq * 32); *(u32x4*)(dp + 8) = *(const LAS u32x4*)(tl + orow * 144 + oq * 32 + 16);
            } };
        int t = lo + first;
        if (t < hi) {
            TileRef TA = decode(t), TB = TA; f32x4 va[8], vb[8]; float sa[8], sb[8];
            issue(TA, va, sa);
#pragma unroll 1
            for (;;) {
                int tn = t + stride; bool hn = tn < hi;
                if (hn) { TB = decode(tn); issue(TB, vb, sb); }
                finish(TA, va, sa, 0);
                if (!hn) break;
                t = tn; tn = t + stride; hn = tn < hi;
                if (hn) { TA = decode(tn); issue(TA, va, sa); }
                finish(TB, vb, sb, 1);
                if (!hn) break;
                t = tn;
            }
        }
    }
    __syncthreads();
}

__device__ __forceinline__ void phase_prologue(const Params& p, const int wv, LAS unsigned char* lds) {
    const int tid = opaque_tid(wv);
    unsigned char* ws = p.ws;
    if (blockIdx.x == 0) {
        float* tab = (float*)(ws + OFF_TAB);
        for (int i = tid; i < 1024; i += NTHREADS) { const int pos = i >> 4, f = i & 15; const float inv = 1.0f / powf(10000.0f, (float)(2 * f) / 32.0f); const float ang = (float)pos * inv; tab[i] = cosf(ang); tab[1024 + i] = sinf(ang); }
        for (int i = tid; i < 512; i += NTHREADS) { const int pos = i >> 3, f = i & 7; const float inv = 1.0f / powf(10000.0f, (float)(2 * f) / 16.0f); const float ang = (float)pos * inv; tab[2048 + i] = cosf(ang); tab[2048 + 512 + i] = sinf(ang); }
    }
    {
        LAS float* sv = (LAS float*)lds;
        LAS float* red = (LAS float*)(lds + 36864);
        for (int i = tid; i < 9 * 1024; i += NTHREADS) { const int r = i >> 10, k = i & 1023; const float c = r < 8 ? p.in[1][r * 1024 + k] : p.in[3][k]; sv[i] = c / (1.0f + expf(-c)); }
        __syncthreads();
        for (int u = blockIdx.x; u < 384; u += gridDim.x) {
            const int layer = u / 96, cg = u % 96, cq = tid & 15, kg = tid >> 4;
            f32x4 acc[9];
#pragma unroll
            for (int r = 0; r < 9; ++r) acc[r] = (f32x4){0.f, 0.f, 0.f, 0.f};
            const float* wp = p.in[4] + ((size_t)layer * 1024 + kg * 32) * 6144 + cg * 64 + cq * 4;
#pragma unroll 8
            for (int kk = 0; kk < 32; ++kk) {
                const f32x4 w = __builtin_nontemporal_load((const f32x4*)(wp + (size_t)kk * 6144));
#pragma unroll
                for (int r = 0; r < 9; ++r) acc[r] += w * sv[r * 1024 + kg * 32 + kk];
            }
#pragma unroll
            for (int r = 0; r < 9; ++r) *(LAS f32x4*)(red + (kg * 9 + r) * 64 + cq * 4) = acc[r];
            __syncthreads();
            float* mod = (float*)(ws + OFF_MOD);
            for (int i = tid; i < 9 * 64; i += NTHREADS) { const int r = i >> 6, cc = i & 63; float sacc = 0.f;
#pragma unroll
                for (int g = 0; g < 32; ++g) sacc += red[(g * 9 + r) * 64 + cc];
                mod[((size_t)layer * 9 + r) * 6144 + cg * 64 + cc] = sacc + p.in[5][layer * 6144 + cg * 64 + cc]; }
            __syncthreads();
        }
    }
    conv_units(p, lds, tid, 0, CV_NU_PRO, (int)((blockIdx.x + (gridDim.x >> 1)) % gridDim.x), (int)gridDim.x);
    conv_tiles_run(p, lds, tid, 0, CV_NT_PRO, (int)(gridDim.x - 1 - blockIdx.x), (int)gridDim.x);
}

__device__ __forceinline__ void ld16(const float* p, int lane, float (&v)[16]) {
#pragma unroll
    for (int j = 0; j < 2; ++j) { const f32x4 a = *(const f32x4*)(p + 8 * lane + 512 * j), b = *(const f32x4*)(p + 8 * lane + 512 * j + 4);
        v[8 * j] = a[0]; v[8 * j + 1] = a[1]; v[8 * j + 2] = a[2]; v[8 * j + 3] = a[3]; v[8 * j + 4] = b[0]; v[8 * j + 5] = b[1]; v[8 * j + 6] = b[2]; v[8 * j + 7] = b[3]; }
}
__device__ __forceinline__ void ld16_nt(const float* p, int lane, float (&v)[16]) {
#pragma unroll
    for (int j = 0; j < 2; ++j) { const f32x4 a = __builtin_nontemporal_load((const f32x4*)(p + 8 * lane + 512 * j)), b = __builtin_nontemporal_load((const f32x4*)(p + 8 * lane + 512 * j + 4));
        v[8 * j] = a[0]; v[8 * j + 1] = a[1]; v[8 * j + 2] = a[2]; v[8 * j + 3] = a[3]; v[8 * j + 4] = b[0]; v[8 * j + 5] = b[1]; v[8 * j + 6] = b[2]; v[8 * j + 7] = b[3]; }
}
__device__ __forceinline__ void st16_f32_nt(float* p, int lane, const float (&v)[16]) {
#pragma unroll
    for (int j = 0; j < 2; ++j) { __builtin_nontemporal_store((f32x4){v[8 * j], v[8 * j + 1], v[8 * j + 2], v[8 * j + 3]}, (f32x4*)(p + 8 * lane + 512 * j)); __builtin_nontemporal_store((f32x4){v[8 * j + 4], v[8 * j + 5], v[8 * j + 6], v[8 * j + 7]}, (f32x4*)(p + 8 * lane + 512 * j + 4)); }
}
__device__ __forceinline__ void ld16_bf16(const bf16_t* p, int lane, float (&v)[16]) {
#pragma unroll
    for (int j = 0; j < 2; ++j) { const u32x4 w = *(const u32x4*)(p + 8 * lane + 512 * j);
#pragma unroll
        for (int k = 0; k < 4; ++k) { v[8 * j + 2 * k] = bf_lo(w[k]); v[8 * j + 2 * k + 1] = bf_hi(w[k]); } }
}
__device__ __forceinline__ void st16_f32(float* p, int lane, const float (&v)[16]) {
#pragma unroll
    for (int j = 0; j < 2; ++j) { *(f32x4*)(p + 8 * lane + 512 * j) = (f32x4){v[8 * j], v[8 * j + 1], v[8 * j + 2], v[8 * j + 3]}; *(f32x4*)(p + 8 * lane + 512 * j + 4) = (f32x4){v[8 * j + 4], v[8 * j + 5], v[8 * j + 6], v[8 * j + 7]}; }
}
__device__ __forceinline__ void st16_bf16(bf16_t* p, int lane, const float (&v)[16]) {
#pragma unroll
    for (int j = 0; j < 2; ++j) { u32x4 w; w.x = pk_bf16(v[8 * j], v[8 * j + 1]); w.y = pk_bf16(v[8 * j + 2], v[8 * j + 3]); w.z = pk_bf16(v[8 * j + 4], v[8 * j + 5]); w.w = pk_bf16(v[8 * j + 6], v[8 * j + 7]); *(u32x4*)(p + 8 * lane + 512 * j) = w; }
}
__device__ __forceinline__ float st16_i8_lds(LAS unsigned char* p, int lane, const float (&v)[16]) {
    float mx = 0.f;
#pragma unroll
    for (int k = 0; k < 16; ++k) mx = fmaxf(mx, fabsf(v[k]));
    mx = wave_max(mx); mx = mx > 0.f ? mx : 1.0f;
    const float inv = 127.0f / mx;
#pragma unroll
    for (int j = 0; j < 2; ++j) { u32x2 w; w.x = pk_i8x4(v[8 * j] * inv, v[8 * j + 1] * inv, v[8 * j + 2] * inv, v[8 * j + 3] * inv); w.y = pk_i8x4(v[8 * j + 4] * inv, v[8 * j + 5] * inv, v[8 * j + 6] * inv, v[8 * j + 7] * inv);
        *(LAS u32x2*)(p + 8 * lane + 512 * j) = w; }
    return mx * (1.0f / 127.0f);
}
__device__ __forceinline__ float st16_i8(unsigned char* p, int lane, const float (&v)[16]) {
    float mx = 0.f;
#pragma unroll
    for (int k = 0; k < 16; ++k) mx = fmaxf(mx, fabsf(v[k]));
    mx = wave_max(mx); mx = mx > 0.f ? mx : 1.0f;
    const float inv = 127.0f / mx;
#pragma unroll
    for (int j = 0; j < 2; ++j) { u32x2 w; w.x = pk_i8x4(v[8 * j] * inv, v[8 * j + 1] * inv, v[8 * j + 2] * inv, v[8 * j + 3] * inv); w.y = pk_i8x4(v[8 * j + 4] * inv, v[8 * j + 5] * inv, v[8 * j + 6] * inv, v[8 * j + 7] * inv);
        *(u32x2*)(p + 8 * lane + 512 * j) = w; }
    return mx * (1.0f / 127.0f);
}
__device__ __forceinline__ float sumsq16(const float (&v)[16]) { float s = 0.f;
#pragma unroll
    for (int i = 0; i < 16; ++i) s += v[i] * v[i];
    return wave_sum(s); }
__device__ __forceinline__ const float* modp(const Params& p, int layer, int bidx, int which) { return (const float*)(p.ws + OFF_MOD) + (((size_t)layer * 9 + bidx) * 6 + which) * 1024; }
__device__ __forceinline__ const float* xin_row(const Params& p, int row) { return row < MLAT ? p.in[0] + (size_t)row * DM : p.in[2] + (size_t)(row - MLAT) * DM; }
__device__ __forceinline__ int row_bidx(int row) { return row < MLAT ? (row >> 12) : 8; }

__device__ __forceinline__ void phase_h0(const Params& p, const int wv) {
    const int tid = opaque_tid(wv), lane = tid & 63, wave = tid >> 6;
    bf16_t* abuf = (bf16_t*)(p.ws + OFF_ABUF);
    float gs[16], sh[16];
    int cur = -1;
    const int row0 = blockIdx.x * ROWS_PER_BLOCK + wave;
    constexpr int NI = ROWS_PER_BLOCK / NWAVES;
    float Xb[3][16];
    auto step = [&](int i, float (&x)[16], float (&xn2)[16]) -> bool {
        if (i >= NI) return false;
        const int row = row0 + NWAVES * i, bidx = row_bidx(row);
        if (i + 2 < NI) ld16_nt(xin_row(p, row + 2 * NWAVES), lane, xn2);
        if (bidx != cur) { cur = bidx; float t[16]; ld16(modp(p, 0, bidx, 1), lane, gs); ld16(p.in[6], lane, t);
#pragma unroll
            for (int k = 0; k < 16; ++k) gs[k] = t[k] * (1.0f + gs[k]);
            ld16(modp(p, 0, bidx, 0), lane, sh); }
        const float rstd = rsqrtf(sumsq16(x) * (1.0f / DM) + EPSN);
#pragma unroll
        for (int k = 0; k < 16; ++k) x[k] = x[k] * rstd * gs[k] + sh[k];
        { const float fs = st16_i8((unsigned char*)abuf + (size_t)row * DM, lane, x); if (lane == 0) ((float*)(p.ws + OFF_FSC))[row] = fs; }
        return true;
    };
    ld16_nt(xin_row(p, row0), lane, Xb[0]); ld16_nt(xin_row(p, row0 + NWAVES), lane, Xb[1]);
#pragma unroll 1
    for (int i = 0; i < NI; i += 3) {
        if (!step(i, Xb[0], Xb[2])) break;
        if (!step(i + 1, Xb[1], Xb[0])) break;
        if (!step(i + 2, Xb[2], Xb[1])) break;
    }
}

template <bool ODD>
__device__ __forceinline__ void phase_rowB(const Params& p, const int wv, LAS unsigned char* lds, int layer, const bf16_t* Y, int nrows, bool dummy = false) {
    const int tid = opaque_tid(wv), lane = tid & 63, wave = tid >> 6;
    const bf16_t* xs_in = (const bf16_t*)(p.ws + OFF_XS); bf16_t* xs = (bf16_t*)(p.ws + (dummy ? WS_END : OFF_XS)); bf16_t* abuf = (bf16_t*)(p.ws + (dummy ? WS_END + (size_t)MTOT * DM * 4 : OFF_ABUF));
    const float* ng = p.in[6] + (size_t)layer * 4 * DM;
    float mg1[16], gs2[16], m3[16];
    LAS float* wrt = (LAS float*)lds;
    LAS int* lcnt = (LAS int*)(lds + 32768);
    LAS int* lbase = (LAS int*)(lds + 32768 + 64);
    LAS int* rinfo = (LAS int*)(lds + 32768 + 128);
    LAS float* rwt = (LAS float*)(lds + 32768 + 128 + ROWS_PER_BLOCK * 16);
    LAS unsigned char* stash = lds + 40960;
    if (ODD) {
        const float* wr = p.in[21] + (size_t)(layer >> 1) * DM * NEXP;
        for (int i = tid; i < DM * NEXP; i += NTHREADS) wrt[i] = wr[i];
        if (tid < 8) lcnt[tid] = 0;
        __syncthreads();
    }
    int cur = -1;
    const int row0 = blockIdx.x * ROWS_PER_BLOCK + wave;
    constexpr int NI = ROWS_PER_BLOCK / NWAVES;
    float Yb[3][16], Xb[3][16];
    auto issue = [&](int row, float (&yy)[16], float (&xx)[16]) { ld16_bf16(Y + (size_t)row * DM, lane, yy); if (layer == 0) ld16_nt(xin_row(p, row), lane, xx); else ld16_bf16(xs_in + (size_t)row * DM, lane, xx); };
    auto step = [&](int i, float (&y)[16], float (&x)[16], float (&yn2)[16], float (&xn2)[16]) -> bool {
        const int lrow = wave + NWAVES * i, row = row0 + NWAVES * i, bidx = row_bidx(row);
        if (i >= NI || row >= nrows) return false;
        if (i + 2 < NI && row + 2 * NWAVES < nrows) issue(row + 2 * NWAVES, yn2, xn2);
        if (bidx != cur) { cur = bidx; float t[16]; ld16(modp(p, layer, bidx, 2), lane, mg1); ld16(ng + DM, lane, t);
#pragma unroll
            for (int k = 0; k < 16; ++k) mg1[k] *= t[k];
            ld16(modp(p, layer, bidx, 4), lane, gs2); ld16(ng + 2 * DM, lane, t);
#pragma unroll
            for (int k = 0; k < 16; ++k) gs2[k] = t[k] * (1.0f + gs2[k]);
            ld16(modp(p, layer, bidx, 3), lane, m3); }
        const float rsy = rsqrtf(sumsq16(y) * (1.0f / DM) + EPSN);
#pragma unroll
        for (int k = 0; k < 16; ++k) x[k] = x[k] + mg1[k] * (y[k] * rsy);
        st16_bf16(xs + (size_t)row * DM, lane, x);
        const float rs1 = rsqrtf(sumsq16(x) * (1.0f / DM) + EPSN);
#pragma unroll
        for (int k = 0; k < 16; ++k) y[k] = x[k] * rs1 * gs2[k] + m3[k];
        float fs;
        if (ODD) fs = st16_i8_lds(stash + (size_t)(i < 9 ? wave * 9 + i : wave * 8 + (i - 9)) * 1024, lane, y);
        else { fs = st16_i8((unsigned char*)abuf + (size_t)row * DM, lane, y); if (lane == 0 && !dummy) ((float*)(p.ws + OFF_FSC))[row] = fs; }
        if (ODD) {
            float lg[8];
#pragma unroll
            for (int e = 0; e < 8; ++e) lg[e] = 0.f;
#pragma unroll
            for (int j = 0; j < 4; ++j)
#pragma unroll
                for (int q = 0; q < 4; ++q) { const int col = 8 * lane + 512 * (j >> 1) + 4 * (j & 1) + q; const f32x4 wa = *(const LAS f32x4*)(wrt + col * 8), wb = *(const LAS f32x4*)(wrt + col * 8 + 4); const float f = y[4 * j + q];
                    lg[0] += f * wa[0]; lg[1] += f * wa[1]; lg[2] += f * wa[2]; lg[3] += f * wa[3]; lg[4] += f * wb[0]; lg[5] += f * wb[1]; lg[6] += f * wb[2]; lg[7] += f * wb[3]; }
#pragma unroll
            for (int e = 0; e < 8; ++e) lg[e] = wave_sum(lg[e]);
            int e0 = 0; float l0 = lg[0];
#pragma unroll
            for (int e = 1; e < 8; ++e) if (lg[e] > l0) { l0 = lg[e]; e0 = e; }
            int e1 = e0 == 0 ? 1 : 0; float l1 = -INFINITY;
#pragma unroll
            for (int e = 0; e < 8; ++e) if (e != e0 && lg[e] > l1) { l1 = lg[e]; e1 = e; }
            if (lane == 0) {
                const float w1 = 1.0f / (1.0f + expf(l0 - l1)), w0 = 1.0f - w1;
                const int i0 = __hip_atomic_fetch_add(lcnt + e0, 1, __ATOMIC_RELAXED, __HIP_MEMORY_SCOPE_WORKGROUP);
                const int i1 = __hip_atomic_fetch_add(lcnt + e1, 1, __ATOMIC_RELAXED, __HIP_MEMORY_SCOPE_WORKGROUP);
                rinfo[lrow * 4 + 0] = e0; rinfo[lrow * 4 + 1] = e1; rinfo[lrow * 4 + 2] = i0; rinfo[lrow * 4 + 3] = i1; rwt[lrow * 3] = w0; rwt[lrow * 3 + 1] = w1; rwt[lrow * 3 + 2] = fs;
            }
        }
        return true;
    };
    auto flush = [&](int i_lo, int i_hi) {
        __syncthreads();
        unsigned* cnt = (unsigned*)(p.ws + OFF_CTL) + CW_MOECNT + (layer >> 1) * 64;
        if (tid < 8) lbase[tid] = (int)__hip_atomic_fetch_add(cnt + tid, (unsigned)lcnt[tid], __ATOMIC_RELAXED, __HIP_MEMORY_SCOPE_AGENT);
        __syncthreads();
        int* slot = (int*)(p.ws + OFF_SLOT); float* twt = (float*)(p.ws + OFF_TWT); float* tsc = (float*)(p.ws + OFF_GWT); unsigned char* gbuf = p.ws + OFF_GBUF;
        for (int i = i_lo; i < i_hi; ++i) {
            const int lrow = wave + NWAVES * i, row = row0 + NWAVES * i;
            if (row >= nrows) break;
            const int e0 = rinfo[lrow * 4], e1 = rinfo[lrow * 4 + 1], s0 = lbase[e0] + rinfo[lrow * 4 + 2], s1 = lbase[e1] + rinfo[lrow * 4 + 3];
            const u32x4 v = *(const LAS u32x4*)(stash + (size_t)(i < 9 ? wave * 9 + i : wave * 8 + (i - 9)) * 1024 + lane * 16);
            *(u32x4*)(gbuf + ((size_t)e0 * CAPR + s0) * 1024 + lane * 16) = v;
            *(u32x4*)(gbuf + ((size_t)e1 * CAPR + s1) * 1024 + lane * 16) = v;
            if (lane == 0) { *(int4*)(slot + (size_t)row * 4) = make_int4(e0, s0, e1, s1);
                twt[(size_t)e0 * MTOT + s0] = rwt[lrow * 3]; twt[(size_t)e1 * MTOT + s1] = rwt[lrow * 3 + 1]; tsc[(size_t)e0 * MTOT + s0] = rwt[lrow * 3 + 2]; tsc[(size_t)e1 * MTOT + s1] = rwt[lrow * 3 + 2]; }
        }
        __syncthreads();
        if (tid < 8) lcnt[tid] = 0;
        __syncthreads();
    };
    if (row0 < nrows) issue(row0, Yb[0], Xb[0]);
    if (row0 + NWAVES < nrows) issue(row0 + NWAVES, Yb[1], Xb[1]);
    bool live = true;
#pragma unroll 1
    for (int i = 0; i < 9 && live; i += 3) {
        if (!step(i, Yb[0], Xb[0], Yb[2], Xb[2])) { live = false; break; }
        if (!step(i + 1, Yb[1], Xb[1], Yb[0], Xb[0])) { live = false; break; }
        if (!step(i + 2, Yb[2], Xb[2], Yb[1], Xb[1])) { live = false; break; }
    }
    if (ODD && !dummy) flush(0, 9);
#pragma unroll 1
    for (int i = 9; i < NI && live; i += 3) {
        if (!step(i, Yb[0], Xb[0], Yb[2], Xb[2])) break;
        if (!step(i + 1, Yb[1], Xb[1], Yb[0], Xb[0])) break;
        if (!step(i + 2, Yb[2], Xb[2], Yb[1], Xb[1])) break;
    }
    if (ODD && !dummy) flush(9, NI);
}

struct MoeLayout { int cnt[8], ustart[9], tstart[9]; };
__device__ __forceinline__ MoeLayout moe_layout(const Params& p, int layer) {
    unsigned* cnt = (unsigned*)(p.ws + OFF_CTL) + CW_MOECNT + (layer >> 1) * 64;
    MoeLayout L; int u = 0, t = 0;
#pragma unroll
    for (int e = 0; e < 8; ++e) { const int c = __builtin_amdgcn_readfirstlane((int)__hip_atomic_load(cnt + e, __ATOMIC_RELAXED, __HIP_MEMORY_SCOPE_AGENT)); L.cnt[e] = c; L.ustart[e] = u; L.tstart[e] = t; u += c; t += (c + 255) >> 8; }
    L.ustart[8] = u; L.tstart[8] = t; return L;
}

template <bool MOE>
__device__ __forceinline__ void phase_rowC(const Params& p, const int wv, int layer, const bf16_t* F, bool last, bool dummy = false) {
    const int tid = opaque_tid(wv), lane = tid & 63, wave = tid >> 6;
    const bf16_t* xs_in = (const bf16_t*)(p.ws + OFF_XS); bf16_t* xs = (bf16_t*)(p.ws + (dummy ? WS_END : OFF_XS)); bf16_t* abuf = (bf16_t*)(p.ws + (dummy ? WS_END + (size_t)MTOT * DM * 4 : OFF_ABUF));
    float* outp = dummy ? (float*)xs : p.out;
    const float* ng = p.in[6] + (size_t)layer * 4 * DM;
    float mg3[16], gsn[16], sh[16];
    const int nrows = last ? MLAT : MTOT;
    const bf16_t* eout = (const bf16_t*)(p.ws + OFF_EOUT);
    constexpr int NI = ROWS_PER_BLOCK / NWAVES;
    const int row0 = blockIdx.x * ROWS_PER_BLOCK + wave;
    int my0 = 0, my1 = 0;
    if (MOE) {
        const MoeLayout L = moe_layout(p, layer);
        const int r = row0 + NWAVES * lane;
        if (lane < NI && r < nrows) {
            const int4 si = *(const int4*)((const int*)(p.ws + OFF_SLOT) + (size_t)r * 4);
            int t0 = 0, t1 = 0;
#pragma unroll
            for (int j = 0; j < 8; ++j) { t0 = (j == si.x) ? L.tstart[j] : t0; t1 = (j == si.z) ? L.tstart[j] : t1; }
            my0 = t0 * 256 + si.y; my1 = t1 * 256 + si.w;
        }
    }
    float Fb[3][16], Gb[3][16], Xb[3][16];
    auto issue = [&](int i, int row, float (&ff)[16], float (&gg)[16], float (&xx)[16]) {
        if (MOE) { const int a0 = __builtin_amdgcn_readlane(my0, i), a1 = __builtin_amdgcn_readlane(my1, i); ld16_bf16(eout + (size_t)a0 * DM, lane, ff); ld16_bf16(eout + (size_t)a1 * DM, lane, gg); }
        else ld16_bf16(F + (size_t)row * DM, lane, ff);
        ld16_bf16(xs_in + (size_t)row * DM, lane, xx);
    };
    int cur = -1;
    auto step = [&](int i, float (&f)[16], float (&f1)[16], float (&x)[16], float (&fn2)[16], float (&gn2)[16], float (&xn2)[16]) -> bool {
        const int row = row0 + NWAVES * i, bidx = row_bidx(row);
        if (i >= NI || row >= nrows) return false;
        constexpr int AHEAD = MOE ? 1 : 2;
        if (i + AHEAD < NI && row + AHEAD * NWAVES < nrows) issue(i + AHEAD, row + AHEAD * NWAVES, fn2, gn2, xn2);
        if (MOE) {
#pragma unroll
            for (int k = 0; k < 16; ++k) f[k] += f1[k];
        }
        if (bidx != cur) { cur = bidx; float t[16]; ld16(modp(p, layer, bidx, 5), lane, mg3); ld16(ng + 3 * DM, lane, t);
#pragma unroll
            for (int k = 0; k < 16; ++k) mg3[k] *= t[k];
            if (!last) { ld16(modp(p, layer + 1, bidx, 1), lane, gsn); ld16(ng + 4 * DM, lane, t);
#pragma unroll
                for (int k = 0; k < 16; ++k) gsn[k] = t[k] * (1.0f + gsn[k]);
                ld16(modp(p, layer + 1, bidx, 0), lane, sh); } }
        const float rsf = rsqrtf(sumsq16(f) * (1.0f / DM) + EPSN);
#pragma unroll
        for (int k = 0; k < 16; ++k) x[k] = x[k] + mg3[k] * (f[k] * rsf);
        if (last) st16_f32_nt(outp + (size_t)row * DM, lane, x);
        else {
            st16_bf16(xs + (size_t)row * DM, lane, x);
            const float rs2 = rsqrtf(sumsq16(x) * (1.0f / DM) + EPSN);
#pragma unroll
            for (int k = 0; k < 16; ++k) f[k] = x[k] * rs2 * gsn[k] + sh[k];
            { const float fs = st16_i8((unsigned char*)abuf + (size_t)row * DM, lane, f); if (lane == 0 && !dummy) ((float*)(p.ws + OFF_FSC))[row] = fs; }
        }
        return true;
    };
    if (row0 < nrows) issue(0, row0, Fb[0], Gb[0], Xb[0]);
    if constexpr (MOE) {
#pragma unroll 1
        for (int i = 0; i < NI; i += 2) {
            if (!step(i, Fb[0], Gb[0], Xb[0], Fb[1], Gb[1], Xb[1])) break;
            if (!step(i + 1, Fb[1], Gb[1], Xb[1], Fb[0], Gb[0], Xb[0])) break;
        }
    } else {
        if (row0 + NWAVES < nrows) issue(1, row0 + NWAVES, Fb[1], Gb[1], Xb[1]);
#pragma unroll 1
        for (int i = 0; i < NI; i += 3) {
            if (!step(i, Fb[0], Gb[0], Xb[0], Fb[2], Gb[2], Xb[2])) break;
            if (!step(i + 1, Fb[1], Gb[1], Xb[1], Fb[0], Gb[0], Xb[0])) break;
            if (!step(i + 2, Fb[2], Gb[2], Xb[2], Fb[1], Gb[1], Xb[1])) break;
        }
    }
}

__device__ __forceinline__ void phase_conv(const Params& p, const int wv, int layer) {
    const int tid = opaque_tid(wv), lane = tid & 63, wave = tid >> 6;
    const bf16_t* P = (const bf16_t*)(p.ws + OFF_U + U_P_E); bf16_t* mix = (bf16_t*)(p.ws + OFF_U + U_MIX_E);
    const float* cw = p.in[8] + (size_t)(layer >> 1) * 3 * 512;
    float w0[8], w1[8], w2[8];
#pragma unroll
    for (int k = 0; k < 8; ++k) { w0[k] = cw[8 * lane + k]; w1[k] = cw[512 + 8 * lane + k]; w2[k] = cw[1024 + 8 * lane + k]; }
    const int bA = (int)(blockIdx.x & 7), isA = bA < 2, nit = isA ? 14 : 18;
    const int jb = (int)(blockIdx.x >> 3) * 6 + (bA - 2), oa = jb / 3, orow = (14 + jb % 3) * 2048 + ((oa >> 1) * 8 + (oa & 1)) * 8 + wave;
#pragma unroll 1
    for (int it = 0; it < nit; ++it) {
        const int row = it < 17 ? it * 2048 + (int)blockIdx.x * NWAVES + wave : orow;
        const int pos = row < MLAT ? (row & (SEQ - 1)) : ((row - MLAT) & (CTXL - 1)), len = row < MLAT ? SEQ : CTXL;
        const bf16_t* pr = P + (size_t)row * EVEN_IN + 8 * lane;
        const u32x4 bg = *(const u32x4*)pr;
        float acc[8];
#pragma unroll
        for (int k = 0; k < 8; ++k) acc[k] = 0.f;
#pragma unroll
        for (int d = -1; d <= 1; ++d) {
            if (pos + d < 0 || pos + d >= len) continue;
            const bf16_t* q = pr + (ptrdiff_t)d * EVEN_IN;
            const u32x4 cg = *(const u32x4*)(q + 512), uu = *(const u32x4*)(q + 1024);
            const float* w = d < 0 ? w0 : (d == 0 ? w1 : w2);
#pragma unroll
            for (int k = 0; k < 4; ++k) { acc[2 * k] += w[2 * k] * bf_lo(cg[k]) * bf_lo(uu[k]); acc[2 * k + 1] += w[2 * k + 1] * bf_hi(cg[k]) * bf_hi(uu[k]); }
        }
        u32x4 o;
#pragma unroll
        for (int k = 0; k < 4; ++k) o[k] = pk_bf16(bf_lo(bg[k]) * acc[2 * k], bf_hi(bg[k]) * acc[2 * k + 1]);
        *(u32x4*)(mix + (size_t)row * DM + 8 * lane) = o;
    }
}

__device__ __forceinline__ float max3f(float a, float b, float c) { return __builtin_fmaxf(__builtin_fmaxf(a, b), c); }
__device__ __forceinline__ float xhalf_max(float v) { const auto rr = __builtin_amdgcn_permlane32_swap(__float_as_uint(v), __float_as_uint(v), false, false); return fmaxf(__uint_as_float(rr[0]), __uint_as_float(rr[1])); }
__device__ __forceinline__ float xhalf_sum(float v) { const auto rr = __builtin_amdgcn_permlane32_swap(__float_as_uint(v), __float_as_uint(v), false, false); return __uint_as_float(rr[0]) + __uint_as_float(rr[1]); }
struct NoMask { __device__ __forceinline__ void operator()(f32x16&, f32x16&) const {} };
struct BandMask {
    int kp0, qp, hi;
    __device__ __forceinline__ void operator()(f32x16& s0, f32x16& s1) const {
#pragma unroll
        for (int r = 0; r < 16; ++r) { const int d0 = kp0 + crow(r, hi) - qp, d1 = d0 + 32; if (d0 > 128 || d0 < -128) s0[r] = -INFINITY; if (d1 > 128 || d1 < -128) s1[r] = -INFINITY; }
    }
};
#define ABAR() asm volatile("s_waitcnt lgkmcnt(0)\n\ts_barrier" ::: "memory")
template <int KP, int NKS>
__device__ __forceinline__ void attn_X(const LAS unsigned char* Kt, const bf16x8 (&qf)[NKS], const f32x16& negm, f32x16& s0, f32x16& s1, int lane) {
    const int r32 = lane & 31, hi = lane >> 5;
    const LAS unsigned char* kp = Kt + r32 * KP + hi * 16;
#pragma unroll
    for (int s = 0; s < NKS; ++s) {
        const bf16x8 k0 = *(const LAS bf16x8*)(kp + s * 32), k1 = *(const LAS bf16x8*)(kp + 32 * KP + s * 32);
        s0 = __builtin_amdgcn_mfma_f32_32x32x16_bf16(k0, qf[s], s == 0 ? negm : s0, 0, 0, 0);
        s1 = __builtin_amdgcn_mfma_f32_32x32x16_bf16(k1, qf[s], s == 0 ? negm : s1, 0, 0, 0);
    }
}
template <int NDB, class Mask>
__device__ __forceinline__ void attn_Y(f32x16& s0, f32x16& s1, u32x4 (&pw)[4], f32x16 (&o)[NDB], f32x16& negm, float& m, float& l, bool first, const Mask& mask) {
    constexpr float THR = 8.0f;
    mask(s0, s1);
    float a = max3f(s0[0], s0[1], s1[0]), b = max3f(s0[2], s0[3], s1[1]); a = max3f(a, s1[2], s1[3]);
#pragma unroll
    for (int r = 4; r < 16; r += 4) { a = max3f(a, s0[r], s0[r + 1]); b = max3f(b, s0[r + 2], s0[r + 3]); a = max3f(a, s1[r], s1[r + 1]); b = max3f(b, s1[r + 2], s1[r + 3]); }
    const float rm = xhalf_max(fmaxf(a, b));
    if (first || __any(rm > THR)) {
        const float dl = first ? fmaxf(rm, -64.0f) : fmaxf(rm, 0.f), f = fast_exp2(-dl);
        m += dl; l *= f;
#pragma unroll
        for (int r = 0; r < 16; ++r) { s0[r] -= dl; s1[r] -= dl; float nm_ = -m; asm volatile("" : "+v"(nm_)); negm[r] = nm_; }
        asm volatile("s_nop 7" ::: "memory");
#pragma unroll
        for (int d = 0; d < NDB; ++d)
#pragma unroll
            for (int r = 0; r < 16; ++r) o[d][r] *= f;
    }
    float ps = 0.f;
#pragma unroll
    for (int r = 0; r < 16; ++r) { s0[r] = fast_exp2(s0[r]); s1[r] = fast_exp2(s1[r]); ps += s0[r] + s1[r]; }
    l += ps;
#pragma unroll
    for (int ks = 0; ks < 2; ++ks) {
        pw[ks] = (u32x4){pk_bf16(s0[8 * ks], s0[8 * ks + 1]), pk_bf16(s0[8 * ks + 2], s0[8 * ks + 3]), pk_bf16(s0[8 * ks + 4], s0[8 * ks + 5]), pk_bf16(s0[8 * ks + 6], s0[8 * ks + 7])};
        pw[2 + ks] = (u32x4){pk_bf16(s1[8 * ks], s1[8 * ks + 1]), pk_bf16(s1[8 * ks + 2], s1[8 * ks + 3]), pk_bf16(s1[8 * ks + 4], s1[8 * ks + 5]), pk_bf16(s1[8 * ks + 6], s1[8 * ks + 7])};
    }
}
template <int VP, int NDB>
__device__ __forceinline__ void attn_Z(const LAS unsigned char* Vt, const u32x4 (&pw)[4], f32x16 (&o)[NDB], int lane) {
    const int hi = lane >> 5;
    const LAS unsigned char* vp = Vt + (4 * hi + ((lane & 15) >> 2)) * VP + ((lane >> 4) & 1) * 32 + (lane & 3) * 8;
    if constexpr (NDB <= 4) {
        s16x4 lo[NDB], hh[NDB], lon[NDB], hhn[NDB];
#pragma unroll
        for (int d = 0; d < NDB; ++d) { lo[d] = __builtin_bit_cast(s16x4, __builtin_amdgcn_ds_read_tr16_b64_v4i16((LAS s16x4*)(vp + d * 64))); hh[d] = __builtin_bit_cast(s16x4, __builtin_amdgcn_ds_read_tr16_b64_v4i16((LAS s16x4*)(vp + d * 64 + 8 * VP))); }
#pragma unroll
        for (int st = 0; st < 4; ++st) {
            __builtin_amdgcn_sched_barrier(0);
            if (st < 3) {
#pragma unroll
                for (int d = 0; d < NDB; ++d) { const LAS unsigned char* a = vp + (16 * (st + 1)) * VP + d * 64;
                    lon[d] = __builtin_bit_cast(s16x4, __builtin_amdgcn_ds_read_tr16_b64_v4i16((LAS s16x4*)a)); hhn[d] = __builtin_bit_cast(s16x4, __builtin_amdgcn_ds_read_tr16_b64_v4i16((LAS s16x4*)(a + 8 * VP))); }
            }
            const bf16x8 pf = __builtin_bit_cast(bf16x8, pw[st]);
#pragma unroll
            for (int d = 0; d < NDB; ++d) { const bf16x8 vf = {lo[d][0], lo[d][1], lo[d][2], lo[d][3], hh[d][0], hh[d][1], hh[d][2], hh[d][3]}; o[d] = __builtin_amdgcn_mfma_f32_32x32x16_bf16(vf, pf, o[d], 0, 0, 0); }
#pragma unroll
            for (int d = 0; d < NDB; ++d) { lo[d] = lon[d]; hh[d] = hhn[d]; }
        }
    } else {
#pragma unroll
        for (int st = 0; st < 4; ++st) {
            __builtin_amdgcn_sched_barrier(0);
            const bf16x8 pf = __builtin_bit_cast(bf16x8, pw[st]);
#pragma unroll
            for (int d = 0; d < NDB; ++d) { const LAS unsigned char* a = vp + (16 * st) * VP + d * 64;
                const s16x4 lo = __builtin_bit_cast(s16x4, __builtin_amdgcn_ds_read_tr16_b64_v4i16((LAS s16x4*)a)), hh = __builtin_bit_cast(s16x4, __builtin_amdgcn_ds_read_tr16_b64_v4i16((LAS s16x4*)(a + 8 * VP)));
                const bf16x8 vf = {lo[0], lo[1], lo[2], lo[3], hh[0], hh[1], hh[2], hh[3]}; o[d] = __builtin_amdgcn_mfma_f32_32x32x16_bf16(vf, pf, o[d], 0, 0, 0); }
        }
    }
}
template <int KP, int VP, int NKS, int NDB, class GLK, class GLV, class STK, class STV, class MaskF>
__device__ __forceinline__ void attn_run1(LAS unsigned char* lds, int KB, int SB, int kcoff, const bf16x8 (&qf)[NKS], f32x16 (&o)[NDB], float& m, float& l, int NT, int lane,
                                          GLK glk, GLV glv, STK stk, STV stv, MaskF maskf) {
    f32x16 s0, s1, negm; u32x4 pw[4];
    m = 0.f;
#pragma unroll
    for (int r = 0; r < 16; ++r) negm[r] = 0.f;
    glk(0); glv(0); stk(0); stv(0); ABAR();
#pragma unroll 1
    for (int t = 0; t < NT; ++t) {
        if (t + 1 < NT) { glk(t + 1); glv(t + 1); }
        const LAS unsigned char* Kt = lds + (t & 1) * SB;
        attn_X<KP, NKS>(Kt + kcoff, qf, negm, s0, s1, lane);
        __builtin_amdgcn_sched_barrier(0);
        attn_Y<NDB>(s0, s1, pw, o, negm, m, l, t == 0, [&](f32x16& x0, f32x16& x1) { maskf(t, x0, x1); });
        __builtin_amdgcn_sched_barrier(0);
        attn_Z<VP, NDB>(Kt + KB, pw, o, lane);
        if (t + 1 < NT) { stk((t + 1) & 1); stv((t + 1) & 1); }
        ABAR();
    }
}

template <int NDB, class Mask>
__device__ __forceinline__ void attn_Y1(f32x16& s0, f32x16& s1, f32x16 (&o)[NDB], f32x16& negm, float& m, float& l, bool first, const Mask& mask) {
    constexpr float THR = 8.0f;
    mask(s0, s1);
    float a = max3f(s0[0], s0[1], s1[0]), b = max3f(s0[2], s0[3], s1[1]); a = max3f(a, s1[2], s1[3]);
#pragma unroll
    for (int r = 4; r < 16; r += 4) { a = max3f(a, s0[r], s0[r + 1]); b = max3f(b, s0[r + 2], s0[r + 3]); a = max3f(a, s1[r], s1[r + 1]); b = max3f(b, s1[r + 2], s1[r + 3]); }
    const float rm = xhalf_max(fmaxf(a, b));
    if (first || __any(rm > THR)) {
        const float dl = first ? fmaxf(rm, -64.0f) : fmaxf(rm, 0.f), f = fast_exp2(-dl);
        m += dl; l *= f;
#pragma unroll
        for (int r = 0; r < 16; ++r) { s0[r] -= dl; s1[r] -= dl; float nm_ = -m; asm volatile("" : "+v"(nm_)); negm[r] = nm_; }
        asm volatile("s_nop 7" ::: "memory");
#pragma unroll
        for (int d = 0; d < NDB; ++d)
#pragma unroll
            for (int r = 0; r < 16; ++r) o[d][r] *= f;
    }
}
__device__ __forceinline__ void attn_Y2(f32x16& s0, f32x16& s1, u32x4 (&pw)[4], float& l) {
    float ps = 0.f;
#pragma unroll
    for (int r = 0; r < 16; ++r) { s0[r] = fast_exp2(s0[r]); s1[r] = fast_exp2(s1[r]); ps += s0[r] + s1[r]; }
    l += ps;
#pragma unroll
    for (int ks = 0; ks < 2; ++ks) {
        pw[ks] = (u32x4){pk_bf16(s0[8 * ks], s0[8 * ks + 1]), pk_bf16(s0[8 * ks + 2], s0[8 * ks + 3]), pk_bf16(s0[8 * ks + 4], s0[8 * ks + 5]), pk_bf16(s0[8 * ks + 6], s0[8 * ks + 7])};
        pw[2 + ks] = (u32x4){pk_bf16(s1[8 * ks], s1[8 * ks + 1]), pk_bf16(s1[8 * ks + 2], s1[8 * ks + 3]), pk_bf16(s1[8 * ks + 4], s1[8 * ks + 5]), pk_bf16(s1[8 * ks + 6], s1[8 * ks + 7])};
    }
}
template <int KP, int VP, int NKS, int NDB, int VPM  , class GLK, class GLV, class STK, class STV, class MaskF>
__device__ __forceinline__ void attn_run2(LAS unsigned char* lds, int KB, int SB, int kcoff, const bf16x8 (&qf)[NKS], f32x16 (&o)[NDB], float& m, float& l, int NT, int lane,
                                          GLK glk, GLV glv, STK stk, STV stv, MaskF maskf) {
    f32x16 sa0, sa1, sb0, sb1, negm; u32x4 pw[4];
    m = 0.f;
#pragma unroll
    for (int r = 0; r < 16; ++r) negm[r] = 0.f;
    glk(0); stk(0); glv(0); stv(0);
    if (NT > 1) { glk(1); stk(1); }
    ABAR();
    attn_X<KP, NKS>(lds + kcoff, qf, negm, sa0, sa1, lane);
    auto step = [&](int t, f32x16& c0, f32x16& c1, f32x16& n0, f32x16& n1) {
        if (t + 2 < NT) glk(t + 2);
        if (t + 1 < NT) glv(t + 1);
        attn_Y1<NDB>(c0, c1, o, negm, m, l, t == 0, [&](f32x16& x0, f32x16& x1) { maskf(t, x0, x1); });
        if (t + 1 < NT) attn_X<KP, NKS>(lds + ((t + 1) & 1) * SB + kcoff, qf, negm, n0, n1, lane);
        attn_Y2(c0, c1, pw, l);
        __builtin_amdgcn_sched_group_barrier(0x100, 4, 0);
#pragma unroll
        for (int i = 0; i < 2 * NKS; ++i) { __builtin_amdgcn_sched_group_barrier(0x008, 1, 0); if (i < 2 * NKS - 4) __builtin_amdgcn_sched_group_barrier(0x100, 1, 0); __builtin_amdgcn_sched_group_barrier(0x002, VPM, 0); }
        __builtin_amdgcn_sched_barrier(0);
        attn_Z<VP, NDB>(lds + (t & 1) * SB + KB, pw, o, lane);
        if (t + 2 < NT) stk(t & 1);
        if (t + 1 < NT) stv((t + 1) & 1);
        ABAR();
    };
#pragma unroll 1
    for (int t = 0; t < NT; t += 2) {
        step(t, sa0, sa1, sb0, sb1);
        if (t + 1 < NT) step(t + 1, sb0, sb1, sa0, sa1);
    }
}

__device__ __forceinline__ void store_row_pairs(bf16_t* p32, const u32x2 (&w)[4], int hi) {
#pragma unroll
    for (int k = 0; k < 4; k += 2) {
        u32x2 a = w[k], b = w[k + 1];
        { const auto r = __builtin_amdgcn_permlane32_swap(a.x, b.x, false, false); a.x = r[0]; b.x = r[1]; }
        { const auto r = __builtin_amdgcn_permlane32_swap(a.y, b.y, false, false); a.y = r[0]; b.y = r[1]; }
        *(u32x4*)(p32 + 8 * k + 8 * hi) = (u32x4){a.x, a.y, b.x, b.y};
    }
}
__device__ __forceinline__ bf16x8 load_q(const bf16_t* p, float qs) {
    const u32x4 w = *(const u32x4*)p; u32x4 o;
#pragma unroll
    for (int k = 0; k < 4; ++k) o[k] = pk_bf16(bf_lo(w[k]) * qs, bf_hi(w[k]) * qs);
    return __builtin_bit_cast(bf16x8, o);
}
__device__ __forceinline__ int attn_vcu() { return (int)((blockIdx.x & 7) * (gridDim.x >> 3) + (blockIdx.x >> 3)); }

__device__ __forceinline__ void swa_unit(const Params& p, const int wv, LAS unsigned char* lds, int layer, int b, int g, int q0, bool ctxq) {
    constexpr int KP = 144, VP = 192, KB = 64 * KP, SB = KB + 64 * VP;
    const int tid = opaque_tid(wv), lane = tid & 63, wave = __builtin_amdgcn_readfirstlane(tid >> 6), r32 = lane & 31, hi = lane >> 5;
    const bf16_t* P = (const bf16_t*)(p.ws + OFF_U + U_P_E); bf16_t* mix = (bf16_t*)(p.ws + OFF_U + U_MIX_E);
    const int hd = 4 * g + (wave >> 1);
    const int qrow = (ctxq ? MLAT + b * CTXL : b * SEQ) + q0 + 32 * (wave & 1) + r32;
    const float qs = 0.125f * LOG2E;
    bf16x8 qf[4];
#pragma unroll
    for (int s = 0; s < 4; ++s) qf[s] = load_q(P + (size_t)qrow * EVEN_IN + 1536 + hd * 64 + 16 * s + 8 * hi, qs);
    f32x16 o[2];
#pragma unroll
    for (int d = 0; d < 2; ++d)
#pragma unroll
        for (int r = 0; r < 16; ++r) o[d][r] = 0.f;
    float m = -1e30f, l = 0.f;
    int ilo = 0, nlat = 0;
    if (!ctxq) { ilo = q0 >= 128 ? 0 : (128 - q0) / 64; int ihi = (SEQ + 64 - q0) / 64; ihi = ihi > 4 ? 4 : ihi; nlat = ihi - ilo + 1; }
    const int NT = nlat + 4;
    const int ki = tid >> 3, kc = tid & 7;
    u32x4 rk, rv;
    auto krow = [&](int t) { return t < nlat ? b * SEQ + q0 - 128 + 64 * (ilo + t) + ki : MLAT + b * CTXL + 64 * (t - nlat) + ki; };
    auto glk = [&](int t) { rk = *(const u32x4*)(P + (size_t)krow(t) * EVEN_IN + 2048 + g * 64 + kc * 8); };
    auto glv = [&](int t) { rv = *(const u32x4*)(P + (size_t)krow(t) * EVEN_IN + 2176 + g * 64 + kc * 8); };
    auto stk = [&](int buf) { *(LAS u32x4*)(lds + buf * SB + ki * KP + kc * 16) = rk; };
    auto stv = [&](int buf) { *(LAS u32x4*)(lds + buf * SB + KB + ki * VP + kc * 16) = rv; };
    const int qp = q0 + 32 * (wave & 1) + r32;
    attn_run1<KP, VP, 4, 2>(lds, KB, SB, 0, qf, o, m, l, NT, lane, glk, glv, stk, stv,
        [&](int t, f32x16& x0, f32x16& x1) { if (t < nlat) { BandMask bm; bm.kp0 = q0 - 128 + 64 * (ilo + t); bm.qp = qp; bm.hi = hi; bm(x0, x1); } });
    l = xhalf_sum(l);
    l += fast_exp2(p.in[9][(layer >> 1) * 8 + hd] * LOG2E - m);
    const float inv = 1.0f / l;
    bf16_t* orow = mix + (size_t)qrow * DM + 512 + hd * 64;
#pragma unroll
    for (int d = 0; d < 2; ++d) { u32x2 w[4];
#pragma unroll
        for (int gq = 0; gq < 4; ++gq) { w[gq].x = pk_bf16(o[d][4 * gq] * inv, o[d][4 * gq + 1] * inv); w[gq].y = pk_bf16(o[d][4 * gq + 2] * inv, o[d][4 * gq + 3] * inv); }
        store_row_pairs(orow + 32 * d, w, hi); }
}
__device__ __forceinline__ void phase_swa(const Params& p, const int wv, LAS unsigned char* lds, int layer) {
    const int v = attn_vcu();
    for (int u = v; u < 1024 + 64; u += gridDim.x) {
        if (u < 1024) swa_unit(p, wv, lds, layer, u >> 7, (u >> 6) & 1, (u & 63) * 64, false);
        else { const int c = u - 1024; swa_unit(p, wv, lds, layer, c >> 3, (c >> 2) & 1, (c & 3) * 64, true); }
    }
}

__device__ __forceinline__ void mla_unit(const Params& p, const int wv, LAS unsigned char* lds, int b, int h, int qrow0, int nl) {
    constexpr int KP = 208, VP = 192, KB = 64 * KP, SB = KB + 64 * VP;
    const int tid = opaque_tid(wv), lane = tid & 63, wave = __builtin_amdgcn_readfirstlane(tid >> 6), r32 = lane & 31, hi = lane >> 5;
    const bf16_t* P = (const bf16_t*)(p.ws + OFF_U + U_P_O); const bf16_t* QF = (const bf16_t*)(p.ws + OFF_U + U_QF_O); const bf16_t* KVF = (const bf16_t*)(p.ws + OFF_U + U_KVF_O);
    bf16_t* mix = (bf16_t*)(p.ws + OFF_U + U_MIX_O);
    const int qrow = qrow0 + 32 * wave + r32;
    const float qs = 0.10206207261596575f * LOG2E;
    bf16x8 qf[6];
#pragma unroll
    for (int s = 0; s < 4; ++s) qf[s] = load_q(QF + (size_t)qrow * 768 + h * 96 + 16 * s + 8 * hi, qs);
    {
        const u32x4 a = *(const u32x4*)(QF + (size_t)qrow * 768 + h * 96 + 64 + 8 * hi), bq = *(const u32x4*)(QF + (size_t)qrow * 768 + h * 96 + 80 + 8 * hi);
        float x1[8], x2[8];
#pragma unroll
        for (int k = 0; k < 4; ++k) { x1[2 * k] = bf_lo(a[k]); x1[2 * k + 1] = bf_hi(a[k]); x2[2 * k] = bf_lo(bq[k]); x2[2 * k + 1] = bf_hi(bq[k]); }
        if (nl > 0) {
            const float* tab = (const float*)(p.ws + OFF_TAB) + 2048; const int sp = qrow & (SEQ - 1), pos = hi ? (sp & 63) : (sp >> 6);
#pragma unroll
            for (int k = 0; k < 8; ++k) { const float cs = tab[pos * 8 + k], sn = tab[512 + pos * 8 + k]; const float o1 = x1[k] * cs - x2[k] * sn, o2 = x2[k] * cs + x1[k] * sn; x1[k] = o1; x2[k] = o2; }
        }
        u32x4 w1, w2;
#pragma unroll
        for (int k = 0; k < 4; ++k) { w1[k] = pk_bf16(x1[2 * k] * qs, x1[2 * k + 1] * qs); w2[k] = pk_bf16(x2[2 * k] * qs, x2[2 * k + 1] * qs); }
        qf[4] = __builtin_bit_cast(bf16x8, w1); qf[5] = __builtin_bit_cast(bf16x8, w2);
    }
    f32x16 o[2];
#pragma unroll
    for (int d = 0; d < 2; ++d)
#pragma unroll
        for (int r = 0; r < 16; ++r) o[d][r] = 0.f;
    float m = -1e30f, l = 0.f;
    const int NT = nl + 4;
    const int ki = tid >> 3, kc = tid & 7, ki2 = (tid >> 2) & 63, kc2 = tid & 3;
    u32x4 rk, rv, rp;
    auto krow = [&](int t, int i) { return t < nl ? b * SEQ + 64 * t + i : MLAT + b * CTXL + 64 * (t - nl) + i; };
    auto glk = [&](int t) { rk = *(const u32x4*)(KVF + (size_t)krow(t, ki) * 1024 + h * 128 + kc * 8); if (tid < 256) rp = *(const u32x4*)(P + (size_t)krow(t, ki2) * ODD_INP + 384 + kc2 * 8); };
    auto glv = [&](int t) { rv = *(const u32x4*)(KVF + (size_t)krow(t, ki) * 1024 + h * 128 + 64 + kc * 8); };
    auto stk = [&](int buf) { *(LAS u32x4*)(lds + buf * SB + ki * KP + kc * 16) = rk; if (tid < 256) *(LAS u32x4*)(lds + buf * SB + ki2 * KP + 128 + kc2 * 16) = rp; };
    auto stv = [&](int buf) { *(LAS u32x4*)(lds + buf * SB + KB + ki * VP + kc * 16) = rv; };
    attn_run2<KP, VP, 6, 2, 7>(lds, KB, SB, 0, qf, o, m, l, NT, lane, glk, glv, stk, stv, [](int, f32x16&, f32x16&) {});
    l = xhalf_sum(l);
    const float inv = 1.0f / l;
    bf16_t* orow = mix + (size_t)qrow * DM + h * 64;
#pragma unroll
    for (int d = 0; d < 2; ++d) { u32x2 w[4];
#pragma unroll
        for (int gq = 0; gq < 4; ++gq) { w[gq].x = pk_bf16(o[d][4 * gq] * inv, o[d][4 * gq + 1] * inv); w[gq].y = pk_bf16(o[d][4 * gq + 2] * inv, o[d][4 * gq + 3] * inv); }
        store_row_pairs(orow + 32 * d, w, hi); }
}

__device__ __forceinline__ void diff_unit(const Params& p, const int wv, LAS unsigned char* lds, int layer, int b, int h, int qrow0, int nl, float lam, float lam_init) {
    constexpr int KP = 272, VP = 320, KB = 64 * KP, SB = KB + 64 * VP, XP = 528;
    const int tid = opaque_tid(wv), lane = tid & 63, wave = __builtin_amdgcn_readfirstlane(tid >> 6), r32 = lane & 31, hi = lane >> 5;
    const bf16_t* P = (const bf16_t*)(p.ws + OFF_U + U_P_O); bf16_t* mix = (bf16_t*)(p.ws + OFF_U + U_MIX_O);
    const int comp = wave >> 2, qrow = qrow0 + 32 * (wave & 3) + r32;
    const float qs = 0.125f * LOG2E;
    bf16x8 qf[4];
#pragma unroll
    for (int s = 0; s < 4; ++s) qf[s] = load_q(P + (size_t)qrow * ODD_INP + 512 + h * 128 + comp * 64 + 16 * s + 8 * hi, qs);
    f32x16 o[4];
#pragma unroll
    for (int d = 0; d < 4; ++d)
#pragma unroll
        for (int r = 0; r < 16; ++r) o[d][r] = 0.f;
    float m = -1e30f, l = 0.f;
    const int NT = nl + 4;
    const int ki = tid >> 3, kc = tid & 7;
    u32x4 rk0, rk1, rv0, rv1;
    auto krow = [&](int t) { return t < nl ? b * SEQ + 64 * t + ki : MLAT + b * CTXL + 64 * (t - nl) + ki; };
    auto glk = [&](int t) { const bf16_t* pr = P + (size_t)krow(t) * ODD_INP + 1024 + h * 128 + kc * 8; rk0 = *(const u32x4*)pr; rk1 = *(const u32x4*)(pr + 64); };
    auto glv = [&](int t) { const bf16_t* pr = P + (size_t)krow(t) * ODD_INP + 1536 + h * 128 + kc * 8; rv0 = *(const u32x4*)pr; rv1 = *(const u32x4*)(pr + 64); };
    auto stk = [&](int buf) { LAS unsigned char* kb = lds + buf * SB + ki * KP + kc * 16; *(LAS u32x4*)kb = rk0; *(LAS u32x4*)(kb + 128) = rk1; };
    auto stv = [&](int buf) { LAS unsigned char* vb = lds + buf * SB + KB + ki * VP + kc * 16; *(LAS u32x4*)vb = rv0; *(LAS u32x4*)(vb + 128) = rv1; };
    attn_run2<KP, VP, 4, 4, 10>(lds, KB, SB, comp * 128, qf, o, m, l, NT, lane, glk, glv, stk, stv, [](int, f32x16&, f32x16&) {});
    l = xhalf_sum(l);
    const float inv = 1.0f / l;
    LAS unsigned char* xrow = lds + (32 * (wave & 3) + r32) * XP;
    if (comp == 1) {
#pragma unroll
        for (int d = 0; d < 4; ++d)
#pragma unroll
            for (int gq = 0; gq < 4; ++gq) *(LAS f32x4*)(xrow + (32 * d + 8 * gq + 4 * hi) * 4) = (f32x4){o[d][4 * gq] * inv, o[d][4 * gq + 1] * inv, o[d][4 * gq + 2] * inv, o[d][4 * gq + 3] * inv};
    }
    __syncthreads();
    if (comp == 0) {
        float ss = 0.f;
#pragma unroll
        for (int d = 0; d < 4; ++d)
#pragma unroll
            for (int gq = 0; gq < 4; ++gq) { const f32x4 o2 = *(const LAS f32x4*)(xrow + (32 * d + 8 * gq + 4 * hi) * 4);
#pragma unroll
                for (int k = 0; k < 4; ++k) { const float v = o[d][4 * gq + k] * inv - lam * o2[k]; o[d][4 * gq + k] = v; ss += v * v; } }
        ss = xhalf_sum(ss);
        const float omli = __uint_as_float(__builtin_amdgcn_readfirstlane(__float_as_uint(layer == 1 ? 1.0f - 0.35550906f : 1.0f - 0.55605820f)));
        const float rs = rsqrtf(ss * (1.0f / 128.0f) + EPSN) * omli;
        const float* sg = p.in[17] + (size_t)(layer >> 1) * 128;
        bf16_t* orow = mix + (size_t)qrow * DM + 512 + h * 128;
#pragma unroll
        for (int d = 0; d < 4; ++d) { u32x2 w[4];
#pragma unroll
            for (int gq = 0; gq < 4; ++gq) { const int c = 32 * d + 8 * gq + 4 * hi; const f32x4 gg = *(const f32x4*)(sg + c);
                w[gq].x = pk_bf16(o[d][4 * gq] * rs * gg[0], o[d][4 * gq + 1] * rs * gg[1]); w[gq].y = pk_bf16(o[d][4 * gq + 2] * rs * gg[2], o[d][4 * gq + 3] * rs * gg[3]); }
            store_row_pairs(orow + 32 * d, w, hi); }
    }
    __syncthreads();
}
__device__ __forceinline__ void phase_attn_odd(const Params& p, const int wv, LAS unsigned char* lds, int layer) {
    const int v = attn_vcu();
    const bool need_ctx = layer < 3;
    const float* lp = p.in[16] + (size_t)(layer >> 1) * 256; const int ln = opaque_tid(wv) & 63;
    const float lam_init = layer == 1 ? 0.35550906f : 0.55605820f;
    const float lam = __uint_as_float(__builtin_amdgcn_readfirstlane(__float_as_uint(expf(wave_sum(lp[ln] * lp[64 + ln])) - expf(wave_sum(lp[128 + ln] * lp[192 + ln])) + lam_init)));
    const int n_mla = 1024 + (need_ctx ? 64 : 0);
#ifndef NO_MLA
    for (int u = v; u < n_mla; u += gridDim.x) {
        if (u < 1024) { const int bh = u >> 4, qb = u & 15; mla_unit(p, wv, lds, bh >> 3, bh & 7, (bh >> 3) * SEQ + qb * 256, 64); }
        else { const int c = u - 1024; mla_unit(p, wv, lds, c >> 3, c & 7, MLAT + (c >> 3) * CTXL, 0); }
    }
#endif
#ifndef NO_DIFF
    for (int u = v; u < n_mla + 64; u += gridDim.x) {
        if (u < 1024) { const int bh = u >> 5, qb = u & 31; diff_unit(p, wv, lds, layer, bh >> 2, bh & 3, (bh >> 2) * SEQ + qb * 128, 64, lam, lam_init); }
        else if (u >= 1024 + 64) { const int c = u - 1024 - 64, bh = c >> 1; diff_unit(p, wv, lds, layer, bh >> 2, bh & 3, MLAT + (bh >> 2) * CTXL + (c & 1) * 128, 0, lam, lam_init); }
    }
#endif
}

__device__ __forceinline__ bool tail_share(int nwg, int G, int c, int& rank, int& nidle) {
    const int rmax = (nwg + G - 1) / G; int busy = nwg - (rmax - 1) * G; busy = busy >= G ? 0 : busy;
    rank = c - busy; nidle = G - busy; return c >= busy;
}

constexpr int NPH_PAIR = 16, NPHASES = 2 + 2 * NPH_PAIR;
__global__ void __launch_bounds__(NTHREADS, 2) fwd(Params p, int lo, int hi) {
    extern __shared__ __attribute__((aligned(16))) unsigned char smem_raw[];
    LAS unsigned char* lds = (LAS unsigned char*)smem_raw;
    volatile LAS unsigned* xbw = (volatile LAS unsigned*)(lds + LDS_BYTES - 16);
    unsigned char* ws = p.ws;
    const int wv = __builtin_amdgcn_readfirstlane((int)(threadIdx.x >> 6));
    XcdBarrier bar; bar.bar = (unsigned*)(ws + OFF_CTL); bar.x = 0; bar.st = xbw; bar.wv = wv;
    if (hi - lo > 1) {
        if (wv == 0 && lane_id() == 0) { xbw[0] = 0u; xbw[1] = 0u; xbw[2] = 0u; xbw[3] = 0u; }
        __syncthreads();
        bar = xcd_barrier_post((unsigned*)(ws + OFF_CTL), xbw, wv);
    }
    const int G = gridDim.x, c = blockIdx.x;
    constexpr int NM = MTOT / 256;
#ifndef PH_MASK
#define PH_MASK 0xFFFFFFFFu
#endif
#define PHASE(id) if (lo <= (id) && (id) < hi)
#ifndef DUP_MASK
#define DUP_MASK 0u
#endif
#define DUPK(k) _Pragma("unroll 1") for (int dup_ = 0; dup_ < ((((DUP_MASK) >> (k)) & 1u) ? 2 : 1); ++dup_)
#define DUP_DUMMY(k) (((((DUP_MASK) >> (k)) & 1u) != 0u) && dup_ == 0)
#define PMARK(k) asm volatile("; PHASE_MARK " #k ::: "memory")
#define PHM(k) if constexpr ((PH_MASK >> (k)) & 1u)
#define SEAM(id) do { if ((id) > lo) xcd_barrier(bar); } while (0)
    PHM(0) PHASE(0) DUPK(0) { PMARK(0); phase_prologue(p, wv, lds); }
    PHM(1) PHASE(1) DUPK(1) { PMARK(1); SEAM(1); phase_h0(p, wv); }
    for (int pr = 0; pr < 2; ++pr) {
        Params pq = p; pq.ws = fresh_ws();
        unsigned char* ws = pq.ws;
        const int le = 2 * pr, lod = 2 * pr + 1, pb = 2 + pr * NPH_PAIR;
        const bf16_t* abuf = (const bf16_t*)(ws + OFF_ABUF);
        PHM(2) PHASE(pb + 0) DUPK(2) { PMARK(2); SEAM(pb + 0);
            pg8::Gemm g{abuf, ws + OFF_WINE + pr * SZ_WINE, 1024, 1024}; pg8::StaticOrder S; S.init(NM, EVEN_IN / 256, G, c);
            pg8::EpiRope<0> E{(bf16_t*)(ws + OFF_U + U_P_E), EVEN_IN, (const float*)(ws + OFF_TAB), (const float*)(ws + OFF_FSC), (const float*)(ws + OFF_WSCI) + (size_t)pr * EVEN_IN, nullptr}; pg8::gemm_phase<3>(lds, g, S, E, wv); }
        PHM(3) PHASE(pb + 1) DUPK(3) { PMARK(3); SEAM(pb + 1); phase_conv(pq, wv, le); phase_swa(pq, wv, lds, le); }
        PHM(4) PHASE(pb + 2) DUPK(4) { PMARK(4); SEAM(pb + 2);
            pg8::Gemm g{(const bf16_t*)(ws + OFF_U + U_MIX_E), (const bf16_t*)(ws + OFF_WOUTE + pr * SZ_WOUT), 1024, 1024}; pg8::StaticOrder S; S.init(NM, 4, G, c);
            pg8::EpiBf16S E{(bf16_t*)(ws + OFF_U + U_Y_E), 1024, 4, nullptr, 1.0f}; pg8::gemm_phase<2>(lds, g, S, E, wv);
            { int rk, ni; if (tail_share(NM * 4, G, c, rk, ni)) conv_tiles_run(p, lds, opaque_tid(wv), CV_NT_PRO + pr * (CV_NT_E / 2), CV_NT_PRO + pr * (CV_NT_E / 2) + TAIL_T_SPLIT, rk, ni); } }
        PHM(5) PHASE(pb + 3) DUPK(5) { PMARK(5); SEAM(pb + 3); phase_rowB<false>(pq, wv, lds, le, (const bf16_t*)(ws + OFF_U + U_Y_E), MTOT, DUP_DUMMY(5)); }
        PHM(6) PHASE(pb + 4) DUPK(6) { PMARK(6); SEAM(pb + 4);
            pg8::Gemm g{abuf, ws + OFF_WGU + pr * SZ_WGU, 1024, 1024}; pg8::StaticOrder S; S.init(NM, 2 * FFD / 256, G, c);
            pg8::EpiSwiGLU<FFN_DOWN_FP8 != 0> E{ws + OFF_U + U_ACT_E, FFD, 2 * FFD / 256, (const float*)(ws + OFF_FSC), (const float*)(ws + OFF_WSCD) + (size_t)pr * 2 * FFD}; pg8::gemm_phase<3>(lds, g, S, E, wv); }
        PHM(7) PHASE(pb + 5) DUPK(7) { PMARK(7); SEAM(pb + 5);
            pg8::Gemm g{ws + OFF_U + U_ACT_E, ws + OFF_WDN + pr * SZ_WDN, FFD, FFD}; pg8::StaticOrder S; S.init(NM, 4, G, c);
            pg8::EpiBf16S E{(bf16_t*)(ws + OFF_U + U_Y_E), 1024, 4, nullptr, FFN_DOWN_FP8 ? 1.0f / W8_SCALE : 1.0f}; pg8::gemm_phase<FFN_DOWN_FP8 ? 1 : 2>(lds, g, S, E, wv);
            { int rk, ni; if (tail_share(NM * 4, G, c, rk, ni)) {
                if (pr == 0) conv_units(p, lds, opaque_tid(wv), CV_NU_PRO, CV_NU_PRO + TAIL_U_SPLIT, rk, ni); else conv_units(p, lds, opaque_tid(wv), CV_NU_PRO + CV_NU_E / 2 + TAIL_U_SPLIT, CV_NU, rk, ni); } } }
        PHM(8) PHASE(pb + 6) DUPK(8) { PMARK(8); SEAM(pb + 6); phase_rowC<false>(pq, wv, le, (const bf16_t*)(ws + OFF_U + U_Y_E), false, DUP_DUMMY(8)); }
        PHM(9) PHASE(pb + 7) DUPK(9) { PMARK(9); SEAM(pb + 7);
            pg8::Gemm g{abuf, ws + OFF_WINO + pr * SZ_WINO, 1024, 1024}; pg8::StaticOrder S; S.init(NM, ODD_INP / 256, G, c);
            pg8::EpiRope<1> E{(bf16_t*)(ws + OFF_U + U_P_O), ODD_INP, (const float*)(ws + OFF_TAB), (const float*)(ws + OFF_FSC), (const float*)(ws + OFF_WSCI) + 2 * EVEN_IN + (size_t)pr * ODD_INP, (float*)(ws + OFF_U + U_SSQ_O)}; pg8::gemm_phase<3>(lds, g, S, E, wv);
            { int rk, ni; if (tail_share(NM * (ODD_INP / 256), G, c, rk, ni)) conv_tiles_run(p, lds, opaque_tid(wv), CV_NT_PRO + pr * (CV_NT_E / 2) + TAIL_T_SPLIT, CV_NT_PRO + (pr + 1) * (CV_NT_E / 2), rk, ni); } }
        PHM(11) PHASE(pb + 8) DUPK(11) { PMARK(11); SEAM(pb + 8);
            pg8::Gemm g{(const bf16_t*)(ws + OFF_U + U_P_O), (const bf16_t*)(ws + OFF_WQUP + pr * SZ_WQUP), ODD_INP, 256}; pg8::StaticOrder S; S.init(NM, 3, G, c);
            pg8::EpiBf16N<8> E{(bf16_t*)(ws + OFF_U + U_QF_O), 768, (const float*)(ws + OFF_U + U_SSQ_O), 1.0f / 256.0f}; pg8::gemm_phase<2>(lds, g, S, E, wv); }
        PHM(19) PHASE(pb + 9) DUPK(19) { PMARK(19);
            pg8::Gemm g{(const bf16_t*)(ws + OFF_U + U_P_O) + 256, (const bf16_t*)(ws + OFF_WKVUP + pr * SZ_WKVUP), ODD_INP, 256}; pg8::StaticOrder S; S.init(NM, 4, G, G - 1 - c);
            pg8::EpiBf16N<4> E{(bf16_t*)(ws + OFF_U + U_KVF_O), 1024, (const float*)(ws + OFF_U + U_SSQ_O) + 8, 1.0f / 128.0f}; pg8::gemm_phase<2>(lds, g, S, E, wv); }
        PHM(12) PHASE(pb + 10) DUPK(12) { PMARK(12); SEAM(pb + 10); phase_attn_odd(pq, wv, lds, lod); }
        PHM(13) PHASE(pb + 11) DUPK(13) { PMARK(13); SEAM(pb + 11);
            pg8::Gemm g{(const bf16_t*)(ws + OFF_U + U_MIX_O), (const bf16_t*)(ws + OFF_WOUTO + pr * SZ_WOUT), 1024, 1024}; pg8::StaticOrder S; S.init(pr == 1 ? MLAT / 256 : NM, 4, G, c);
            pg8::EpiBf16S E{(bf16_t*)(ws + OFF_EOUT), 1024, 4, nullptr, 1.0f}; pg8::gemm_phase<2>(lds, g, S, E, wv);
            { int rk, ni; if (pr == 0 && tail_share(NM * 4, G, c, rk, ni)) conv_units(p, lds, opaque_tid(wv), CV_NU_PRO + TAIL_U_SPLIT, CV_NU_PRO + CV_NU_E / 2, rk, ni); } }
        PHM(14) PHASE(pb + 12) DUPK(14) { PMARK(14); SEAM(pb + 12); phase_rowB<true>(pq, wv, lds, lod, (const bf16_t*)(ws + OFF_EOUT), pr == 1 ? MLAT : MTOT, DUP_DUMMY(14)); }
        PHM(16) PHASE(pb + 13) DUPK(16) { PMARK(16); SEAM(pb + 13);
            const MoeLayout L = moe_layout(pq, lod);
            pg8::Gemm g{ws + OFF_GBUF, ws + OFF_WEGU + (size_t)pr * 8 * (SZ_WEGU / 2), 1024, 1024};
            pg8::MoeOrder S; S.gatherA = true; S.so.init(L.tstart[8], 2 * FFE / 256, G, c);
#pragma unroll
            for (int e = 0; e < 9; ++e) S.ts[e] = L.tstart[e];
            pg8::EpiSwiGLU<FFN_DOWN_FP8 != 0> E{ws + OFF_U, FFE, 2 * FFE / 256, (const float*)(ws + OFF_GWT), (const float*)(ws + OFF_WSCE) + (size_t)pr * 8 * 2 * FFE}; pg8::gemm_phase<3>(lds, g, S, E, wv); }
        PHM(17) PHASE(pb + 14) DUPK(17) { PMARK(17); SEAM(pb + 14);
            const MoeLayout L = moe_layout(pq, lod);
            pg8::Gemm g{ws + OFF_U, ws + OFF_WEDN + (size_t)pr * 8 * (SZ_WEDN / (FFN_DOWN_FP8 ? 2 : 1)), FFE, FFE};
            pg8::MoeOrder S; S.gatherA = false; S.so.init(L.tstart[8], 4, G, c);
#pragma unroll
            for (int e = 0; e < 9; ++e) S.ts[e] = L.tstart[e];
            pg8::EpiBf16S E{(bf16_t*)(ws + OFF_EOUT), 1024, 4, (const float*)(ws + OFF_TWT), FFN_DOWN_FP8 ? 1.0f / W8_SCALE : 1.0f}; pg8::gemm_phase<FFN_DOWN_FP8 ? 1 : 2>(lds, g, S, E, wv);
            { int rk, ni; if (pr == 0 && tail_share(4 * L.tstart[8], G, c, rk, ni)) conv_units(p, lds, opaque_tid(wv), CV_NU_PRO + CV_NU_E / 2, CV_NU_PRO + CV_NU_E / 2 + TAIL_U_SPLIT, rk, ni); } }
        PHM(18) PHASE(pb + 15) DUPK(18) { PMARK(18); SEAM(pb + 15); phase_rowC<true>(pq, wv, lod, nullptr, pr == 1, DUP_DUMMY(18)); }
    }
#undef PHASE
#undef SEAM
}

extern "C" void kernel_launch(void* const* d_in, const int* in_sizes, int n_in, void* d_out, int out_size, void* d_ws, size_t ws_size, hipStream_t stream) {
    static int grid = 0;
    if (grid == 0) {
        if (n_in != 24 || out_size != MLAT * DM || ws_size < WS_END + (DUP_MASK != 0u ? (size_t)MTOT * DM * 6 : (size_t)0)) { fprintf(stderr, "kernel_launch: unexpected shapes (n_in %d, out %d, ws %zu, need %zu)\n", n_in, out_size, ws_size, (size_t)WS_END); grid = -1; return; }
        int dev = 0, cus = 0, per_cu = 0;
        if (hipGetDevice(&dev) != hipSuccess || hipDeviceGetAttribute(&cus, hipDeviceAttributeMultiprocessorCount, dev) != hipSuccess) { grid = -1; return; }
        if (hipFuncSetAttribute((const void*)fwd, hipFuncAttributeMaxDynamicSharedMemorySize, LDS_BYTES) != hipSuccess) { fprintf(stderr, "kernel_launch: hipFuncSetAttribute failed\n"); grid = -1; return; }
        if (hipOccupancyMaxActiveBlocksPerMultiprocessor(&per_cu, (const void*)fwd, NTHREADS, LDS_BYTES) != hipSuccess || per_cu < 1) { fprintf(stderr, "kernel_launch: occupancy query says %d\n", per_cu); grid = -1; return; }
        grid = cus < 256 ? cus : 256;
        if (grid != 256) fprintf(stderr, "kernel_launch: %d CUs; the row-wise phases assume 256 workgroups\n", cus);
    }
    if (grid != 256) return;
    Params p{};
    for (int i = 0; i < 24; ++i) p.in[i] = (const float*)d_in[i];
    p.out = (float*)d_out; p.ws = (unsigned char*)d_ws;
    hipMemsetAsync((char*)d_ws + OFF_CTL, 0, CTL_BYTES, stream);
#if MK_MULTI_LAUNCH
    for (int ph = 0; ph < NPHASES; ++ph) hipLaunchKernelGGL(fwd, dim3(grid), dim3(NTHREADS), LDS_BYTES, stream, p, ph, ph + 1);
#else
    hipLaunchKernelGGL(fwd, dim3(grid), dim3(NTHREADS), LDS_BYTES, stream, p, 0, NPHASES);
#endif
}
```

```cpp
#include <hip/hip_runtime.h>
#include <cstdio>
#include <cstdint>
#include <cstddef>

#ifndef FFN_DOWN_FP8
#define FFN_DOWN_FP8 1
#endif
#ifndef MK_MULTI_LAUNCH
#define MK_MULTI_LAUNCH 0
#endif

#define LAS __attribute__((address_space(3)))
typedef unsigned short bf16_t;
typedef short bf16x8 __attribute__((ext_vector_type(8)));
typedef short s16x4 __attribute__((ext_vector_type(4)));
typedef float f32x4 __attribute__((ext_vector_type(4)));
typedef float f32x2 __attribute__((ext_vector_type(2)));
typedef float f32x16 __attribute__((ext_vector_type(16)));
typedef unsigned u32x4 __attribute__((ext_vector_type(4)));
typedef unsigned u32x2 __attribute__((ext_vector_type(2)));

constexpr int DM = 1024, NB = 8, SEQ = 4096, CTXL = 256;
constexpr int MLAT = NB * SEQ, MCTX = NB * CTXL, MTOT = MLAT + MCTX;
constexpr int EVEN_IN = 2304, ODD_INP = 2048  , FFD = 2816, FFE = 3584, NEXP = 8;
constexpr int MG_ROWS = 2 * MTOT + NEXP * 256;
constexpr float EPSN = 1e-6f;
constexpr float LOG2E = 1.4426950408889634f;
constexpr int NTHREADS = 512, NWAVES = 8;
constexpr int LDS_BYTES = 147456;
constexpr int ROWS_PER_BLOCK = MTOT / 256;

constexpr size_t al256(size_t x) { return (x + 255) & ~(size_t)255; }
constexpr size_t OFF_CTL   = 0;
constexpr size_t CTL_BYTES = 65536;
constexpr size_t OFF_MOD   = OFF_CTL + CTL_BYTES;
constexpr size_t OFF_TAB   = al256(OFF_MOD + (size_t)4 * 9 * 6144 * 4);
constexpr size_t OFF_SLOT  = al256(OFF_TAB + 16384);
constexpr size_t OFF_TOK   = al256(OFF_SLOT + (size_t)MTOT * 16);
constexpr size_t OFF_TWT   = al256(OFF_TOK + (size_t)NEXP * MTOT * 4);
constexpr size_t OFF_GWT   = al256(OFF_TWT + (size_t)NEXP * MTOT * 4);
constexpr size_t OFF_GSC   = al256(OFF_GWT + (size_t)NEXP * MTOT * 4);
constexpr size_t OFF_FSC   = al256(OFF_GSC + (size_t)MG_ROWS * 4);
constexpr size_t OFF_WSCD  = al256(OFF_FSC + (size_t)MTOT * 4);
constexpr size_t OFF_WSCE  = al256(OFF_WSCD + (size_t)2 * 2 * FFD * 4);
constexpr size_t OFF_WSCI  = al256(OFF_WSCE + (size_t)16 * 2 * FFE * 4);
constexpr size_t OFF_WINE  = al256(OFF_WSCI + (size_t)(2 * EVEN_IN + 2 * ODD_INP) * 4);
constexpr size_t SZ_WINE   = (size_t)EVEN_IN * 1024 * 2;
constexpr size_t OFF_WOUTE = OFF_WINE + 2 * SZ_WINE;
constexpr size_t SZ_WOUT   = (size_t)1024 * 1024 * 2;
constexpr size_t OFF_WINO  = OFF_WOUTE + 2 * SZ_WOUT;
constexpr size_t SZ_WINO   = (size_t)ODD_INP * 1024 * 2;
constexpr size_t OFF_WQUP  = OFF_WINO + 2 * SZ_WINO;
constexpr size_t SZ_WQUP   = (size_t)768 * 256 * 2;
constexpr size_t OFF_WKVUP = OFF_WQUP + 2 * SZ_WQUP;
constexpr size_t SZ_WKVUP  = (size_t)1024 * 256 * 2;
constexpr size_t OFF_WOUTO = OFF_WKVUP + 2 * SZ_WKVUP;
constexpr size_t OFF_WGU   = OFF_WOUTO + 2 * SZ_WOUT;
constexpr size_t SZ_WGU    = (size_t)2 * FFD * 1024 * 2;
constexpr size_t OFF_WDN   = OFF_WGU + 2 * SZ_WGU;
constexpr size_t SZ_WDN    = (size_t)1024 * FFD * 2;
constexpr size_t OFF_WEGU  = OFF_WDN + 2 * SZ_WDN;
constexpr size_t SZ_WEGU   = (size_t)2 * FFE * 1024 * 2;
constexpr size_t OFF_WEDN  = OFF_WEGU + 16 * SZ_WEGU;
constexpr size_t SZ_WEDN   = (size_t)1024 * FFE * 2;
constexpr size_t OFF_XS    = al256(OFF_WEDN + 16 * SZ_WEDN);
constexpr size_t OFF_ABUF  = OFF_XS + (size_t)MTOT * 1024 * 4;
constexpr size_t OFF_U     = OFF_ABUF + (size_t)MTOT * 1024 * 2;
constexpr size_t SZ_U      = (size_t)MG_ROWS * FFE * 2;
constexpr size_t U_P_E   = 0;
constexpr size_t U_MIX_E = U_P_E + (size_t)MTOT * EVEN_IN * 2;
constexpr size_t U_Y_E   = U_MIX_E + (size_t)MTOT * 1024 * 2;
constexpr size_t U_ACT_E = 0;
constexpr size_t U_P_O   = 0;
constexpr size_t U_NRM_O = U_P_O + (size_t)MTOT * ODD_INP * 2;
constexpr size_t U_KVN_O = U_NRM_O + (size_t)MTOT * 256 * 2;
constexpr size_t U_SSQ_O = U_NRM_O;
constexpr size_t U_QF_O  = U_KVN_O + (size_t)MTOT * 256 * 2;
constexpr size_t U_KVF_O = U_QF_O + (size_t)MTOT * 768 * 2;
constexpr size_t U_MIX_O = U_KVF_O + (size_t)MTOT * 1024 * 2;
static_assert(U_MIX_O + (size_t)MTOT * 1024 * 2 <= SZ_U, "odd-layer map fits the union region");
static_assert(U_Y_E + (size_t)MTOT * 1024 * 4 <= SZ_U, "even-layer map fits the union region");
static_assert((size_t)MTOT * FFD * 2 <= U_Y_E, "dense act must not overlap F");
constexpr int    CAPR      = MTOT;
constexpr size_t OFF_GBUF  = OFF_U + SZ_U;
constexpr size_t OFF_EOUT  = OFF_GBUF + (size_t)NEXP * CAPR * 1024;
constexpr size_t WS_END    = OFF_EOUT + (size_t)MG_ROWS * 1024 * 2;

constexpr int CW_MOECNT = 4096;

struct Params { const float* in[24]; float* out; unsigned char* ws; };

__device__ __forceinline__ unsigned pk_bf16(float lo, float hi) { typedef __bf16 b2 __attribute__((ext_vector_type(2))); f32x2 v = {lo, hi}; b2 b = __builtin_convertvector(v, b2); return __builtin_bit_cast(unsigned, b); }
__device__ __forceinline__ float bf_lo(unsigned w) { return __uint_as_float(w << 16); }
__device__ __forceinline__ float bf_hi(unsigned w) { return __uint_as_float(w & 0xffff0000u); }
__device__ __forceinline__ float clamp448(float x) { return __builtin_fminf(__builtin_fmaxf(x, -448.0f), 448.0f); }
__device__ __forceinline__ unsigned pk_fp8x4(float a, float b, float c, float d) {
    int v = __builtin_amdgcn_cvt_pk_fp8_f32(clamp448(a), clamp448(b), 0, false); v = __builtin_amdgcn_cvt_pk_fp8_f32(clamp448(c), clamp448(d), v, true); return (unsigned)v; }
__device__ __forceinline__ unsigned pk_i8x4(float a, float b, float c, float d) {
    const int ia = (int)__builtin_rintf(a), ib = (int)__builtin_rintf(b), ic = (int)__builtin_rintf(c), id = (int)__builtin_rintf(d);
    return (unsigned)(ia & 0xff) | ((unsigned)(ib & 0xff) << 8) | ((unsigned)(ic & 0xff) << 16) | ((unsigned)id << 24); }
template <int CTRL> __device__ __forceinline__ float dppf(float v) { return __builtin_bit_cast(float, __builtin_amdgcn_update_dpp(0, __builtin_bit_cast(int, v), CTRL, 0xF, 0xF, true)); }
__device__ __forceinline__ float wave_max(float v) {
    v = fmaxf(v, dppf<0xB1>(v)); v = fmaxf(v, dppf<0x4E>(v)); v = fmaxf(v, dppf<0x141>(v)); v = fmaxf(v, dppf<0x140>(v));
    { const auto rr = __builtin_amdgcn_permlane16_swap(__float_as_uint(v), __float_as_uint(v), false, false); v = fmaxf(__uint_as_float(rr[0]), __uint_as_float(rr[1])); }
    { const auto rr = __builtin_amdgcn_permlane32_swap(__float_as_uint(v), __float_as_uint(v), false, false); v = fmaxf(__uint_as_float(rr[0]), __uint_as_float(rr[1])); }
    return v; }
__device__ __forceinline__ float wave_sum(float v) {
    v += dppf<0xB1>(v); v += dppf<0x4E>(v); v += dppf<0x141>(v); v += dppf<0x140>(v);
    { const auto rr = __builtin_amdgcn_permlane16_swap(__float_as_uint(v), __float_as_uint(v), false, false); v = __uint_as_float(rr[0]) + __uint_as_float(rr[1]); }
    { const auto rr = __builtin_amdgcn_permlane32_swap(__float_as_uint(v), __float_as_uint(v), false, false); v = __uint_as_float(rr[0]) + __uint_as_float(rr[1]); }
    return v; }
__device__ __forceinline__ void st_wt(void* base, unsigned off, u32x4 v) { __builtin_amdgcn_raw_buffer_store_b128(v, __builtin_amdgcn_make_buffer_rsrc(base, 0, 0x7FFFFFFF, 0x00020000), (int)off, 0, 16); }
__device__ __forceinline__ void st_wt(void* base, unsigned off, u32x2 v) { __builtin_amdgcn_raw_buffer_store_b64(v, __builtin_amdgcn_make_buffer_rsrc(base, 0, 0x7FFFFFFF, 0x00020000), (int)off, 0, 16); }
__device__ __forceinline__ void st_pl(void* base, unsigned off, u32x4 v) { *(u32x4*)((unsigned char*)base + off) = v; }
__device__ __forceinline__ void st_pl(void* base, unsigned off, u32x2 v) { *(u32x2*)((unsigned char*)base + off) = v; }
__device__ __forceinline__ float fast_exp2(float x) { return __builtin_amdgcn_exp2f(x); }
__device__ __forceinline__ float fast_rcp(float x) { return __builtin_amdgcn_rcpf(x); }
__device__ __forceinline__ float silu_f(float g) { return g * fast_rcp(1.0f + fast_exp2(-g * LOG2E)); }
__device__ __forceinline__ int lane_id() { int l; asm volatile("v_mbcnt_lo_u32_b32 %0, -1, 0\n\tv_mbcnt_hi_u32_b32 %0, -1, %0" : "=v"(l)); return l; }
__device__ __forceinline__ int opaque_tid(int wv) { int t = (wv << 6) | lane_id(); asm volatile("" : "+v"(t)); return t; }
__device__ __forceinline__ int crow(int r, int hi) { return (r & 3) + 8 * (r >> 2) + 4 * hi; }

#define XB_TMO      128
#define XB_XCNT(j)  (256  + 64 * (j))
#define XB_XSUB(j)  (1280 + 64 * (j))
#define XB_XGEN(j)  (2304 + 64 * (j))
#define XB_TOP      3328
#define XB_TOPGEN   3392
#define XCD_BAR_WORDS 3456
#define XB_SPIN_CAP (1u << 22)
__device__ __forceinline__ unsigned xb_ld(unsigned* p)              { return __hip_atomic_load(p, __ATOMIC_RELAXED, __HIP_MEMORY_SCOPE_AGENT); }
__device__ __forceinline__ unsigned xb_add(unsigned* p, unsigned v) { return __hip_atomic_fetch_add(p, v, __ATOMIC_RELAXED, __HIP_MEMORY_SCOPE_AGENT); }
__device__ __forceinline__ unsigned xb_xcc_id() { return (unsigned)__builtin_amdgcn_s_getreg((3 << 11) | 20) & 0xFu; }
#define XB_SPIN(cond, bar) do { unsigned _sp = 0; while (cond) { __builtin_amdgcn_s_sleep(1); \
    if ((++_sp & 255u) == 0u) { if (xb_ld(&(bar)[XB_TMO])) break; if (_sp > XB_SPIN_CAP) { atomicAdd(&(bar)[XB_TMO], 1u); break; } } } } while (0)
struct XcdBarrier { unsigned* bar; unsigned x; volatile LAS unsigned* st; int wv; };
__device__ __forceinline__ XcdBarrier xcd_barrier_post(unsigned* bar, volatile LAS unsigned* st, int wv) {
    XcdBarrier b; b.bar = bar; b.x = xb_xcc_id(); b.st = st; b.wv = wv;
    if (wv == 0 && lane_id() == 0) (void)xb_add(&bar[XB_XCNT(b.x)], 1u);
    return b;
}
__device__ __forceinline__ void xcd_barrier_complete(unsigned* bar, unsigned x, unsigned& nloc, unsigned& nx) {
    const unsigned G = gridDim.x * gridDim.y * gridDim.z;
    unsigned sum, cnt, mine, sp = 0u;
    for (;;) {
        sum = 0u; cnt = 0u; mine = 0u;
#pragma unroll
        for (unsigned j = 0; j < 16; ++j) { const unsigned c = xb_ld(&bar[XB_XCNT(j)]); sum += c; cnt += (c > 0u) ? 1u : 0u; mine = (j == x) ? c : mine; }
        if (sum == G) break;
        __builtin_amdgcn_s_sleep(1);
        if ((++sp & 255u) == 0u) { if (xb_ld(&bar[XB_TMO])) break; if (sp > XB_SPIN_CAP) { atomicAdd(&bar[XB_TMO], 1u); break; } }
    }
    nloc = mine > 0u ? mine : 1u; nx = cnt > 0u ? cnt : 1u;
}
__device__ __forceinline__ void xcd_barrier(const XcdBarrier& b) {
    asm volatile("s_waitcnt vmcnt(0)" ::: "memory");
    __syncthreads();
    if (b.wv == 0 && lane_id() == 0) {
        unsigned* bar = b.bar;
        __builtin_amdgcn_s_waitcnt(0);
        unsigned nloc = b.st[0], nx = b.st[1];
        if (nloc == 0u) { xcd_barrier_complete(bar, b.x, nloc, nx); b.st[0] = nloc; b.st[1] = nx; }
        const unsigned old = xb_add(&bar[XB_XSUB(b.x)], 1u);
        const unsigned gen = old / nloc;
        if (old + 1u == (gen + 1u) * nloc) {
            __builtin_amdgcn_fence(__ATOMIC_RELEASE, "agent");
            asm volatile("s_waitcnt vmcnt(0)" ::: "memory");
            const unsigned og = xb_add(&bar[XB_TOP], 1u);
            const unsigned tg = og / nx;
            if (og + 1u == (tg + 1u) * nx) xb_add(&bar[XB_TOPGEN], 1u);
            else XB_SPIN(xb_ld(&bar[XB_TOPGEN]) == tg, bar);
            __builtin_amdgcn_fence(__ATOMIC_ACQUIRE, "agent");
            xb_add(&bar[XB_XGEN(b.x)], 1u);
            asm volatile("s_waitcnt vmcnt(0)" ::: "memory");
        } else {
            XB_SPIN(xb_ld(&bar[XB_XGEN(b.x)]) == gen, bar);
            __builtin_amdgcn_fence(__ATOMIC_ACQUIRE, "agent");
            asm volatile("s_waitcnt vmcnt(0)" ::: "memory");
        }
    }
    __syncthreads();
}

namespace pg8 {
constexpr int BM = 256, BK = 64, HALF = 128, HTB = HALF * BK * 2, STAGE_BYTES = 8 * HTB, NXCD = 8, WGM = 8;
__host__ __device__ __forceinline__ int lds_byte(int r, int c) { const int st = (r >> 4) * 2 + (c >> 5), rr = r & 15, cc = c & 31, ob = rr * 64 + cc * 2; return st * 1024 + (ob ^ (((ob >> 9) & 1) << 5)); }
__host__ __device__ __forceinline__ void stage_rc(int b, int& R, int& C) { const int st = b / 1024, sb = b % 1024, swz = sb ^ (((sb >> 9) & 1) << 5); R = (st >> 1) * 16 + swz / 64; C = (st & 1) * 32 + (swz % 64) / 2; }
__host__ __device__ __forceinline__ int perm32(int rho) { const int n = rho >> 4, i = rho & 15; return 8 * (i >> 2) + 4 * n + (i & 3); }
typedef int v8i32 __attribute__((ext_vector_type(8))); typedef int v4i32 __attribute__((ext_vector_type(4)));
__device__ __forceinline__ v8i32 cat8(bf16x8 a, bf16x8 b) { const v4i32 x = __builtin_bit_cast(v4i32, a), y = __builtin_bit_cast(v4i32, b); return (v8i32){x[0], x[1], x[2], x[3], y[0], y[1], y[2], y[3]}; }
struct Unit { int pm, pn, pa, ro; };
struct Gemm { const void* A; const void* Bt; int lda, K; };
struct StaticOrder {
    int nM, nN, nwg, G, c;
    __device__ void init(int nM_, int nN_, int G_, int c_) { nM = nM_; nN = nN_; nwg = nM * nN; G = G_; c = c_; }
    __device__ __forceinline__ bool next(int i, Unit& u) const {
        const long L = (long)i * G + c; if (L >= nwg) return false;
        int wgid = (int)L; { const int q = nwg / NXCD, r = nwg % NXCD, xcd = wgid % NXCD, off = wgid / NXCD; wgid = (xcd < r ? xcd * (q + 1) : r * (q + 1) + (xcd - r) * q) + off; }
        const int nig = WGM * nN, gid = wgid / nig, fm = gid * WGM, gsz = (nM - fm) < WGM ? (nM - fm) : WGM;
        u.pm = fm + ((wgid % nig) % gsz); u.pn = (wgid % nig) / gsz; u.pa = u.pm; u.ro = 0; return true;
    }
};
struct MoeOrder {
    StaticOrder so; int ts[9]; bool gatherA;
    __device__ __forceinline__ bool next(int i, Unit& u) const {
        if (!so.next(i, u)) return false;
        int e = 0;
#pragma unroll
        for (int j = 1; j < 8; ++j) e += (u.pm >= ts[j]) ? 1 : 0;
        int te = 0;
#pragma unroll
        for (int j = 0; j < 8; ++j) te = (j == e) ? ts[j] : te;
        u.pn += e * so.nN; u.pa = gatherA ? e * (CAPR / 256) + (u.pm - te) : u.pm; u.ro = e * MTOT - te * 256; return true;
    }
};

template <int FMT, class Epi, class Sched>
__device__ __forceinline__ void gemm_phase(LAS unsigned char* lds, const Gemm g, const Sched& S, const Epi& E, const int wv) {
    const int tid = opaque_tid(wv), wid = __builtin_amdgcn_readfirstlane(tid >> 6), lane = tid & 63, wr = wid >> 2, wc = wid & 3, fr = lane & 15, fq = lane >> 4;
    constexpr int ESZ = FMT == 2 ? 2 : 1;
    int K_ = g.K, lda_ = g.lda; asm volatile("" : "+s"(K_), "+s"(lda_));
    const int K = K_ * ESZ, nt = K / (BK * 2), lda = lda_ * ESZ;
    unsigned voffA[2], voffB[2];
#pragma unroll
    for (int i = 0; i < 2; ++i) { int R, C; stage_rc(tid * 16 + i * 8192, R, C); const int Rb = Epi::PERM ? ((R & ~31) + perm32(R & 31)) : R;
        voffA[i] = (unsigned)(R * lda + C * 2); voffB[i] = (unsigned)(Rb * K + C * 2); }
    const size_t kstep = (size_t)(BK * 2);
    const size_t hstepA = (size_t)HALF * lda, hstepB = (size_t)HALF * K;
    const size_t tstepA = 2 * hstepA, tstepB = 2 * hstepB;
    const unsigned ldsw = (unsigned)wid * 1024u;
    const int aoff = lds_byte(wr * 64 + fr, fq * 8), boff = lds_byte(wc * 32 + fr, fq * 8);
#define PG8_SA(b, h) (((b) * 2 + (h)) * HTB)
#define PG8_SB(b, h) ((4 + (b) * 2 + (h)) * HTB)
#define PG8_STAGE(bufoff, gbase, voff) do { _Pragma("unroll") for (int _i = 0; _i < 2; ++_i) \
        __builtin_amdgcn_global_load_lds((const unsigned*)((const char*)(gbase) + (voff)[_i]), (LAS unsigned*)(lds + (bufoff) + ldsw + _i * 8192), 16, 0, 0); } while (0)
#define PG8_LD8(addr) __builtin_shufflevector(*(const LAS v4i32*)(addr), *(const LAS v4i32*)((addr) + 1024), 0, 1, 2, 3, 4, 5, 6, 7)
#define PG8_LDA(dst, b, h) do { _Pragma("unroll") for (int m = 0; m < 4; ++m) dst[m] = PG8_LD8(lds + PG8_SA(b, h) + aoff + m * 2048); } while (0)
#define PG8_LDB(dst, b, h) do { _Pragma("unroll") for (int n = 0; n < 2; ++n) dst[n] = PG8_LD8(lds + PG8_SB(b, h) + boff + n * 2048); } while (0)
#define PG8_LO(v) __builtin_bit_cast(bf16x8, __builtin_shufflevector(v, v, 0, 1, 2, 3))
#define PG8_HI(v) __builtin_bit_cast(bf16x8, __builtin_shufflevector(v, v, 4, 5, 6, 7))
#define PG8_MMA(ai, bj, At, Bt) do { __builtin_amdgcn_s_setprio(1); \
        if constexpr (FMT == 3) { _Pragma("unroll") for (int m = 0; m < 4; ++m) _Pragma("unroll") for (int n = 0; n < 2; ++n) { \
            v4i32 c_ = __builtin_bit_cast(v4i32, acc[ai][bj][m][n]); \
            c_ = __builtin_amdgcn_mfma_i32_16x16x64_i8(__builtin_shufflevector(Bt[n], Bt[n], 0, 1, 2, 3), __builtin_shufflevector(At[m], At[m], 0, 1, 2, 3), c_, 0, 0, 0); \
            c_ = __builtin_amdgcn_mfma_i32_16x16x64_i8(__builtin_shufflevector(Bt[n], Bt[n], 4, 5, 6, 7), __builtin_shufflevector(At[m], At[m], 4, 5, 6, 7), c_, 0, 0, 0); \
            acc[ai][bj][m][n] = __builtin_bit_cast(f32x4, c_); } } \
        else if constexpr (FMT == 2) { _Pragma("unroll") for (int m = 0; m < 4; ++m) _Pragma("unroll") for (int n = 0; n < 2; ++n) { \
            acc[ai][bj][m][n] = __builtin_amdgcn_mfma_f32_16x16x32_bf16(PG8_LO(Bt[n]), PG8_LO(At[m]), acc[ai][bj][m][n], 0, 0, 0); \
            acc[ai][bj][m][n] = __builtin_amdgcn_mfma_f32_16x16x32_bf16(PG8_HI(Bt[n]), PG8_HI(At[m]), acc[ai][bj][m][n], 0, 0, 0); } } \
        else { asm volatile("s_nop 1\n\t" \
            "v_mfma_f32_16x16x128_f8f6f4 %0, %8, %10, %0\n\t" "v_mfma_f32_16x16x128_f8f6f4 %1, %9, %10, %1\n\t" \
            "v_mfma_f32_16x16x128_f8f6f4 %2, %8, %11, %2\n\t" "v_mfma_f32_16x16x128_f8f6f4 %3, %9, %11, %3\n\t" \
            "v_mfma_f32_16x16x128_f8f6f4 %4, %8, %12, %4\n\t" "v_mfma_f32_16x16x128_f8f6f4 %5, %9, %12, %5\n\t" \
            "v_mfma_f32_16x16x128_f8f6f4 %6, %8, %13, %6\n\t" "v_mfma_f32_16x16x128_f8f6f4 %7, %9, %13, %7\n\t" \
            "s_nop 11" \
            : "+v"(acc[ai][bj][0][0]), "+v"(acc[ai][bj][0][1]), "+v"(acc[ai][bj][1][0]), "+v"(acc[ai][bj][1][1]), "+v"(acc[ai][bj][2][0]), "+v"(acc[ai][bj][2][1]), "+v"(acc[ai][bj][3][0]), "+v"(acc[ai][bj][3][1]) \
            : "v"(Bt[0]), "v"(Bt[1]), "v"(At[0]), "v"(At[1]), "v"(At[2]), "v"(At[3]), "v"(scl8)); } \
        __builtin_amdgcn_s_setprio(0); } while (0)
#define PG8_WAIT_V(n) asm volatile("s_waitcnt vmcnt(" #n ")" ::: "memory")
#define PG8_WAIT_L(n) asm volatile("s_waitcnt lgkmcnt(" #n ")" ::: "memory")
#define PG8_BAR __builtin_amdgcn_s_barrier()
#define PG8_SCHED __builtin_amdgcn_sched_barrier(0)
    Unit cur, nxt; int ui = 0;
    if (!S.next(0, cur)) return;
    f32x4 acc[2][2][4][2];
#pragma unroll
    for (int a = 0; a < 2; ++a)
#pragma unroll
        for (int b = 0; b < 2; ++b)
#pragma unroll
            for (int m = 0; m < 4; ++m)
#pragma unroll
                for (int n = 0; n < 2; ++n) acc[a][b][m][n] = (f32x4){0.f, 0.f, 0.f, 0.f};
    v8i32 At[4], B0[2], B1[2];
    const int scl8 = 0x7F7F7F7F;
    const char* cA = (const char*)g.A + (size_t)cur.pa * tstepA; const char* cB = (const char*)g.Bt + (size_t)cur.pn * tstepB;
    PG8_STAGE(PG8_SB(0, 0), cB, voffB); PG8_STAGE(PG8_SB(0, 1), cB + hstepB, voffB); PG8_STAGE(PG8_SA(0, 0), cA, voffA); PG8_STAGE(PG8_SA(0, 1), cA + hstepA, voffA);
    if (wr == 1) PG8_BAR;
    PG8_WAIT_V(2); PG8_BAR;
    PG8_STAGE(PG8_SB(1, 0), cB + kstep, voffB); PG8_STAGE(PG8_SA(1, 0), cA + kstep, voffA); PG8_STAGE(PG8_SB(1, 1), cB + hstepB + kstep, voffB);
    PG8_WAIT_V(6); PG8_BAR;
    for (;;) {
        const bool has_next = S.next(ui + 1, nxt);
        const char* nA = has_next ? (const char*)g.A + (size_t)nxt.pa * tstepA : cA; const char* nB = has_next ? (const char*)g.Bt + (size_t)nxt.pn * tstepB : cB;
#pragma unroll 1
        for (int t = 0; t < nt; t += 2) {
            const bool last = (t == nt - 2);
            const char* a1 = cA + (size_t)(t + 1) * kstep;
            const char* a2 = last ? nA : cA + (size_t)(t + 2) * kstep; const char* b2 = last ? nB : cB + (size_t)(t + 2) * kstep;
            const char* a3 = a2 + kstep; const char* b3 = b2 + kstep;
            PG8_LDB(B0, 0, 0); PG8_LDB(B1, 0, 1); PG8_SCHED; PG8_LDA(At, 0, 0); PG8_STAGE(PG8_SA(1, 1), a1 + hstepA, voffA);
            PG8_WAIT_V(8); PG8_WAIT_L(0); PG8_BAR; PG8_MMA(0, 0, At, B0); PG8_MMA(0, 1, At, B1); PG8_BAR; PG8_SCHED;
            PG8_LDA(At, 0, 1); PG8_STAGE(PG8_SB(0, 0), b2, voffB); PG8_STAGE(PG8_SB(0, 1), b2 + hstepB, voffB); PG8_STAGE(PG8_SA(0, 0), a2, voffA);
            PG8_WAIT_V(8); PG8_WAIT_L(0); PG8_BAR; PG8_MMA(1, 0, At, B0); PG8_MMA(1, 1, At, B1); PG8_BAR; PG8_SCHED;
            PG8_LDB(B0, 1, 0); PG8_LDB(B1, 1, 1); PG8_SCHED; PG8_LDA(At, 1, 0); PG8_STAGE(PG8_SA(0, 1), a2 + hstepA, voffA);
            PG8_WAIT_V(8); PG8_WAIT_L(0); PG8_BAR; PG8_MMA(0, 0, At, B0); PG8_MMA(0, 1, At, B1); PG8_BAR; PG8_SCHED;
            PG8_LDA(At, 1, 1); PG8_STAGE(PG8_SB(1, 0), b3, voffB); PG8_STAGE(PG8_SB(1, 1), b3 + hstepB, voffB); PG8_STAGE(PG8_SA(1, 0), a3, voffA);
            PG8_WAIT_V(8); PG8_WAIT_L(0); PG8_BAR; PG8_MMA(1, 0, At, B0); PG8_MMA(1, 1, At, B1); PG8_BAR; PG8_SCHED;
        }
        if (wr == 0) PG8_BAR;
        E(acc, cur, wr, wc, fr, fq);
        if (!has_next) break;
#pragma unroll
        for (int a = 0; a < 2; ++a)
#pragma unroll
            for (int b = 0; b < 2; ++b)
#pragma unroll
                for (int m = 0; m < 4; ++m)
#pragma unroll
                    for (int n = 0; n < 2; ++n) acc[a][b][m][n] = (f32x4){0.f, 0.f, 0.f, 0.f};
        cur = nxt; cA = nA; cB = nB; ++ui;
        if (wr == 1) PG8_BAR;
    }
    PG8_WAIT_V(0);
    PG8_BAR;
#undef PG8_SA
#undef PG8_SB
#undef PG8_STAGE
#undef PG8_LDA
#undef PG8_LD8
#undef PG8_LO
#undef PG8_HI
#undef PG8_LDB
#undef PG8_MMA
#undef PG8_WAIT_V
#undef PG8_WAIT_L
#undef PG8_BAR
#undef PG8_SCHED
}

struct EpiBf16S {
    static constexpr bool PERM = true;
    bf16_t* O; int ldc; int ncol_tiles; const float* rowscale; float scale;
    __device__ __forceinline__ void operator()(const f32x4 (&acc)[2][2][4][2], const Unit& u, int wr, int wc, int fr, int fq) const {
        const int row0 = u.pm * BM + wr * 64 + fr, col0 = (u.pn % ncol_tiles) * BM + wc * 32 + 8 * fq;
        float rsv[2][4];
#pragma unroll
        for (int ai = 0; ai < 2; ++ai)
#pragma unroll
            for (int m = 0; m < 4; ++m) rsv[ai][m] = rowscale ? rowscale[(ptrdiff_t)u.ro + row0 + ai * HALF + m * 16] * scale : scale;
#pragma unroll
        for (int ai = 0; ai < 2; ++ai)
#pragma unroll
            for (int m = 0; m < 4; ++m) { const int row = row0 + ai * HALF + m * 16; const unsigned ob = (unsigned)(row * ldc + col0) * 2u; const float rs = rsv[ai][m];
#pragma unroll
                for (int bj = 0; bj < 2; ++bj) { const f32x4 v0 = acc[ai][bj][m][0] * rs, v1 = acc[ai][bj][m][1] * rs;
                    u32x4 w; w.x = pk_bf16(v0[0], v0[1]); w.y = pk_bf16(v0[2], v0[3]); w.z = pk_bf16(v1[0], v1[1]); w.w = pk_bf16(v1[2], v1[3]);
                    st_pl(O, ob + bj * HALF * 2, w); } }
    }
};
struct EpiBf16 {
    static constexpr bool PERM = true;
    bf16_t* O; int ldc;
    __device__ __forceinline__ void operator()(const f32x4 (&acc)[2][2][4][2], const Unit& u, int wr, int wc, int fr, int fq) const {
        const int row0 = u.pm * BM + wr * 64 + fr, col0 = u.pn * BM + wc * 32 + 8 * fq;
#pragma unroll
        for (int ai = 0; ai < 2; ++ai)
#pragma unroll
            for (int m = 0; m < 4; ++m) { bf16_t* rowp = O + (size_t)(row0 + ai * HALF + m * 16) * ldc + col0;
#pragma unroll
                for (int bj = 0; bj < 2; ++bj) { const f32x4 v0 = acc[ai][bj][m][0], v1 = acc[ai][bj][m][1];
                    u32x4 w; w.x = pk_bf16(v0[0], v0[1]); w.y = pk_bf16(v0[2], v0[3]); w.z = pk_bf16(v1[0], v1[1]); w.w = pk_bf16(v1[2], v1[3]);
                    *(u32x4*)(rowp + bj * HALF) = w; } }
    }
};
template <int NS> struct EpiBf16N {
    static constexpr bool PERM = true;
    bf16_t* O; int ldc; const float* ssq; float invn;
    __device__ __forceinline__ void operator()(const f32x4 (&acc)[2][2][4][2], const Unit& u, int wr, int wc, int fr, int fq) const {
        const int row0 = u.pm * BM + wr * 64 + fr, col0 = u.pn * BM + wc * 32 + 8 * fq;
        float rsv[2][4];
#pragma unroll
        for (int ai = 0; ai < 2; ++ai)
#pragma unroll
            for (int m = 0; m < 4; ++m) { const float* sp = ssq + (size_t)(row0 + ai * HALF + m * 16) * 16; const f32x4 a = *(const f32x4*)sp; float t = (a[0] + a[1]) + (a[2] + a[3]);
                if (NS == 8) { const f32x4 b = *(const f32x4*)(sp + 4); t += (b[0] + b[1]) + (b[2] + b[3]); }
                rsv[ai][m] = rsqrtf(t * invn + EPSN); }
#pragma unroll
        for (int ai = 0; ai < 2; ++ai)
#pragma unroll
            for (int m = 0; m < 4; ++m) { const unsigned ob = (unsigned)((row0 + ai * HALF + m * 16) * ldc + col0) * 2u; const float rs = rsv[ai][m];
#pragma unroll
                for (int bj = 0; bj < 2; ++bj) { const f32x4 v0 = acc[ai][bj][m][0] * rs, v1 = acc[ai][bj][m][1] * rs;
                    u32x4 w; w.x = pk_bf16(v0[0], v0[1]); w.y = pk_bf16(v0[2], v0[3]); w.z = pk_bf16(v1[0], v1[1]); w.w = pk_bf16(v1[2], v1[3]);
                    st_pl(O, ob + bj * HALF * 2, w); } }
    }
};
template <bool OUT8> struct EpiSwiGLU {
    static constexpr bool PERM = true;
    unsigned char* O; int ldc; int ncol_tiles; const float* rowscale; const float* colscale;
    __device__ __forceinline__ void operator()(const f32x4 (&acc)[2][2][4][2], const Unit& u, int wr, int wc, int fr, int fq) const {
        const int row0 = u.pm * BM + wr * 64 + fr, col0 = (u.pn % ncol_tiles) * HALF + wc * 32 + 8 * fq;
        const float cg = colscale[(size_t)u.pn * BM + wc * 32], cu = colscale[(size_t)u.pn * BM + HALF + wc * 32];
        const float cgl = cg * (-LOG2E), cgu = cg * cu;
        float rsv[2][4];
#pragma unroll
        for (int ai = 0; ai < 2; ++ai)
#pragma unroll
            for (int m = 0; m < 4; ++m) rsv[ai][m] = rowscale[(ptrdiff_t)u.ro + row0 + ai * HALF + m * 16];
#pragma unroll
        for (int ai = 0; ai < 2; ++ai)
#pragma unroll
            for (int m = 0; m < 4; ++m) { const int row = row0 + ai * HALF + m * 16; const unsigned ob = (unsigned)(row * ldc + col0) * (OUT8 ? 1u : 2u);
                const float rs = rsv[ai][m], kt = rs * cgl, iko = fast_rcp((rs * rs) * cgu);
                const v4i32 ig0 = __builtin_bit_cast(v4i32, acc[ai][0][m][0]), ig1 = __builtin_bit_cast(v4i32, acc[ai][0][m][1]), iu0 = __builtin_bit_cast(v4i32, acc[ai][1][m][0]), iu1 = __builtin_bit_cast(v4i32, acc[ai][1][m][1]);
                f32x2 g[4], uu[4], e[4], a[4];
#pragma unroll
                for (int k = 0; k < 2; ++k) { g[k] = (f32x2){(float)ig0[2 * k], (float)ig0[2 * k + 1]}; g[2 + k] = (f32x2){(float)ig1[2 * k], (float)ig1[2 * k + 1]}; uu[k] = (f32x2){(float)iu0[2 * k], (float)iu0[2 * k + 1]}; uu[2 + k] = (f32x2){(float)iu1[2 * k], (float)iu1[2 * k + 1]}; }
#pragma unroll
                for (int k = 0; k < 4; ++k) e[k] = g[k] * kt;
#pragma unroll
                for (int k = 0; k < 4; ++k) { e[k].x = fast_exp2(e[k].x); e[k].y = fast_exp2(e[k].y); }
#pragma unroll
                for (int k = 0; k < 4; ++k) a[k] = g[k] * uu[k];
#pragma unroll
                for (int k = 0; k < 4; ++k) e[k] = e[k] * iko + iko;
#pragma unroll
                for (int k = 0; k < 4; ++k) { e[k].x = fast_rcp(e[k].x); e[k].y = fast_rcp(e[k].y); }
#pragma unroll
                for (int k = 0; k < 4; ++k) a[k] = a[k] * e[k];
                if (OUT8) { u32x2 w; w.x = pk_fp8x4(a[0].x, a[0].y, a[1].x, a[1].y); w.y = pk_fp8x4(a[2].x, a[2].y, a[3].x, a[3].y); st_pl(O, ob, w); }
                else { u32x4 w; w.x = pk_bf16(a[0].x, a[0].y); w.y = pk_bf16(a[1].x, a[1].y); w.z = pk_bf16(a[2].x, a[2].y); w.w = pk_bf16(a[3].x, a[3].y); st_pl(O, ob, w); } }
    }
};
template <int MODE> struct EpiRope {
    static constexpr bool PERM = false;
    bf16_t* O; int ldc; const float* tab;
    const float* rowscale; const float* colscale;
    float* ssq;
    __device__ __forceinline__ static int kind(int gi) {
        if (MODE == 0) return (gi >= 48 && gi < 68) ? 1 + (gi & 1) : 0;
        if (MODE == 1) return gi == 12 ? 3 : ((gi >= 16 && gi < 48) ? 1 + (gi & 1) : 0);
        return (gi == 2 || gi == 5 || gi == 8 || gi == 11 || gi == 14 || gi == 17 || gi == 20 || gi == 23) ? 3 : 0;
    }
    __device__ __forceinline__ void operator()(const f32x4 (&acc)[2][2][4][2], const Unit& u, int wr, int wc, int fr, int fq) const {
        const int row0 = u.pm * BM + wr * 64 + fr;
        const bool lat = u.pm < (MLAT / BM);
        float rsv[2][4];
#pragma unroll
        for (int ai = 0; ai < 2; ++ai)
#pragma unroll
            for (int m = 0; m < 4; ++m) rsv[ai][m] = rowscale[(ptrdiff_t)u.ro + row0 + ai * HALF + m * 16];
#pragma unroll
        for (int bj = 0; bj < 2; ++bj) {
            const int gi = u.pn * 8 + bj * 4 + wc; const int kd = lat ? kind(gi) : 0;
            const int col0 = gi * 32 + 4 * fq;
            const f32x4 cs1 = *(const f32x4*)(colscale + col0), cs2 = *(const f32x4*)(colscale + col0 + 16);
#pragma unroll
            for (int ai = 0; ai < 2; ++ai)
#pragma unroll
                for (int m = 0; m < 4; ++m) {
                    const int row = row0 + ai * HALF + m * 16; const unsigned ob = (unsigned)(row * ldc + col0) * 2u;
                    const float rsc = rsv[ai][m]; const v4i32 i1 = __builtin_bit_cast(v4i32, acc[ai][bj][m][0]), i2 = __builtin_bit_cast(v4i32, acc[ai][bj][m][1]);
                    f32x4 x1, x2;
#pragma unroll
                    for (int k = 0; k < 4; ++k) { x1[k] = (float)i1[k] * (rsc * cs1[k]); x2[k] = (float)i2[k] * (rsc * cs2[k]); }
                    if (kd != 0) {
                        const int s = row & (SEQ - 1), gr = s >> 6, gc = s & 63;
                        f32x4 cs, sn;
                        if (kd == 3) { const int pos = fq < 2 ? gr : gc; cs = *(const f32x4*)(tab + 2048 + pos * 8 + 4 * (fq & 1)); sn = *(const f32x4*)(tab + 2048 + 512 + pos * 8 + 4 * (fq & 1)); }
                        else { const int pos = kd == 1 ? gr : gc; cs = *(const f32x4*)(tab + pos * 16 + 4 * fq); sn = *(const f32x4*)(tab + 1024 + pos * 16 + 4 * fq); }
                        const f32x4 o1 = x1 * cs - x2 * sn, o2 = x2 * cs + x1 * sn; x1 = o1; x2 = o2;
                    }
                    u32x2 w0, w1; w0.x = pk_bf16(x1[0], x1[1]); w0.y = pk_bf16(x1[2], x1[3]); w1.x = pk_bf16(x2[0], x2[1]); w1.y = pk_bf16(x2[2], x2[3]);
                    if (MODE == 1 && (u.pn == 0 || (u.pn == 1 && bj == 0))) {
                        float ss = bf_lo(w0.x) * bf_lo(w0.x) + bf_hi(w0.x) * bf_hi(w0.x) + bf_lo(w0.y) * bf_lo(w0.y) + bf_hi(w0.y) * bf_hi(w0.y) + bf_lo(w1.x) * bf_lo(w1.x) + bf_hi(w1.x) * bf_hi(w1.x) + bf_lo(w1.y) * bf_lo(w1.y) + bf_hi(w1.y) * bf_hi(w1.y);
                        { const auto rr = __builtin_amdgcn_permlane16_swap(__float_as_uint(ss), __float_as_uint(ss), false, false); ss = __uint_as_float(rr[0]) + __uint_as_float(rr[1]); }
                        { const auto rr = __builtin_amdgcn_permlane32_swap(__float_as_uint(ss), __float_as_uint(ss), false, false); ss = __uint_as_float(rr[0]) + __uint_as_float(rr[1]); }
                        if (fq == 0) ssq[(size_t)row * 16 + (u.pn == 0 ? bj * 4 + wc : 8 + wc)] = ss;
                    }
                    { const auto r = __builtin_amdgcn_permlane16_swap(w0.x, w1.x, false, false); w0.x = r[0]; w1.x = r[1]; }
                    { const auto r = __builtin_amdgcn_permlane16_swap(w0.y, w1.y, false, false); w0.y = r[0]; w1.y = r[1]; }
                    st_pl(O, ob + ((fq & 1) ? 24u : 0u), (u32x4){w0.x, w0.y, w1.x, w1.y});
                    asm volatile("" ::: "memory");
                }
        }
    }
};
}

__device__ __forceinline__ unsigned char* fresh_ws() {
    static_assert(offsetof(Params, ws) == 200, "Params layout");
    unsigned long long w; const unsigned long long ka = (unsigned long long)__builtin_amdgcn_kernarg_segment_ptr();
    asm volatile("s_load_dwordx2 %0, %1, 0xc8\n\ts_waitcnt lgkmcnt(0)" : "=s"(w) : "s"(ka) : "memory");
    return (unsigned char*)(__attribute__((address_space(1))) unsigned char*)w;
}
__device__ __forceinline__ int rope_orig(int p) { return p < 8 ? p : (p < 16 ? 16 + (p - 8) : (p < 24 ? 8 + (p - 16) : p)); }

struct ConvJob { const float* src; bf16_t* dst; const float* scale; int Ksrc, Nsrc, Kdst, nb, kb, map, f8; };
constexpr float W8_SCALE = 64.0f;
constexpr int CJ_NMAT[10]  = {0, 2, 0, 2, 2, 2, 0, 2, 0, 16};
constexpr int CJ_NB[10]    = {18, 8, 16, 6, 8, 8, 44, 8, 56, 8};
constexpr int CJ_KB[10]    = {16, 16, 16, 4, 4, 16, 16, FFN_DOWN_FP8 ? 22 : 44, 16, FFN_DOWN_FP8 ? 28 : 56};
__device__ __forceinline__ int conv_tiles(int j) { return CJ_NMAT[j] * CJ_NB[j] * CJ_KB[j]; }
constexpr int conv_tiles_total() { int s = 0; for (int j = 0; j < 10; ++j) s += CJ_NMAT[j] * CJ_NB[j] * CJ_KB[j]; return s; }
__device__ __forceinline__ int conv_map(int map, int n) {
    switch (map) {
    case 0: return n;
    case 1:
        if (n < 256) return n; if (n < 384) return 768 + (n - 256); if (n < 416) return 896 + rope_orig(n - 384); if (n < 512) return -1;
        if (n < 1024) return 256 + (n - 512); if (n < 1536) return 928 + (n - 1024); return 1440 + (n - 1536);
    case 2: { const int h = n / 96, j = n % 96; return j < 64 ? n : h * 96 + 64 + rope_orig(j - 64); }
    case 3: { const int t = n >> 8, r = n & 255; return r < 128 ? t * 128 + r : FFD + t * 128 + (r - 128); }
    default: { const int t = n >> 8, r = n & 255; return r < 128 ? t * 128 + r : FFE + t * 128 + (r - 128); }
    }
}
__device__ __forceinline__ ConvJob conv_job(const Params& p, unsigned char* ws, int j, int mat) {
    ConvJob c; c.scale = nullptr; c.map = 0; c.nb = CJ_NB[j]; c.kb = CJ_KB[j]; c.f8 = FFN_DOWN_FP8 && (j == 7 || j == 9);
    switch (j) {
    case 0: c.src = p.in[7] + (size_t)mat * 1024 * EVEN_IN; c.dst = (bf16_t*)(ws + OFF_WINE + mat * SZ_WINE); c.Ksrc = 1024; c.Nsrc = EVEN_IN; c.Kdst = 1024; break;
    case 1: c.src = p.in[10] + (size_t)mat * 1024 * 1024; c.dst = (bf16_t*)(ws + OFF_WOUTE + mat * SZ_WOUT); c.Ksrc = 1024; c.Nsrc = 1024; c.Kdst = 1024; break;
    case 2: c.src = p.in[11] + (size_t)mat * 1024 * 1952; c.dst = (bf16_t*)(ws + OFF_WINO + mat * SZ_WINO); c.Ksrc = 1024; c.Nsrc = 1952; c.Kdst = 1024; c.map = 1; break;
    case 3: c.src = p.in[14] + (size_t)mat * 256 * 768; c.dst = (bf16_t*)(ws + OFF_WQUP + mat * SZ_WQUP); c.Ksrc = 256; c.Nsrc = 768; c.Kdst = 256; c.map = 2; c.scale = p.in[12] + mat * 256; break;
    case 4: c.src = p.in[15] + (size_t)mat * 128 * 1024; c.dst = (bf16_t*)(ws + OFF_WKVUP + mat * SZ_WKVUP); c.Ksrc = 128; c.Nsrc = 1024; c.Kdst = 256; c.scale = p.in[13] + mat * 128; break;
    case 5: c.src = p.in[18] + (size_t)mat * 1024 * 1024; c.dst = (bf16_t*)(ws + OFF_WOUTO + mat * SZ_WOUT); c.Ksrc = 1024; c.Nsrc = 1024; c.Kdst = 1024; break;
    case 6: c.src = p.in[19] + (size_t)mat * 1024 * 2 * FFD; c.dst = (bf16_t*)(ws + OFF_WGU + mat * SZ_WGU); c.Ksrc = 1024; c.Nsrc = 2 * FFD; c.Kdst = 1024; c.map = 3; break;
    case 7: c.src = p.in[20] + (size_t)mat * FFD * 1024; c.dst = (bf16_t*)(ws + OFF_WDN + mat * SZ_WDN); c.Ksrc = FFD; c.Nsrc = 1024; c.Kdst = FFD; break;
    case 8: c.src = p.in[22] + (size_t)mat * 1024 * 2 * FFE; c.dst = (bf16_t*)(ws + OFF_WEGU + mat * (SZ_WEGU / 2)); c.Ksrc = 1024; c.Nsrc = 2 * FFE; c.Kdst = 1024; c.map = 4; break;
    default: c.src = p.in[23] + (size_t)mat * FFE * 1024; c.dst = (bf16_t*)(ws + OFF_WEDN + mat * (SZ_WEDN / (FFN_DOWN_FP8 ? 2 : 1))); c.Ksrc = FFE; c.Nsrc = 1024; c.Kdst = FFE; break;
    }
    return c;
}

constexpr int CV_NU_D = 2 * (2 * FFD / 64), CV_NU_IE = 2 * (EVEN_IN / 64), CV_NU_IO = 2 * (ODD_INP / 64), CV_NU_E = 16 * (2 * FFE / 64), CV_NU_PRO = CV_NU_D + CV_NU_IE + CV_NU_IO, CV_NU = CV_NU_PRO + CV_NU_E;
constexpr int TAIL_U_SPLIT = 560, TAIL_T_SPLIT = 1100;
constexpr int CV_NT = conv_tiles_total(), CV_NT_E = CJ_NMAT[9] * CJ_NB[9] * CJ_KB[9], CV_NT_PRO = CV_NT - CV_NT_E;
__device__ __forceinline__ void conv_units(const Params& p, LAS unsigned char* lds, const int tid, int lo, int hi, int first, int stride) {
    unsigned char* ws = fresh_ws();
    __syncthreads();
    {
        constexpr int WP = 2052;
        LAS unsigned char* wl = lds;
        LAS float* cmx = (LAS float*)(lds + 64 * WP);
        constexpr int NU_D = CV_NU_D, NU_E = CV_NU_E, NU_IE = CV_NU_IE, NU_IO = CV_NU_IO;
        const int cq = tid & 15, rg = tid >> 4, wvn = tid >> 6, col = tid >> 3, piece = tid & 7;
        struct U8 { const float* sp; unsigned char* dst; float* wsc; int Nsrc, ok, blk; };
        auto decode = [&](int u) -> U8 {
            const int cat = u < NU_D ? 0 : (u < NU_D + NU_IE ? 2 : (u < NU_D + NU_IE + NU_IO ? 3 : 1));
            const int uu = u - (cat == 0 ? 0 : (cat == 2 ? NU_D : (cat == 3 ? NU_D + NU_IE : NU_D + NU_IE + NU_IO)));
            const int Ndst = cat == 0 ? 2 * FFD : (cat == 1 ? 2 * FFE : (cat == 2 ? EVEN_IN : ODD_INP)), nbp = Ndst / 64, mat = uu / nbp, nbi = uu % nbp;
            U8 U; U.Nsrc = cat == 3 ? 1952 : Ndst;
            const float* src = (cat == 0 ? p.in[19] : (cat == 1 ? p.in[22] : (cat == 2 ? p.in[7] : p.in[11]))) + (size_t)mat * 1024 * U.Nsrc;
            unsigned char* dstb = cat == 0 ? ws + OFF_WGU + (size_t)mat * SZ_WGU : (cat == 1 ? ws + OFF_WEGU + (size_t)mat * (SZ_WEGU / 2) : (cat == 2 ? ws + OFF_WINE + (size_t)mat * SZ_WINE : ws + OFF_WINO + (size_t)mat * SZ_WINO));
            float* wscb = (cat == 0 ? (float*)(ws + OFF_WSCD) : (cat == 1 ? (float*)(ws + OFF_WSCE) : (cat == 2 ? (float*)(ws + OFF_WSCI) : (float*)(ws + OFF_WSCI) + 2 * EVEN_IN))) + (size_t)mat * Ndst;
            const int cmap = cat == 0 ? 3 : (cat == 1 ? 4 : (cat == 2 ? 0 : 1));
            const int sc = conv_map(cmap, nbi * 64 + cq * 4);
            U.blk = cat < 2; U.ok = sc >= 0; U.sp = src + (size_t)rg * U.Nsrc + (sc >= 0 ? sc : 0); U.dst = dstb + (size_t)(nbi * 64) * 1024; U.wsc = wscb + nbi * 64; return U; };
        auto ldg = [&](const float*& ptr, size_t step, int ok, f32x4 (&v)[8]) {
#pragma unroll
            for (int i = 0; i < 8; ++i) { v[i] = ok ? __builtin_nontemporal_load((const f32x4*)ptr) : (f32x4){0.f, 0.f, 0.f, 0.f}; ptr += step; } };
        auto consume = [&](int q, const f32x4 (&v)[8], f32x4& cm) {
#pragma unroll
            for (int i = 0; i < 8; ++i) { cm = __builtin_elementwise_max(cm, __builtin_elementwise_abs(v[i]));
                const unsigned w0 = pk_bf16(v[i][0], v[i][1]), w1 = pk_bf16(v[i][2], v[i][3]);
                LAS unsigned short* bp = (LAS unsigned short*)(wl + (cq * 4) * WP + ((q * 8 + i) * 32 + rg) * 2);
                bp[0] = (unsigned short)w0; bp[WP / 2] = (unsigned short)(w0 >> 16); bp[WP] = (unsigned short)w1; bp[3 * (WP / 2)] = (unsigned short)(w1 >> 16); } };
        int u = lo + first;
        if (u < hi) {
            U8 U = decode(u);
            f32x4 q0[8], q1[8], q2[8], q3[8];
            const float* lp = U.sp; size_t lstep = (size_t)32 * U.Nsrc; int lok = U.ok;
            ldg(lp, lstep, lok, q0); ldg(lp, lstep, lok, q1);
#pragma unroll 1
            for (;;) {
                const int un = u + stride; const bool hn = un < hi;
                U8 Un = U; if (hn) Un = decode(un);
                f32x4 cm = (f32x4){0.f, 0.f, 0.f, 0.f};
                ldg(lp, lstep, lok, q2); consume(0, q0, cm);
                ldg(lp, lstep, lok, q3); consume(1, q1, cm);
                lp = Un.sp; lstep = (size_t)32 * Un.Nsrc; lok = Un.ok;
                if (hn) ldg(lp, lstep, lok, q0);
                consume(2, q2, cm);
                if (hn) ldg(lp, lstep, lok, q1);
                consume(3, q3, cm);
#pragma unroll
                for (int c = 0; c < 4; ++c) { float v = cm[c];
                    { const auto rr = __builtin_amdgcn_permlane16_swap(__float_as_uint(v), __float_as_uint(v), false, false); v = fmaxf(__uint_as_float(rr[0]), __uint_as_float(rr[1])); }
                    { const auto rr = __builtin_amdgcn_permlane32_swap(__float_as_uint(v), __float_as_uint(v), false, false); v = fmaxf(__uint_as_float(rr[0]), __uint_as_float(rr[1])); }
                    cm[c] = v; }
                if ((tid & 63) < 16) *(LAS f32x4*)(cmx + wvn * 64 + cq * 4) = cm;
                __syncthreads();
                float mx = 0.f;
#pragma unroll
                for (int w = 0; w < 8; ++w) mx = fmaxf(mx, cmx[w * 64 + col]);
                if (U.blk) {
                    mx = wave_max(mx); if ((tid & 63) == 0) cmx[512 + wvn] = mx; __syncthreads();
#pragma unroll
                    for (int w = 0; w < 8; ++w) mx = fmaxf(mx, cmx[512 + w]);
                }
                mx = mx > 0.f ? mx : 1.0f;
                const float inv = 127.0f / mx;
                if (piece == 0) U.wsc[col] = mx * (1.0f / 127.0f);
#pragma unroll 2
                for (int it = 0; it < 8; ++it) {
                    const int k0 = it * 128 + piece * 16;
                    const LAS unsigned* rp = (const LAS unsigned*)(wl + col * WP + k0 * 2);
                    unsigned w[8];
#pragma unroll
                    for (int j = 0; j < 8; ++j) w[j] = rp[j];
                    u32x4 o;
#pragma unroll
                    for (int j = 0; j < 4; ++j) o[j] = pk_i8x4(bf_lo(w[2 * j]) * inv, bf_hi(w[2 * j]) * inv, bf_lo(w[2 * j + 1]) * inv, bf_hi(w[2 * j + 1]) * inv);
                    *(u32x4*)(U.dst + (size_t)col * 1024 + k0) = o;
                }
                __syncthreads();
                if (!hn) break;
                U = Un; u = un;
            }
        }
    }
    __syncthreads();
}

__device__ __forceinline__ void conv_tiles_run(const Params& p, LAS unsigned char* lds, const int tid, int lo, int hi, int first, int stride) {
    unsigned char* ws = fresh_ws();
    const int ng = tid & 31, kgq = tid >> 5;
    const int orow = tid >> 2, oq = tid & 3;
    {
        __syncthreads();
        struct TileRef { ConvJob c; int nbi, kbi; };
        auto decode = [&](int t) -> TileRef {
            int j = 0, rem = t;
#pragma unroll 1
            for (; j < 9; ++j) { const int n = conv_tiles(j); if (rem < n) break; rem -= n; }
            const int per = CJ_NB[j] * CJ_KB[j], mat = rem / per, r2 = rem % per;
            TileRef T; T.c = conv_job(p, ws, j, mat); T.kbi = r2 / T.c.nb; T.nbi = r2 % T.c.nb; return T; };
        auto issue = [&](const TileRef& T, f32x4 (&v)[8], float (&ks)[8]) {
            const int n0 = T.nbi * 128 + ng * 4, k0 = T.kbi * (T.c.f8 ? 128 : 64) + kgq * 4, sc = conv_map(T.c.map, n0);
#pragma unroll
            for (int r = 0; r < 8; ++r) { const int k = k0 + (r >> 2) * 64 + (r & 3);
                if ((r < 4 || T.c.f8) && sc >= 0 && k < T.c.Ksrc) { v[r] = __builtin_nontemporal_load((const f32x4*)(T.c.src + (size_t)k * T.c.Nsrc + sc)); ks[r] = T.c.scale ? T.c.scale[k] : 1.0f; } else { v[r] = (f32x4){0.f, 0.f, 0.f, 0.f}; ks[r] = 0.f; } } };
        auto finish = [&](const TileRef& T, const f32x4 (&v)[8], const float (&ks)[8], int buf) {
            LAS unsigned char* tl = lds + buf * 32768;
            if (T.c.f8) {
#pragma unroll
                for (int h = 0; h < 2; ++h)
#pragma unroll
                    for (int cc = 0; cc < 4; ++cc) *(LAS unsigned*)(tl + (ng * 4 + cc) * 144 + h * 64 + kgq * 4) = pk_fp8x4(v[4 * h][cc] * (ks[4 * h] * W8_SCALE), v[4 * h + 1][cc] * (ks[4 * h + 1] * W8_SCALE), v[4 * h + 2][cc] * (ks[4 * h + 2] * W8_SCALE), v[4 * h + 3][cc] * (ks[4 * h + 3] * W8_SCALE));
                __syncthreads();
                unsigned char* dp = (unsigned char*)T.c.dst + (size_t)(T.nbi * 128 + orow) * T.c.Kdst + T.kbi * 128 + oq * 32;
                *(u32x4*)dp = *(const LAS u32x4*)(tl + orow * 144 + oq * 32); *(u32x4*)(dp + 16) = *(const LAS u32x4*)(tl + orow * 144 + oq * 32 + 16);
            } else {
#pragma unroll
                for (int cc = 0; cc < 4; ++cc) { u32x2 w; w.x = pk_bf16(v[0][cc] * ks[0], v[1][cc] * ks[1]); w.y = pk_bf16(v[2][cc] * ks[2], v[3][cc] * ks[3]); *(LAS u32x2*)(tl + (ng * 4 + cc) * 144 + kgq * 8) = w; }
                __syncthreads();
                bf16_t* dp = T.c.dst + (size_t)(T.nbi * 128 + orow) * T.c.Kdst + T.kbi * 64 + oq * 16;
                *(u32x4*)dp = *(const LAS u32x4*)(tl + orow * 144 + oq * 32); *(u32x4*)(dp + 8) = *(const LAS u32x4*)(tl + orow * 144 + oq * 32 + 16);
            } };
        int t = lo + first;
        if (t < hi) {
            TileRef TA = decode(t), TB = TA; f32x4 va[8], vb[8]; float sa[8], sb[8];
            issue(TA, va, sa);
#pragma unroll 1
            for (;;) {
                int tn = t + stride; bool hn = tn < hi;
                if (hn) { TB = decode(tn); issue(TB, vb, sb); }
                finish(TA, va, sa, 0);
                if (!hn) break;
                t = tn; tn = t + stride; hn = tn < hi;
                if (hn) { TA = decode(tn); issue(TA, va, sa); }
                finish(TB, vb, sb, 1);
                if (!hn) break;
                t = tn;
            }
        }
    }
    __syncthreads();
}

__device__ __forceinline__ void phase_prologue(const Params& p, const int wv, LAS unsigned char* lds) {
    const int tid = opaque_tid(wv);
    unsigned char* ws = p.ws;
    if (blockIdx.x == 0) {
        float* tab = (float*)(ws + OFF_TAB);
        for (int i = tid; i < 1024; i += NTHREADS) { const int pos = i >> 4, f = i & 15; const float inv = 1.0f / powf(10000.0f, (float)(2 * f) / 32.0f); const float ang = (float)pos * inv; tab[i] = cosf(ang); tab[1024 + i] = sinf(ang); }
        for (int i = tid; i < 512; i += NTHREADS) { const int pos = i >> 3, f = i & 7; const float inv = 1.0f / powf(10000.0f, (float)(2 * f) / 16.0f); const float ang = (float)pos * inv; tab[2048 + i] = cosf(ang); tab[2048 + 512 + i] = sinf(ang); }
    }
    {
        LAS float* sv = (LAS float*)lds;
        LAS float* red = (LAS float*)(lds + 36864);
        for (int i = tid; i < 9 * 1024; i += NTHREADS) { const int r = i >> 10, k = i & 1023; const float c = r < 8 ? p.in[1][r * 1024 + k] : p.in[3][k]; sv[i] = c / (1.0f + expf(-c)); }
        __syncthreads();
        for (int u = blockIdx.x; u < 384; u += gridDim.x) {
            const int layer = u / 96, cg = u % 96, cq = tid & 15, kg = tid >> 4;
            f32x4 acc[9];
#pragma unroll
            for (int r = 0; r < 9; ++r) acc[r] = (f32x4){0.f, 0.f, 0.f, 0.f};
            const float* wp = p.in[4] + ((size_t)layer * 1024 + kg * 32) * 6144 + cg * 64 + cq * 4;
#pragma unroll 8
            for (int kk = 0; kk < 32; ++kk) {
                const f32x4 w = __builtin_nontemporal_load((const f32x4*)(wp + (size_t)kk * 6144));
#pragma unroll
                for (int r = 0; r < 9; ++r) acc[r] += w * sv[r * 1024 + kg * 32 + kk];
            }
#pragma unroll
            for (int r = 0; r < 9; ++r) *(LAS f32x4*)(red + (kg * 9 + r) * 64 + cq * 4) = acc[r];
            __syncthreads();
            float* mod = (float*)(ws + OFF_MOD);
            for (int i = tid; i < 9 * 64; i += NTHREADS) { const int r = i >> 6, cc = i & 63; float sacc = 0.f;
#pragma unroll
                for (int g = 0; g < 32; ++g) sacc += red[(g * 9 + r) * 64 + cc];
                mod[((size_t)layer * 9 + r) * 6144 + cg * 64 + cc] = sacc + p.in[5][layer * 6144 + cg * 64 + cc]; }
            __syncthreads();
        }
    }
    conv_units(p, lds, tid, 0, CV_NU_PRO, (int)((blockIdx.x + (gridDim.x >> 1)) % gridDim.x), (int)gridDim.x);
    conv_tiles_run(p, lds, tid, 0, CV_NT_PRO, (int)(gridDim.x - 1 - blockIdx.x), (int)gridDim.x);
}

__device__ __forceinline__ void ld16(const float* p, int lane, float (&v)[16]) {
#pragma unroll
    for (int j = 0; j < 2; ++j) { const f32x4 a = *(const f32x4*)(p + 8 * lane + 512 * j), b = *(const f32x4*)(p + 8 * lane + 512 * j + 4);
        v[8 * j] = a[0]; v[8 * j + 1] = a[1]; v[8 * j + 2] = a[2]; v[8 * j + 3] = a[3]; v[8 * j + 4] = b[0]; v[8 * j + 5] = b[1]; v[8 * j + 6] = b[2]; v[8 * j + 7] = b[3]; }
}
__device__ __forceinline__ void ld16_nt(const float* p, int lane, float (&v)[16]) {
#pragma unroll
    for (int j = 0; j < 2; ++j) { const f32x4 a = __builtin_nontemporal_load((const f32x4*)(p + 8 * lane + 512 * j)), b = __builtin_nontemporal_load((const f32x4*)(p + 8 * lane + 512 * j + 4));
        v[8 * j] = a[0]; v[8 * j + 1] = a[1]; v[8 * j + 2] = a[2]; v[8 * j + 3] = a[3]; v[8 * j + 4] = b[0]; v[8 * j + 5] = b[1]; v[8 * j + 6] = b[2]; v[8 * j + 7] = b[3]; }
}
__device__ __forceinline__ void st16_f32_nt(float* p, int lane, const float (&v)[16]) {
#pragma unroll
    for (int j = 0; j < 2; ++j) { __builtin_nontemporal_store((f32x4){v[8 * j], v[8 * j + 1], v[8 * j + 2], v[8 * j + 3]}, (f32x4*)(p + 8 * lane + 512 * j)); __builtin_nontemporal_store((f32x4){v[8 * j + 4], v[8 * j + 5], v[8 * j + 6], v[8 * j + 7]}, (f32x4*)(p + 8 * lane + 512 * j + 4)); }
}
__device__ __forceinline__ void ld16_bf16(const bf16_t* p, int lane, float (&v)[16]) {
#pragma unroll
    for (int j = 0; j < 2; ++j) { const u32x4 w = *(const u32x4*)(p + 8 * lane + 512 * j);
#pragma unroll
        for (int k = 0; k < 4; ++k) { v[8 * j + 2 * k] = bf_lo(w[k]); v[8 * j + 2 * k + 1] = bf_hi(w[k]); } }
}
__device__ __forceinline__ void st16_f32(float* p, int lane, const float (&v)[16]) {
#pragma unroll
    for (int j = 0; j < 2; ++j) { *(f32x4*)(p + 8 * lane + 512 * j) = (f32x4){v[8 * j], v[8 * j + 1], v[8 * j + 2], v[8 * j + 3]}; *(f32x4*)(p + 8 * lane + 512 * j + 4) = (f32x4){v[8 * j + 4], v[8 * j + 5], v[8 * j + 6], v[8 * j + 7]}; }
}
__device__ __forceinline__ void st16_bf16_wt(bf16_t* base, int row, int lane, const float (&v)[16]) {
#pragma unroll
    for (int j = 0; j < 2; ++j) { u32x4 w; w.x = pk_bf16(v[8 * j], v[8 * j + 1]); w.y = pk_bf16(v[8 * j + 2], v[8 * j + 3]); w.z = pk_bf16(v[8 * j + 4], v[8 * j + 5]); w.w = pk_bf16(v[8 * j + 6], v[8 * j + 7]); st_wt(base, (unsigned)(row * DM + 8 * lane + 512 * j) * 2u, w); }
}
__device__ __forceinline__ void st16_bf16(bf16_t* p, int lane, const float (&v)[16]) {
#pragma unroll
    for (int j = 0; j < 2; ++j) { u32x4 w; w.x = pk_bf16(v[8 * j], v[8 * j + 1]); w.y = pk_bf16(v[8 * j + 2], v[8 * j + 3]); w.z = pk_bf16(v[8 * j + 4], v[8 * j + 5]); w.w = pk_bf16(v[8 * j + 6], v[8 * j + 7]); *(u32x4*)(p + 8 * lane + 512 * j) = w; }
}
__device__ __forceinline__ float st16_i8_lds(LAS unsigned char* p, int lane, const float (&v)[16]) {
    float mx = 0.f;
#pragma unroll
    for (int k = 0; k < 16; ++k) mx = fmaxf(mx, fabsf(v[k]));
    mx = wave_max(mx); mx = mx > 0.f ? mx : 1.0f;
    const float inv = 127.0f / mx;
#pragma unroll
    for (int j = 0; j < 2; ++j) { u32x2 w; w.x = pk_i8x4(v[8 * j] * inv, v[8 * j + 1] * inv, v[8 * j + 2] * inv, v[8 * j + 3] * inv); w.y = pk_i8x4(v[8 * j + 4] * inv, v[8 * j + 5] * inv, v[8 * j + 6] * inv, v[8 * j + 7] * inv);
        *(LAS u32x2*)(p + 8 * lane + 512 * j) = w; }
    return mx * (1.0f / 127.0f);
}
__device__ __forceinline__ float st16_i8_wt(unsigned char* base, int row, int lane, const float (&v)[16]) {
    float mx = 0.f;
#pragma unroll
    for (int k = 0; k < 16; ++k) mx = fmaxf(mx, fabsf(v[k]));
    mx = wave_max(mx); mx = mx > 0.f ? mx : 1.0f;
    const float inv = 127.0f / mx;
#pragma unroll
    for (int j = 0; j < 2; ++j) { u32x2 w; w.x = pk_i8x4(v[8 * j] * inv, v[8 * j + 1] * inv, v[8 * j + 2] * inv, v[8 * j + 3] * inv); w.y = pk_i8x4(v[8 * j + 4] * inv, v[8 * j + 5] * inv, v[8 * j + 6] * inv, v[8 * j + 7] * inv);
        st_wt(base, (unsigned)(row * DM + 8 * lane + 512 * j), w); }
    return mx * (1.0f / 127.0f);
}
__device__ __forceinline__ float st16_i8(unsigned char* p, int lane, const float (&v)[16]) {
    float mx = 0.f;
#pragma unroll
    for (int k = 0; k < 16; ++k) mx = fmaxf(mx, fabsf(v[k]));
    mx = wave_max(mx); mx = mx > 0.f ? mx : 1.0f;
    const float inv = 127.0f / mx;
#pragma unroll
    for (int j = 0; j < 2; ++j) { u32x2 w; w.x = pk_i8x4(v[8 * j] * inv, v[8 * j + 1] * inv, v[8 * j + 2] * inv, v[8 * j + 3] * inv); w.y = pk_i8x4(v[8 * j + 4] * inv, v[8 * j + 5] * inv, v[8 * j + 6] * inv, v[8 * j + 7] * inv);
        *(u32x2*)(p + 8 * lane + 512 * j) = w; }
    return mx * (1.0f / 127.0f);
}
__device__ __forceinline__ float sumsq16(const float (&v)[16]) { float s = 0.f;
#pragma unroll
    for (int i = 0; i < 16; ++i) s += v[i] * v[i];
    return wave_sum(s); }
__device__ __forceinline__ const float* modp(const Params& p, int layer, int bidx, int which) { return (const float*)(p.ws + OFF_MOD) + (((size_t)layer * 9 + bidx) * 6 + which) * 1024; }
__device__ __forceinline__ const float* xin_row(const Params& p, int row) { return row < MLAT ? p.in[0] + (size_t)row * DM : p.in[2] + (size_t)(row - MLAT) * DM; }
__device__ __forceinline__ int row_bidx(int row) { return row < MLAT ? (row >> 12) : 8; }

__device__ __forceinline__ void phase_h0(const Params& p, const int wv) {
    const int tid = opaque_tid(wv), lane = tid & 63, wave = tid >> 6;
    bf16_t* abuf = (bf16_t*)(p.ws + OFF_ABUF);
    float gs[16], sh[16];
    int cur = -1;
    const int row0 = blockIdx.x * ROWS_PER_BLOCK + wave;
    constexpr int NI = ROWS_PER_BLOCK / NWAVES;
    float Xb[3][16];
    auto step = [&](int i, float (&x)[16], float (&xn2)[16]) -> bool {
        if (i >= NI) return false;
        const int row = row0 + NWAVES * i, bidx = row_bidx(row);
        if (i + 2 < NI) ld16_nt(xin_row(p, row + 2 * NWAVES), lane, xn2);
        if (bidx != cur) { cur = bidx; float t[16]; ld16(modp(p, 0, bidx, 1), lane, gs); ld16(p.in[6], lane, t);
#pragma unroll
            for (int k = 0; k < 16; ++k) gs[k] = t[k] * (1.0f + gs[k]);
            ld16(modp(p, 0, bidx, 0), lane, sh); }
        const float rstd = rsqrtf(sumsq16(x) * (1.0f / DM) + EPSN);
#pragma unroll
        for (int k = 0; k < 16; ++k) x[k] = x[k] * rstd * gs[k] + sh[k];
        { const float fs = st16_i8_wt((unsigned char*)abuf, row, lane, x); if (lane == 0) ((float*)(p.ws + OFF_FSC))[row] = fs; }
        return true;
    };
    ld16_nt(xin_row(p, row0), lane, Xb[0]); ld16_nt(xin_row(p, row0 + NWAVES), lane, Xb[1]);
#pragma unroll 1
    for (int i = 0; i < NI; i += 3) {
        if (!step(i, Xb[0], Xb[2])) break;
        if (!step(i + 1, Xb[1], Xb[0])) break;
        if (!step(i + 2, Xb[2], Xb[1])) break;
    }
}

template <bool ODD>
__device__ __forceinline__ void phase_rowB(const Params& p, const int wv, LAS unsigned char* lds, int layer, const bf16_t* Y, int nrows, bool dummy = false) {
    const int tid = opaque_tid(wv), lane = tid & 63, wave = tid >> 6;
    const bf16_t* xs_in = (const bf16_t*)(p.ws + OFF_XS); bf16_t* xs = (bf16_t*)(p.ws + (dummy ? WS_END : OFF_XS)); bf16_t* abuf = (bf16_t*)(p.ws + (dummy ? WS_END + (size_t)MTOT * DM * 4 : OFF_ABUF));
    const float* ng = p.in[6] + (size_t)layer * 4 * DM;
    float mg1[16], gs2[16], m3[16];
    LAS float* wrt = (LAS float*)lds;
    LAS int* lcnt = (LAS int*)(lds + 32768);
    LAS int* lbase = (LAS int*)(lds + 32768 + 64);
    LAS int* rinfo = (LAS int*)(lds + 32768 + 128);
    LAS float* rwt = (LAS float*)(lds + 32768 + 128 + ROWS_PER_BLOCK * 16);
    LAS unsigned char* stash = lds + 40960;
    if (ODD) {
        const float* wr = p.in[21] + (size_t)(layer >> 1) * DM * NEXP;
        for (int i = tid; i < DM * NEXP; i += NTHREADS) wrt[i] = wr[i];
        if (tid < 8) lcnt[tid] = 0;
        __syncthreads();
    }
    int cur = -1;
    const int row0 = blockIdx.x * ROWS_PER_BLOCK + wave;
    constexpr int NI = ROWS_PER_BLOCK / NWAVES;
    float Yb[3][16], Xb[3][16];
    auto issue = [&](int row, float (&yy)[16], float (&xx)[16]) { ld16_bf16(Y + (size_t)row * DM, lane, yy); if (layer == 0) ld16_nt(xin_row(p, row), lane, xx); else ld16_bf16(xs_in + (size_t)row * DM, lane, xx); };
    auto step = [&](int i, float (&y)[16], float (&x)[16], float (&yn2)[16], float (&xn2)[16]) -> bool {
        const int lrow = wave + NWAVES * i, row = row0 + NWAVES * i, bidx = row_bidx(row);
        if (i >= NI || row >= nrows) return false;
        if (i + 2 < NI && row + 2 * NWAVES < nrows) issue(row + 2 * NWAVES, yn2, xn2);
        if (bidx != cur) { cur = bidx; float t[16]; ld16(modp(p, layer, bidx, 2), lane, mg1); ld16(ng + DM, lane, t);
#pragma unroll
            for (int k = 0; k < 16; ++k) mg1[k] *= t[k];
            ld16(modp(p, layer, bidx, 4), lane, gs2); ld16(ng + 2 * DM, lane, t);
#pragma unroll
            for (int k = 0; k < 16; ++k) gs2[k] = t[k] * (1.0f + gs2[k]);
            ld16(modp(p, layer, bidx, 3), lane, m3); }
        const float rsy = rsqrtf(sumsq16(y) * (1.0f / DM) + EPSN);
#pragma unroll
        for (int k = 0; k < 16; ++k) x[k] = x[k] + mg1[k] * (y[k] * rsy);
        st16_bf16_wt(xs, row, lane, x);
        const float rs1 = rsqrtf(sumsq16(x) * (1.0f / DM) + EPSN);
#pragma unroll
        for (int k = 0; k < 16; ++k) y[k] = x[k] * rs1 * gs2[k] + m3[k];
        float fs;
        if (ODD) fs = st16_i8_lds(stash + (size_t)(i < 9 ? wave * 9 + i : wave * 8 + (i - 9)) * 1024, lane, y);
        else { fs = st16_i8_wt((unsigned char*)abuf, row, lane, y); if (lane == 0 && !dummy) ((float*)(p.ws + OFF_FSC))[row] = fs; }
        if (ODD) {
            float lg[8];
#pragma unroll
            for (int e = 0; e < 8; ++e) lg[e] = 0.f;
#pragma unroll
            for (int j = 0; j < 4; ++j)
#pragma unroll
                for (int q = 0; q < 4; ++q) { const int col = 8 * lane + 512 * (j >> 1) + 4 * (j & 1) + q; const f32x4 wa = *(const LAS f32x4*)(wrt + col * 8), wb = *(const LAS f32x4*)(wrt + col * 8 + 4); const float f = y[4 * j + q];
                    lg[0] += f * wa[0]; lg[1] += f * wa[1]; lg[2] += f * wa[2]; lg[3] += f * wa[3]; lg[4] += f * wb[0]; lg[5] += f * wb[1]; lg[6] += f * wb[2]; lg[7] += f * wb[3]; }
#pragma unroll
            for (int e = 0; e < 8; ++e) lg[e] = wave_sum(lg[e]);
            int e0 = 0; float l0 = lg[0];
#pragma unroll
            for (int e = 1; e < 8; ++e) if (lg[e] > l0) { l0 = lg[e]; e0 = e; }
            int e1 = e0 == 0 ? 1 : 0; float l1 = -INFINITY;
#pragma unroll
            for (int e = 0; e < 8; ++e) if (e != e0 && lg[e] > l1) { l1 = lg[e]; e1 = e; }
            if (lane == 0) {
                const float w1 = 1.0f / (1.0f + expf(l0 - l1)), w0 = 1.0f - w1;
                const int i0 = __hip_atomic_fetch_add(lcnt + e0, 1, __ATOMIC_RELAXED, __HIP_MEMORY_SCOPE_WORKGROUP);
                const int i1 = __hip_atomic_fetch_add(lcnt + e1, 1, __ATOMIC_RELAXED, __HIP_MEMORY_SCOPE_WORKGROUP);
                rinfo[lrow * 4 + 0] = e0; rinfo[lrow * 4 + 1] = e1; rinfo[lrow * 4 + 2] = i0; rinfo[lrow * 4 + 3] = i1; rwt[lrow * 3] = w0; rwt[lrow * 3 + 1] = w1; rwt[lrow * 3 + 2] = fs;
            }
        }
        return true;
    };
    auto flush = [&](int i_lo, int i_hi) {
        __syncthreads();
        unsigned* cnt = (unsigned*)(p.ws + OFF_CTL) + CW_MOECNT + (layer >> 1) * 64;
        if (tid < 8) lbase[tid] = (int)__hip_atomic_fetch_add(cnt + tid, (unsigned)lcnt[tid], __ATOMIC_RELAXED, __HIP_MEMORY_SCOPE_AGENT);
        __syncthreads();
        int* slot = (int*)(p.ws + OFF_SLOT); float* twt = (float*)(p.ws + OFF_TWT); float* tsc = (float*)(p.ws + OFF_GWT); unsigned char* gbuf = p.ws + OFF_GBUF;
        for (int i = i_lo; i < i_hi; ++i) {
            const int lrow = wave + NWAVES * i, row = row0 + NWAVES * i;
            if (row >= nrows) break;
            const int e0 = rinfo[lrow * 4], e1 = rinfo[lrow * 4 + 1], s0 = lbase[e0] + rinfo[lrow * 4 + 2], s1 = lbase[e1] + rinfo[lrow * 4 + 3];
            const u32x4 v = *(const LAS u32x4*)(stash + (size_t)(i < 9 ? wave * 9 + i : wave * 8 + (i - 9)) * 1024 + lane * 16);
            st_wt(gbuf, (unsigned)((e0 * CAPR + s0) * 1024 + lane * 16), v);
            st_wt(gbuf, (unsigned)((e1 * CAPR + s1) * 1024 + lane * 16), v);
            if (lane == 0) { *(int4*)(slot + (size_t)row * 4) = make_int4(e0, s0, e1, s1);
                twt[(size_t)e0 * MTOT + s0] = rwt[lrow * 3]; twt[(size_t)e1 * MTOT + s1] = rwt[lrow * 3 + 1]; tsc[(size_t)e0 * MTOT + s0] = rwt[lrow * 3 + 2]; tsc[(size_t)e1 * MTOT + s1] = rwt[lrow * 3 + 2]; }
        }
        __syncthreads();
        if (tid < 8) lcnt[tid] = 0;
        __syncthreads();
    };
    if (row0 < nrows) issue(row0, Yb[0], Xb[0]);
    if (row0 + NWAVES < nrows) issue(row0 + NWAVES, Yb[1], Xb[1]);
    bool live = true;
#pragma unroll 1
    for (int i = 0; i < 9 && live; i += 3) {
        if (!step(i, Yb[0], Xb[0], Yb[2], Xb[2])) { live = false; break; }
        if (!step(i + 1, Yb[1], Xb[1], Yb[0], Xb[0])) { live = false; break; }
        if (!step(i + 2, Yb[2], Xb[2], Yb[1], Xb[1])) { live = false; break; }
    }
    if (ODD && !dummy) flush(0, 9);
#pragma unroll 1
    for (int i = 9; i < NI && live; i += 3) {
        if (!step(i, Yb[0], Xb[0], Yb[2], Xb[2])) break;
        if (!step(i + 1, Yb[1], Xb[1], Yb[0], Xb[0])) break;
        if (!step(i + 2, Yb[2], Xb[2], Yb[1], Xb[1])) break;
    }
    if (ODD && !dummy) flush(9, NI);
}

struct MoeLayout { int cnt[8], ustart[9], tstart[9]; };
__device__ __forceinline__ MoeLayout moe_layout(const Params& p, int layer) {
    unsigned* cnt = (unsigned*)(p.ws + OFF_CTL) + CW_MOECNT + (layer >> 1) * 64;
    MoeLayout L; int u = 0, t = 0;
#pragma unroll
    for (int e = 0; e < 8; ++e) { const int c = __builtin_amdgcn_readfirstlane((int)__hip_atomic_load(cnt + e, __ATOMIC_RELAXED, __HIP_MEMORY_SCOPE_AGENT)); L.cnt[e] = c; L.ustart[e] = u; L.tstart[e] = t; u += c; t += (c + 255) >> 8; }
    L.ustart[8] = u; L.tstart[8] = t; return L;
}

template <bool MOE>
__device__ __forceinline__ void phase_rowC(const Params& p, const int wv, int layer, const bf16_t* F, bool last, bool dummy = false) {
    const int tid = opaque_tid(wv), lane = tid & 63, wave = tid >> 6;
    const bf16_t* xs_in = (const bf16_t*)(p.ws + OFF_XS); bf16_t* xs = (bf16_t*)(p.ws + (dummy ? WS_END : OFF_XS)); bf16_t* abuf = (bf16_t*)(p.ws + (dummy ? WS_END + (size_t)MTOT * DM * 4 : OFF_ABUF));
    float* outp = dummy ? (float*)xs : p.out;
    const float* ng = p.in[6] + (size_t)layer * 4 * DM;
    float mg3[16], gsn[16], sh[16];
    const int nrows = last ? MLAT : MTOT;
    const bf16_t* eout = (const bf16_t*)(p.ws + OFF_EOUT);
    constexpr int NI = ROWS_PER_BLOCK / NWAVES;
    const int row0 = blockIdx.x * ROWS_PER_BLOCK + wave;
    int my0 = 0, my1 = 0;
    if (MOE) {
        const MoeLayout L = moe_layout(p, layer);
        const int r = row0 + NWAVES * lane;
        if (lane < NI && r < nrows) {
            const int4 si = *(const int4*)((const int*)(p.ws + OFF_SLOT) + (size_t)r * 4);
            int t0 = 0, t1 = 0;
#pragma unroll
            for (int j = 0; j < 8; ++j) { t0 = (j == si.x) ? L.tstart[j] : t0; t1 = (j == si.z) ? L.tstart[j] : t1; }
            my0 = t0 * 256 + si.y; my1 = t1 * 256 + si.w;
        }
    }
    float Fb[3][16], Gb[3][16], Xb[3][16];
    auto issue = [&](int i, int row, float (&ff)[16], float (&gg)[16], float (&xx)[16]) {
        if (MOE) { const int a0 = __builtin_amdgcn_readlane(my0, i), a1 = __builtin_amdgcn_readlane(my1, i); ld16_bf16(eout + (size_t)a0 * DM, lane, ff); ld16_bf16(eout + (size_t)a1 * DM, lane, gg); }
        else ld16_bf16(F + (size_t)row * DM, lane, ff);
        ld16_bf16(xs_in + (size_t)row * DM, lane, xx);
    };
    int cur = -1;
    auto step = [&](int i, float (&f)[16], float (&f1)[16], float (&x)[16], float (&fn2)[16], float (&gn2)[16], float (&xn2)[16]) -> bool {
        const int row = row0 + NWAVES * i, bidx = row_bidx(row);
        if (i >= NI || row >= nrows) return false;
        constexpr int AHEAD = MOE ? 1 : 2;
        if (i + AHEAD < NI && row + AHEAD * NWAVES < nrows) issue(i + AHEAD, row + AHEAD * NWAVES, fn2, gn2, xn2);
        if (MOE) {
#pragma unroll
            for (int k = 0; k < 16; ++k) f[k] += f1[k];
        }
        if (bidx != cur) { cur = bidx; float t[16]; ld16(modp(p, layer, bidx, 5), lane, mg3); ld16(ng + 3 * DM, lane, t);
#pragma unroll
            for (int k = 0; k < 16; ++k) mg3[k] *= t[k];
            if (!last) { ld16(modp(p, layer + 1, bidx, 1), lane, gsn); ld16(ng + 4 * DM, lane, t);
#pragma unroll
                for (int k = 0; k < 16; ++k) gsn[k] = t[k] * (1.0f + gsn[k]);
                ld16(modp(p, layer + 1, bidx, 0), lane, sh); } }
        const float rsf = rsqrtf(sumsq16(f) * (1.0f / DM) + EPSN);
#pragma unroll
        for (int k = 0; k < 16; ++k) x[k] = x[k] + mg3[k] * (f[k] * rsf);
        if (last) st16_f32_nt(outp + (size_t)row * DM, lane, x);
        else {
            st16_bf16_wt(xs, row, lane, x);
            const float rs2 = rsqrtf(sumsq16(x) * (1.0f / DM) + EPSN);
#pragma unroll
            for (int k = 0; k < 16; ++k) f[k] = x[k] * rs2 * gsn[k] + sh[k];
            { const float fs = st16_i8_wt((unsigned char*)abuf, row, lane, f); if (lane == 0 && !dummy) ((float*)(p.ws + OFF_FSC))[row] = fs; }
        }
        return true;
    };
    if (row0 < nrows) issue(0, row0, Fb[0], Gb[0], Xb[0]);
    if constexpr (MOE) {
#pragma unroll 1
        for (int i = 0; i < NI; i += 2) {
            if (!step(i, Fb[0], Gb[0], Xb[0], Fb[1], Gb[1], Xb[1])) break;
            if (!step(i + 1, Fb[1], Gb[1], Xb[1], Fb[0], Gb[0], Xb[0])) break;
        }
    } else {
        if (row0 + NWAVES < nrows) issue(1, row0 + NWAVES, Fb[1], Gb[1], Xb[1]);
#pragma unroll 1
        for (int i = 0; i < NI; i += 3) {
            if (!step(i, Fb[0], Gb[0], Xb[0], Fb[2], Gb[2], Xb[2])) break;
            if (!step(i + 1, Fb[1], Gb[1], Xb[1], Fb[0], Gb[0], Xb[0])) break;
            if (!step(i + 2, Fb[2], Gb[2], Xb[2], Fb[1], Gb[1], Xb[1])) break;
        }
    }
}

__device__ __forceinline__ void phase_conv(const Params& p, const int wv, int layer) {
    const int tid = opaque_tid(wv), lane = tid & 63, wave = tid >> 6;
    const bf16_t* P = (const bf16_t*)(p.ws + OFF_U + U_P_E); bf16_t* mix = (bf16_t*)(p.ws + OFF_U + U_MIX_E);
    const float* cw = p.in[8] + (size_t)(layer >> 1) * 3 * 512;
    float w0[8], w1[8], w2[8];
#pragma unroll
    for (int k = 0; k < 8; ++k) { w0[k] = cw[8 * lane + k]; w1[k] = cw[512 + 8 * lane + k]; w2[k] = cw[1024 + 8 * lane + k]; }
    const int bA = (int)(blockIdx.x & 7), isA = bA < 2, nit = isA ? 14 : 18;
    const int jb = (int)(blockIdx.x >> 3) * 6 + (bA - 2), oa = jb / 3, orow = (14 + jb % 3) * 2048 + ((oa >> 1) * 8 + (oa & 1)) * 8 + wave;
#pragma unroll 1
    for (int it = 0; it < nit; ++it) {
        const int row = it < 17 ? it * 2048 + (int)blockIdx.x * NWAVES + wave : orow;
        const int pos = row < MLAT ? (row & (SEQ - 1)) : ((row - MLAT) & (CTXL - 1)), len = row < MLAT ? SEQ : CTXL;
        const bf16_t* pr = P + (size_t)row * EVEN_IN + 8 * lane;
        const u32x4 bg = *(const u32x4*)pr;
        float acc[8];
#pragma unroll
        for (int k = 0; k < 8; ++k) acc[k] = 0.f;
#pragma unroll
        for (int d = -1; d <= 1; ++d) {
            if (pos + d < 0 || pos + d >= len) continue;
            const bf16_t* q = pr + (ptrdiff_t)d * EVEN_IN;
            const u32x4 cg = *(const u32x4*)(q + 512), uu = *(const u32x4*)(q + 1024);
            const float* w = d < 0 ? w0 : (d == 0 ? w1 : w2);
#pragma unroll
            for (int k = 0; k < 4; ++k) { acc[2 * k] += w[2 * k] * bf_lo(cg[k]) * bf_lo(uu[k]); acc[2 * k + 1] += w[2 * k + 1] * bf_hi(cg[k]) * bf_hi(uu[k]); }
        }
        u32x4 o;
#pragma unroll
        for (int k = 0; k < 4; ++k) o[k] = pk_bf16(bf_lo(bg[k]) * acc[2 * k], bf_hi(bg[k]) * acc[2 * k + 1]);
        st_wt(mix, (unsigned)(row * DM + 8 * lane) * 2u, o);
    }
}

__device__ __forceinline__ float max3f(float a, float b, float c) { return __builtin_fmaxf(__builtin_fmaxf(a, b), c); }
__device__ __forceinline__ float xhalf_max(float v) { const auto rr = __builtin_amdgcn_permlane32_swap(__float_as_uint(v), __float_as_uint(v), false, false); return fmaxf(__uint_as_float(rr[0]), __uint_as_float(rr[1])); }
__device__ __forceinline__ float xhalf_sum(float v) { const auto rr = __builtin_amdgcn_permlane32_swap(__float_as_uint(v), __float_as_uint(v), false, false); return __uint_as_float(rr[0]) + __uint_as_float(rr[1]); }
struct NoMask { __device__ __forceinline__ void operator()(f32x16&, f32x16&) const {} };
struct BandMask {
    int kp0, qp, hi;
    __device__ __forceinline__ void operator()(f32x16& s0, f32x16& s1) const {
#pragma unroll
        for (int r = 0; r < 16; ++r) { const int d0 = kp0 + crow(r, hi) - qp, d1 = d0 + 32; if (d0 > 128 || d0 < -128) s0[r] = -INFINITY; if (d1 > 128 || d1 < -128) s1[r] = -INFINITY; }
    }
};
#define ABAR() asm volatile("s_waitcnt lgkmcnt(0)\n\ts_barrier" ::: "memory")
template <int KP, int NKS>
__device__ __forceinline__ void attn_X(const LAS unsigned char* Kt, const bf16x8 (&qf)[NKS], const f32x16& negm, f32x16& s0, f32x16& s1, int lane) {
    const int r32 = lane & 31, hi = lane >> 5;
    const LAS unsigned char* kp = Kt + r32 * KP + hi * 16;
#pragma unroll
    for (int s = 0; s < NKS; ++s) {
        const bf16x8 k0 = *(const LAS bf16x8*)(kp + s * 32), k1 = *(const LAS bf16x8*)(kp + 32 * KP + s * 32);
        s0 = __builtin_amdgcn_mfma_f32_32x32x16_bf16(k0, qf[s], s == 0 ? negm : s0, 0, 0, 0);
        s1 = __builtin_amdgcn_mfma_f32_32x32x16_bf16(k1, qf[s], s == 0 ? negm : s1, 0, 0, 0);
    }
}
template <int NDB, class Mask>
__device__ __forceinline__ void attn_Y(f32x16& s0, f32x16& s1, u32x4 (&pw)[4], f32x16 (&o)[NDB], f32x16& negm, float& m, float& l, bool first, const Mask& mask) {
    constexpr float THR = 8.0f;
    mask(s0, s1);
    float a = max3f(s0[0], s0[1], s1[0]), b = max3f(s0[2], s0[3], s1[1]); a = max3f(a, s1[2], s1[3]);
#pragma unroll
    for (int r = 4; r < 16; r += 4) { a = max3f(a, s0[r], s0[r + 1]); b = max3f(b, s0[r + 2], s0[r + 3]); a = max3f(a, s1[r], s1[r + 1]); b = max3f(b, s1[r + 2], s1[r + 3]); }
    const float rm = xhalf_max(fmaxf(a, b));
    if (first || __any(rm > THR)) {
        const float dl = first ? fmaxf(rm, -64.0f) : fmaxf(rm, 0.f), f = fast_exp2(-dl);
        m += dl; l *= f;
#pragma unroll
        for (int r = 0; r < 16; ++r) { s0[r] -= dl; s1[r] -= dl; float nm_ = -m; asm volatile("" : "+v"(nm_)); negm[r] = nm_; }
        asm volatile("s_nop 7" ::: "memory");
#pragma unroll
        for (int d = 0; d < NDB; ++d)
#pragma unroll
            for (int r = 0; r < 16; ++r) o[d][r] *= f;
    }
    float ps = 0.f;
#pragma unroll
    for (int r = 0; r < 16; ++r) { s0[r] = fast_exp2(s0[r]); s1[r] = fast_exp2(s1[r]); ps += s0[r] + s1[r]; }
    l += ps;
#pragma unroll
    for (int ks = 0; ks < 2; ++ks) {
        pw[ks] = (u32x4){pk_bf16(s0[8 * ks], s0[8 * ks + 1]), pk_bf16(s0[8 * ks + 2], s0[8 * ks + 3]), pk_bf16(s0[8 * ks + 4], s0[8 * ks + 5]), pk_bf16(s0[8 * ks + 6], s0[8 * ks + 7])};
        pw[2 + ks] = (u32x4){pk_bf16(s1[8 * ks], s1[8 * ks + 1]), pk_bf16(s1[8 * ks + 2], s1[8 * ks + 3]), pk_bf16(s1[8 * ks + 4], s1[8 * ks + 5]), pk_bf16(s1[8 * ks + 6], s1[8 * ks + 7])};
    }
}
template <int VP, int NDB>
__device__ __forceinline__ void attn_Z(const LAS unsigned char* Vt, const u32x4 (&pw)[4], f32x16 (&o)[NDB], int lane) {
    const int hi = lane >> 5;
    const LAS unsigned char* vp = Vt + (4 * hi + ((lane & 15) >> 2)) * VP + ((lane >> 4) & 1) * 32 + (lane & 3) * 8;
    if constexpr (NDB <= 4) {
        s16x4 lo[NDB], hh[NDB], lon[NDB], hhn[NDB];
#pragma unroll
        for (int d = 0; d < NDB; ++d) { lo[d] = __builtin_bit_cast(s16x4, __builtin_amdgcn_ds_read_tr16_b64_v4i16((LAS s16x4*)(vp + d * 64))); hh[d] = __builtin_bit_cast(s16x4, __builtin_amdgcn_ds_read_tr16_b64_v4i16((LAS s16x4*)(vp + d * 64 + 8 * VP))); }
#pragma unroll
        for (int st = 0; st < 4; ++st) {
            __builtin_amdgcn_sched_barrier(0);
            if (st < 3) {
#pragma unroll
                for (int d = 0; d < NDB; ++d) { const LAS unsigned char* a = vp + (16 * (st + 1)) * VP + d * 64;
                    lon[d] = __builtin_bit_cast(s16x4, __builtin_amdgcn_ds_read_tr16_b64_v4i16((LAS s16x4*)a)); hhn[d] = __builtin_bit_cast(s16x4, __builtin_amdgcn_ds_read_tr16_b64_v4i16((LAS s16x4*)(a + 8 * VP))); }
            }
            const bf16x8 pf = __builtin_bit_cast(bf16x8, pw[st]);
#pragma unroll
            for (int d = 0; d < NDB; ++d) { const bf16x8 vf = {lo[d][0], lo[d][1], lo[d][2], lo[d][3], hh[d][0], hh[d][1], hh[d][2], hh[d][3]}; o[d] = __builtin_amdgcn_mfma_f32_32x32x16_bf16(vf, pf, o[d], 0, 0, 0); }
#pragma unroll
            for (int d = 0; d < NDB; ++d) { lo[d] = lon[d]; hh[d] = hhn[d]; }
        }
    } else {
#pragma unroll
        for (int st = 0; st < 4; ++st) {
            __builtin_amdgcn_sched_barrier(0);
            const bf16x8 pf = __builtin_bit_cast(bf16x8, pw[st]);
#pragma unroll
            for (int d = 0; d < NDB; ++d) { const LAS unsigned char* a = vp + (16 * st) * VP + d * 64;
                const s16x4 lo = __builtin_bit_cast(s16x4, __builtin_amdgcn_ds_read_tr16_b64_v4i16((LAS s16x4*)a)), hh = __builtin_bit_cast(s16x4, __builtin_amdgcn_ds_read_tr16_b64_v4i16((LAS s16x4*)(a + 8 * VP)));
                const bf16x8 vf = {lo[0], lo[1], lo[2], lo[3], hh[0], hh[1], hh[2], hh[3]}; o[d] = __builtin_amdgcn_mfma_f32_32x32x16_bf16(vf, pf, o[d], 0, 0, 0); }
        }
    }
}
template <int KP, int VP, int NKS, int NDB, class GLK, class GLV, class STK, class STV, class MaskF>
__device__ __forceinline__ void attn_run1(LAS unsigned char* lds, int KB, int SB, int kcoff, const bf16x8 (&qf)[NKS], f32x16 (&o)[NDB], float& m, float& l, int NT, int lane,
                                          GLK glk, GLV glv, STK stk, STV stv, MaskF maskf) {
    f32x16 s0, s1, negm; u32x4 pw[4];
    m = 0.f;
#pragma unroll
    for (int r = 0; r < 16; ++r) negm[r] = 0.f;
    glk(0); glv(0); stk(0); stv(0); ABAR();
#pragma unroll 1
    for (int t = 0; t < NT; ++t) {
        if (t + 1 < NT) { glk(t + 1); glv(t + 1); }
        const LAS unsigned char* Kt = lds + (t & 1) * SB;
        attn_X<KP, NKS>(Kt + kcoff, qf, negm, s0, s1, lane);
        __builtin_amdgcn_sched_barrier(0);
        attn_Y<NDB>(s0, s1, pw, o, negm, m, l, t == 0, [&](f32x16& x0, f32x16& x1) { maskf(t, x0, x1); });
        __builtin_amdgcn_sched_barrier(0);
        attn_Z<VP, NDB>(Kt + KB, pw, o, lane);
        if (t + 1 < NT) { stk((t + 1) & 1); stv((t + 1) & 1); }
        ABAR();
    }
}

template <int NDB, class Mask>
__device__ __forceinline__ void attn_Y1(f32x16& s0, f32x16& s1, f32x16 (&o)[NDB], f32x16& negm, float& m, float& l, bool first, const Mask& mask) {
    constexpr float THR = 8.0f;
    mask(s0, s1);
    float a = max3f(s0[0], s0[1], s1[0]), b = max3f(s0[2], s0[3], s1[1]); a = max3f(a, s1[2], s1[3]);
#pragma unroll
    for (int r = 4; r < 16; r += 4) { a = max3f(a, s0[r], s0[r + 1]); b = max3f(b, s0[r + 2], s0[r + 3]); a = max3f(a, s1[r], s1[r + 1]); b = max3f(b, s1[r + 2], s1[r + 3]); }
    const float rm = xhalf_max(fmaxf(a, b));
    if (first || __any(rm > THR)) {
        const float dl = first ? fmaxf(rm, -64.0f) : fmaxf(rm, 0.f), f = fast_exp2(-dl);
        m += dl; l *= f;
#pragma unroll
        for (int r = 0; r < 16; ++r) { s0[r] -= dl; s1[r] -= dl; float nm_ = -m; asm volatile("" : "+v"(nm_)); negm[r] = nm_; }
        asm volatile("s_nop 7" ::: "memory");
#pragma unroll
        for (int d = 0; d < NDB; ++d)
#pragma unroll
            for (int r = 0; r < 16; ++r) o[d][r] *= f;
    }
}
__device__ __forceinline__ void attn_Y2(f32x16& s0, f32x16& s1, u32x4 (&pw)[4], float& l) {
    float ps = 0.f;
#pragma unroll
    for (int r = 0; r < 16; ++r) { s0[r] = fast_exp2(s0[r]); s1[r] = fast_exp2(s1[r]); ps += s0[r] + s1[r]; }
    l += ps;
#pragma unroll
    for (int ks = 0; ks < 2; ++ks) {
        pw[ks] = (u32x4){pk_bf16(s0[8 * ks], s0[8 * ks + 1]), pk_bf16(s0[8 * ks + 2], s0[8 * ks + 3]), pk_bf16(s0[8 * ks + 4], s0[8 * ks + 5]), pk_bf16(s0[8 * ks + 6], s0[8 * ks + 7])};
        pw[2 + ks] = (u32x4){pk_bf16(s1[8 * ks], s1[8 * ks + 1]), pk_bf16(s1[8 * ks + 2], s1[8 * ks + 3]), pk_bf16(s1[8 * ks + 4], s1[8 * ks + 5]), pk_bf16(s1[8 * ks + 6], s1[8 * ks + 7])};
    }
}
template <int KP, int VP, int NKS, int NDB, int VPM  , class GLK, class GLV, class STK, class STV, class MaskF>
__device__ __forceinline__ void attn_run2(LAS unsigned char* lds, int KB, int SB, int kcoff, const bf16x8 (&qf)[NKS], f32x16 (&o)[NDB], float& m, float& l, int NT, int lane,
                                          GLK glk, GLV glv, STK stk, STV stv, MaskF maskf) {
    f32x16 sa0, sa1, sb0, sb1, negm; u32x4 pw[4];
    m = 0.f;
#pragma unroll
    for (int r = 0; r < 16; ++r) negm[r] = 0.f;
    glk(0); stk(0); glv(0); stv(0);
    if (NT > 1) { glk(1); stk(1); }
    ABAR();
    attn_X<KP, NKS>(lds + kcoff, qf, negm, sa0, sa1, lane);
    auto step = [&](int t, f32x16& c0, f32x16& c1, f32x16& n0, f32x16& n1) {
        if (t + 2 < NT) glk(t + 2);
        if (t + 1 < NT) glv(t + 1);
        attn_Y1<NDB>(c0, c1, o, negm, m, l, t == 0, [&](f32x16& x0, f32x16& x1) { maskf(t, x0, x1); });
        if (t + 1 < NT) attn_X<KP, NKS>(lds + ((t + 1) & 1) * SB + kcoff, qf, negm, n0, n1, lane);
        attn_Y2(c0, c1, pw, l);
        __builtin_amdgcn_sched_group_barrier(0x100, 4, 0);
#pragma unroll
        for (int i = 0; i < 2 * NKS; ++i) { __builtin_amdgcn_sched_group_barrier(0x008, 1, 0); if (i < 2 * NKS - 4) __builtin_amdgcn_sched_group_barrier(0x100, 1, 0); __builtin_amdgcn_sched_group_barrier(0x002, VPM, 0); }
        __builtin_amdgcn_sched_barrier(0);
        attn_Z<VP, NDB>(lds + (t & 1) * SB + KB, pw, o, lane);
        if (t + 2 < NT) stk(t & 1);
        if (t + 1 < NT) stv((t + 1) & 1);
        ABAR();
    };
#pragma unroll 1
    for (int t = 0; t < NT; t += 2) {
        step(t, sa0, sa1, sb0, sb1);
        if (t + 1 < NT) step(t + 1, sb0, sb1, sa0, sa1);
    }
}

__device__ __forceinline__ void store_row_pairs(bf16_t* base, unsigned eoff, const u32x2 (&w)[4], int hi) {
#pragma unroll
    for (int k = 0; k < 4; k += 2) {
        u32x2 a = w[k], b = w[k + 1];
        { const auto r = __builtin_amdgcn_permlane32_swap(a.x, b.x, false, false); a.x = r[0]; b.x = r[1]; }
        { const auto r = __builtin_amdgcn_permlane32_swap(a.y, b.y, false, false); a.y = r[0]; b.y = r[1]; }
        st_pl(base, (eoff + 8 * k + 8 * hi) * 2u, (u32x4){a.x, a.y, b.x, b.y});
    }
}
__device__ __forceinline__ bf16x8 load_q(const bf16_t* p, float qs) {
    const u32x4 w = *(const u32x4*)p; u32x4 o;
#pragma unroll
    for (int k = 0; k < 4; ++k) o[k] = pk_bf16(bf_lo(w[k]) * qs, bf_hi(w[k]) * qs);
    return __builtin_bit_cast(bf16x8, o);
}
__device__ __forceinline__ int attn_vcu() { return (int)((blockIdx.x & 7) * (gridDim.x >> 3) + (blockIdx.x >> 3)); }

__device__ __forceinline__ void swa_unit(const Params& p, const int wv, LAS unsigned char* lds, int layer, int b, int g, int q0, bool ctxq) {
    constexpr int KP = 144, VP = 192, KB = 64 * KP, SB = KB + 64 * VP;
    const int tid = opaque_tid(wv), lane = tid & 63, wave = __builtin_amdgcn_readfirstlane(tid >> 6), r32 = lane & 31, hi = lane >> 5;
    const bf16_t* P = (const bf16_t*)(p.ws + OFF_U + U_P_E); bf16_t* mix = (bf16_t*)(p.ws + OFF_U + U_MIX_E);
    const int hd = 4 * g + (wave >> 1);
    const int qrow = (ctxq ? MLAT + b * CTXL : b * SEQ) + q0 + 32 * (wave & 1) + r32;
    const float qs = 0.125f * LOG2E;
    bf16x8 qf[4];
#pragma unroll
    for (int s = 0; s < 4; ++s) qf[s] = load_q(P + (size_t)qrow * EVEN_IN + 1536 + hd * 64 + 16 * s + 8 * hi, qs);
    f32x16 o[2];
#pragma unroll
    for (int d = 0; d < 2; ++d)
#pragma unroll
        for (int r = 0; r < 16; ++r) o[d][r] = 0.f;
    float m = -1e30f, l = 0.f;
    int ilo = 0, nlat = 0;
    if (!ctxq) { ilo = q0 >= 128 ? 0 : (128 - q0) / 64; int ihi = (SEQ + 64 - q0) / 64; ihi = ihi > 4 ? 4 : ihi; nlat = ihi - ilo + 1; }
    const int NT = nlat + 4;
    const int ki = tid >> 3, kc = tid & 7;
    u32x4 rk, rv;
    auto krow = [&](int t) { return t < nlat ? b * SEQ + q0 - 128 + 64 * (ilo + t) + ki : MLAT + b * CTXL + 64 * (t - nlat) + ki; };
    auto glk = [&](int t) { rk = *(const u32x4*)(P + (size_t)krow(t) * EVEN_IN + 2048 + g * 64 + kc * 8); };
    auto glv = [&](int t) { rv = *(const u32x4*)(P + (size_t)krow(t) * EVEN_IN + 2176 + g * 64 + kc * 8); };
    auto stk = [&](int buf) { *(LAS u32x4*)(lds + buf * SB + ki * KP + kc * 16) = rk; };
    auto stv = [&](int buf) { *(LAS u32x4*)(lds + buf * SB + KB + ki * VP + kc * 16) = rv; };
    const int qp = q0 + 32 * (wave & 1) + r32;
    attn_run1<KP, VP, 4, 2>(lds, KB, SB, 0, qf, o, m, l, NT, lane, glk, glv, stk, stv,
        [&](int t, f32x16& x0, f32x16& x1) { if (t < nlat) { BandMask bm; bm.kp0 = q0 - 128 + 64 * (ilo + t); bm.qp = qp; bm.hi = hi; bm(x0, x1); } });
    l = xhalf_sum(l);
    l += fast_exp2(p.in[9][(layer >> 1) * 8 + hd] * LOG2E - m);
    const float inv = 1.0f / l;
    const unsigned orow = (unsigned)(qrow * DM + 512 + hd * 64);
#pragma unroll
    for (int d = 0; d < 2; ++d) { u32x2 w[4];
#pragma unroll
        for (int gq = 0; gq < 4; ++gq) { w[gq].x = pk_bf16(o[d][4 * gq] * inv, o[d][4 * gq + 1] * inv); w[gq].y = pk_bf16(o[d][4 * gq + 2] * inv, o[d][4 * gq + 3] * inv); }
        store_row_pairs(mix, orow + 32 * d, w, hi); }
}
__device__ __forceinline__ void phase_swa(const Params& p, const int wv, LAS unsigned char* lds, int layer) {
    const int v = attn_vcu();
    for (int u = v; u < 1024 + 64; u += gridDim.x) {
        if (u < 1024) swa_unit(p, wv, lds, layer, u >> 7, (u >> 6) & 1, (u & 63) * 64, false);
        else { const int c = u - 1024; swa_unit(p, wv, lds, layer, c >> 3, (c >> 2) & 1, (c & 3) * 64, true); }
    }
}

__device__ __forceinline__ void mla_unit(const Params& p, const int wv, LAS unsigned char* lds, int b, int h, int qrow0, int nl) {
    constexpr int KP = 208, VP = 192, KB = 64 * KP, SB = KB + 64 * VP;
    const int tid = opaque_tid(wv), lane = tid & 63, wave = __builtin_amdgcn_readfirstlane(tid >> 6), r32 = lane & 31, hi = lane >> 5;
    const bf16_t* P = (const bf16_t*)(p.ws + OFF_U + U_P_O); const bf16_t* QF = (const bf16_t*)(p.ws + OFF_U + U_QF_O); const bf16_t* KVF = (const bf16_t*)(p.ws + OFF_U + U_KVF_O);
    bf16_t* mix = (bf16_t*)(p.ws + OFF_U + U_MIX_O);
    const int qrow = qrow0 + 32 * wave + r32;
    const float qs = 0.10206207261596575f * LOG2E;
    bf16x8 qf[6];
#pragma unroll
    for (int s = 0; s < 4; ++s) qf[s] = load_q(QF + (size_t)qrow * 768 + h * 96 + 16 * s + 8 * hi, qs);
    {
        const u32x4 a = *(const u32x4*)(QF + (size_t)qrow * 768 + h * 96 + 64 + 8 * hi), bq = *(const u32x4*)(QF + (size_t)qrow * 768 + h * 96 + 80 + 8 * hi);
        float x1[8], x2[8];
#pragma unroll
        for (int k = 0; k < 4; ++k) { x1[2 * k] = bf_lo(a[k]); x1[2 * k + 1] = bf_hi(a[k]); x2[2 * k] = bf_lo(bq[k]); x2[2 * k + 1] = bf_hi(bq[k]); }
        if (nl > 0) {
            const float* tab = (const float*)(p.ws + OFF_TAB) + 2048; const int sp = qrow & (SEQ - 1), pos = hi ? (sp & 63) : (sp >> 6);
#pragma unroll
            for (int k = 0; k < 8; ++k) { const float cs = tab[pos * 8 + k], sn = tab[512 + pos * 8 + k]; const float o1 = x1[k] * cs - x2[k] * sn, o2 = x2[k] * cs + x1[k] * sn; x1[k] = o1; x2[k] = o2; }
        }
        u32x4 w1, w2;
#pragma unroll
        for (int k = 0; k < 4; ++k) { w1[k] = pk_bf16(x1[2 * k] * qs, x1[2 * k + 1] * qs); w2[k] = pk_bf16(x2[2 * k] * qs, x2[2 * k + 1] * qs); }
        qf[4] = __builtin_bit_cast(bf16x8, w1); qf[5] = __builtin_bit_cast(bf16x8, w2);
    }
    f32x16 o[2];
#pragma unroll
    for (int d = 0; d < 2; ++d)
#pragma unroll
        for (int r = 0; r < 16; ++r) o[d][r] = 0.f;
    float m = -1e30f, l = 0.f;
    const int NT = nl + 4;
    const int ki = tid >> 3, kc = tid & 7, ki2 = (tid >> 2) & 63, kc2 = tid & 3;
    u32x4 rk, rv, rp;
    auto krow = [&](int t, int i) { return t < nl ? b * SEQ + 64 * t + i : MLAT + b * CTXL + 64 * (t - nl) + i; };
    auto glk = [&](int t) { rk = *(const u32x4*)(KVF + (size_t)krow(t, ki) * 1024 + h * 128 + kc * 8); if (tid < 256) rp = *(const u32x4*)(P + (size_t)krow(t, ki2) * ODD_INP + 384 + kc2 * 8); };
    auto glv = [&](int t) { rv = *(const u32x4*)(KVF + (size_t)krow(t, ki) * 1024 + h * 128 + 64 + kc * 8); };
    auto stk = [&](int buf) { *(LAS u32x4*)(lds + buf * SB + ki * KP + kc * 16) = rk; if (tid < 256) *(LAS u32x4*)(lds + buf * SB + ki2 * KP + 128 + kc2 * 16) = rp; };
    auto stv = [&](int buf) { *(LAS u32x4*)(lds + buf * SB + KB + ki * VP + kc * 16) = rv; };
    attn_run2<KP, VP, 6, 2, 7>(lds, KB, SB, 0, qf, o, m, l, NT, lane, glk, glv, stk, stv, [](int, f32x16&, f32x16&) {});
    l = xhalf_sum(l);
    const float inv = 1.0f / l;
    const unsigned orow = (unsigned)(qrow * DM + h * 64);
#pragma unroll
    for (int d = 0; d < 2; ++d) { u32x2 w[4];
#pragma unroll
        for (int gq = 0; gq < 4; ++gq) { w[gq].x = pk_bf16(o[d][4 * gq] * inv, o[d][4 * gq + 1] * inv); w[gq].y = pk_bf16(o[d][4 * gq + 2] * inv, o[d][4 * gq + 3] * inv); }
        store_row_pairs(mix, orow + 32 * d, w, hi); }
}

__device__ __forceinline__ void diff_unit(const Params& p, const int wv, LAS unsigned char* lds, int layer, int b, int h, int qrow0, int nl, float lam, float lam_init) {
    constexpr int KP = 272, VP = 320, KB = 64 * KP, SB = KB + 64 * VP, XP = 528;
    const int tid = opaque_tid(wv), lane = tid & 63, wave = __builtin_amdgcn_readfirstlane(tid >> 6), r32 = lane & 31, hi = lane >> 5;
    const bf16_t* P = (const bf16_t*)(p.ws + OFF_U + U_P_O); bf16_t* mix = (bf16_t*)(p.ws + OFF_U + U_MIX_O);
    const int comp = wave >> 2, qrow = qrow0 + 32 * (wave & 3) + r32;
    const float qs = 0.125f * LOG2E;
    bf16x8 qf[4];
#pragma unroll
    for (int s = 0; s < 4; ++s) qf[s] = load_q(P + (size_t)qrow * ODD_INP + 512 + h * 128 + comp * 64 + 16 * s + 8 * hi, qs);
    f32x16 o[4];
#pragma unroll
    for (int d = 0; d < 4; ++d)
#pragma unroll
        for (int r = 0; r < 16; ++r) o[d][r] = 0.f;
    float m = -1e30f, l = 0.f;
    const int NT = nl + 4;
    const int ki = tid >> 3, kc = tid & 7;
    u32x4 rk0, rk1, rv0, rv1;
    auto krow = [&](int t) { return t < nl ? b * SEQ + 64 * t + ki : MLAT + b * CTXL + 64 * (t - nl) + ki; };
    auto glk = [&](int t) { const bf16_t* pr = P + (size_t)krow(t) * ODD_INP + 1024 + h * 128 + kc * 8; rk0 = *(const u32x4*)pr; rk1 = *(const u32x4*)(pr + 64); };
    auto glv = [&](int t) { const bf16_t* pr = P + (size_t)krow(t) * ODD_INP + 1536 + h * 128 + kc * 8; rv0 = *(const u32x4*)pr; rv1 = *(const u32x4*)(pr + 64); };
    auto stk = [&](int buf) { LAS unsigned char* kb = lds + buf * SB + ki * KP + kc * 16; *(LAS u32x4*)kb = rk0; *(LAS u32x4*)(kb + 128) = rk1; };
    auto stv = [&](int buf) { LAS unsigned char* vb = lds + buf * SB + KB + ki * VP + kc * 16; *(LAS u32x4*)vb = rv0; *(LAS u32x4*)(vb + 128) = rv1; };
    attn_run2<KP, VP, 4, 4, 10>(lds, KB, SB, comp * 128, qf, o, m, l, NT, lane, glk, glv, stk, stv, [](int, f32x16&, f32x16&) {});
    l = xhalf_sum(l);
    const float inv = 1.0f / l;
    LAS unsigned char* xrow = lds + (32 * (wave & 3) + r32) * XP;
    if (comp == 1) {
#pragma unroll
        for (int d = 0; d < 4; ++d)
#pragma unroll
            for (int gq = 0; gq < 4; ++gq) *(LAS f32x4*)(xrow + (32 * d + 8 * gq + 4 * hi) * 4) = (f32x4){o[d][4 * gq] * inv, o[d][4 * gq + 1] * inv, o[d][4 * gq + 2] * inv, o[d][4 * gq + 3] * inv};
    }
    __syncthreads();
    if (comp == 0) {
        float ss = 0.f;
#pragma unroll
        for (int d = 0; d < 4; ++d)
#pragma unroll
            for (int gq = 0; gq < 4; ++gq) { const f32x4 o2 = *(const LAS f32x4*)(xrow + (32 * d + 8 * gq + 4 * hi) * 4);
#pragma unroll
                for (int k = 0; k < 4; ++k) { const float v = o[d][4 * gq + k] * inv - lam * o2[k]; o[d][4 * gq + k] = v; ss += v * v; } }
        ss = xhalf_sum(ss);
        const float omli = __uint_as_float(__builtin_amdgcn_readfirstlane(__float_as_uint(layer == 1 ? 1.0f - 0.35550906f : 1.0f - 0.55605820f)));
        const float rs = rsqrtf(ss * (1.0f / 128.0f) + EPSN) * omli;
        const float* sg = p.in[17] + (size_t)(layer >> 1) * 128;
        const unsigned orow = (unsigned)(qrow * DM + 512 + h * 128);
#pragma unroll
        for (int d = 0; d < 4; ++d) { u32x2 w[4];
#pragma unroll
            for (int gq = 0; gq < 4; ++gq) { const int c = 32 * d + 8 * gq + 4 * hi; const f32x4 gg = *(const f32x4*)(sg + c);
                w[gq].x = pk_bf16(o[d][4 * gq] * rs * gg[0], o[d][4 * gq + 1] * rs * gg[1]); w[gq].y = pk_bf16(o[d][4 * gq + 2] * rs * gg[2], o[d][4 * gq + 3] * rs * gg[3]); }
            store_row_pairs(mix, orow + 32 * d, w, hi); }
    }
    __syncthreads();
}
__device__ __forceinline__ void phase_attn_odd(const Params& p, const int wv, LAS unsigned char* lds, int layer) {
    const int v = attn_vcu();
    const bool need_ctx = layer < 3;
    const float* lp = p.in[16] + (size_t)(layer >> 1) * 256; const int ln = opaque_tid(wv) & 63;
    const float lam_init = layer == 1 ? 0.35550906f : 0.55605820f;
    const float lam = __uint_as_float(__builtin_amdgcn_readfirstlane(__float_as_uint(expf(wave_sum(lp[ln] * lp[64 + ln])) - expf(wave_sum(lp[128 + ln] * lp[192 + ln])) + lam_init)));
    const int n_mla = 1024 + (need_ctx ? 64 : 0);
#ifndef NO_MLA
    for (int u = v; u < n_mla; u += gridDim.x) {
        if (u < 1024) { const int bh = u >> 4, qb = u & 15; mla_unit(p, wv, lds, bh >> 3, bh & 7, (bh >> 3) * SEQ + qb * 256, 64); }
        else { const int c = u - 1024; mla_unit(p, wv, lds, c >> 3, c & 7, MLAT + (c >> 3) * CTXL, 0); }
    }
#endif
#ifndef NO_DIFF
    for (int u = v; u < n_mla + 64; u += gridDim.x) {
        if (u < 1024) { const int bh = u >> 5, qb = u & 31; diff_unit(p, wv, lds, layer, bh >> 2, bh & 3, (bh >> 2) * SEQ + qb * 128, 64, lam, lam_init); }
        else if (u >= 1024 + 64) { const int c = u - 1024 - 64, bh = c >> 1; diff_unit(p, wv, lds, layer, bh >> 2, bh & 3, MLAT + (bh >> 2) * CTXL + (c & 1) * 128, 0, lam, lam_init); }
    }
#endif
}

__device__ __forceinline__ bool tail_share(int nwg, int G, int c, int& rank, int& nidle) {
    const int rmax = (nwg + G - 1) / G; int busy = nwg - (rmax - 1) * G; busy = busy >= G ? 0 : busy;
    rank = c - busy; nidle = G - busy; return c >= busy;
}

constexpr int NPH_PAIR = 16, NPHASES = 2 + 2 * NPH_PAIR;
__global__ void __launch_bounds__(NTHREADS, 2) fwd(Params p, int lo, int hi) {
    extern __shared__ __attribute__((aligned(16))) unsigned char smem_raw[];
    LAS unsigned char* lds = (LAS unsigned char*)smem_raw;
    volatile LAS unsigned* xbw = (volatile LAS unsigned*)(lds + LDS_BYTES - 16);
    unsigned char* ws = p.ws;
    const int wv = __builtin_amdgcn_readfirstlane((int)(threadIdx.x >> 6));
    XcdBarrier bar; bar.bar = (unsigned*)(ws + OFF_CTL); bar.x = 0; bar.st = xbw; bar.wv = wv;
    if (hi - lo > 1) {
        if (wv == 0 && lane_id() == 0) { xbw[0] = 0u; xbw[1] = 0u; xbw[2] = 0u; xbw[3] = 0u; }
        __syncthreads();
        bar = xcd_barrier_post((unsigned*)(ws + OFF_CTL), xbw, wv);
    }
    const int G = gridDim.x, c = blockIdx.x;
    constexpr int NM = MTOT / 256;
#ifndef PH_MASK
#define PH_MASK 0xFFFFFFFFu
#endif
#define PHASE(id) if (lo <= (id) && (id) < hi)
#ifndef DUP_MASK
#define DUP_MASK 0u
#endif
#define DUPK(k) _Pragma("unroll 1") for (int dup_ = 0; dup_ < ((((DUP_MASK) >> (k)) & 1u) ? 2 : 1); ++dup_)
#define DUP_DUMMY(k) (((((DUP_MASK) >> (k)) & 1u) != 0u) && dup_ == 0)
#define PMARK(k) asm volatile("; PHASE_MARK " #k ::: "memory")
#define PHM(k) if constexpr ((PH_MASK >> (k)) & 1u)
#define SEAM(id) do { if ((id) > lo) xcd_barrier(bar); } while (0)
    PHM(0) PHASE(0) DUPK(0) { PMARK(0); phase_prologue(p, wv, lds); }
    PHM(1) PHASE(1) DUPK(1) { PMARK(1); SEAM(1); phase_h0(p, wv); }
    for (int pr = 0; pr < 2; ++pr) {
        Params pq = p; pq.ws = fresh_ws();
        unsigned char* ws = pq.ws;
        const int le = 2 * pr, lod = 2 * pr + 1, pb = 2 + pr * NPH_PAIR;
        const bf16_t* abuf = (const bf16_t*)(ws + OFF_ABUF);
        PHM(2) PHASE(pb + 0) DUPK(2) { PMARK(2); SEAM(pb + 0);
            pg8::Gemm g{abuf, ws + OFF_WINE + pr * SZ_WINE, 1024, 1024}; pg8::StaticOrder S; S.init(NM, EVEN_IN / 256, G, c);
            pg8::EpiRope<0> E{(bf16_t*)(ws + OFF_U + U_P_E), EVEN_IN, (const float*)(ws + OFF_TAB), (const float*)(ws + OFF_FSC), (const float*)(ws + OFF_WSCI) + (size_t)pr * EVEN_IN, nullptr}; pg8::gemm_phase<3>(lds, g, S, E, wv); }
        PHM(3) PHASE(pb + 1) DUPK(3) { PMARK(3); SEAM(pb + 1); phase_conv(pq, wv, le); phase_swa(pq, wv, lds, le); }
        PHM(4) PHASE(pb + 2) DUPK(4) { PMARK(4); SEAM(pb + 2);
            pg8::Gemm g{(const bf16_t*)(ws + OFF_U + U_MIX_E), (const bf16_t*)(ws + OFF_WOUTE + pr * SZ_WOUT), 1024, 1024}; pg8::StaticOrder S; S.init(NM, 4, G, c);
            pg8::EpiBf16S E{(bf16_t*)(ws + OFF_U + U_Y_E), 1024, 4, nullptr, 1.0f}; pg8::gemm_phase<2>(lds, g, S, E, wv);
            { int rk, ni; if (tail_share(NM * 4, G, c, rk, ni)) conv_tiles_run(p, lds, opaque_tid(wv), CV_NT_PRO + pr * (CV_NT_E / 2), CV_NT_PRO + pr * (CV_NT_E / 2) + TAIL_T_SPLIT, rk, ni); } }
        PHM(5) PHASE(pb + 3) DUPK(5) { PMARK(5); SEAM(pb + 3); phase_rowB<false>(pq, wv, lds, le, (const bf16_t*)(ws + OFF_U + U_Y_E), MTOT, DUP_DUMMY(5)); }
        PHM(6) PHASE(pb + 4) DUPK(6) { PMARK(6); SEAM(pb + 4);
            pg8::Gemm g{abuf, ws + OFF_WGU + pr * SZ_WGU, 1024, 1024}; pg8::StaticOrder S; S.init(NM, 2 * FFD / 256, G, c);
            pg8::EpiSwiGLU<FFN_DOWN_FP8 != 0> E{ws + OFF_U + U_ACT_E, FFD, 2 * FFD / 256, (const float*)(ws + OFF_FSC), (const float*)(ws + OFF_WSCD) + (size_t)pr * 2 * FFD}; pg8::gemm_phase<3>(lds, g, S, E, wv); }
        PHM(7) PHASE(pb + 5) DUPK(7) { PMARK(7); SEAM(pb + 5);
            pg8::Gemm g{ws + OFF_U + U_ACT_E, ws + OFF_WDN + pr * SZ_WDN, FFD, FFD}; pg8::StaticOrder S; S.init(NM, 4, G, c);
            pg8::EpiBf16S E{(bf16_t*)(ws + OFF_U + U_Y_E), 1024, 4, nullptr, FFN_DOWN_FP8 ? 1.0f / W8_SCALE : 1.0f}; pg8::gemm_phase<FFN_DOWN_FP8 ? 1 : 2>(lds, g, S, E, wv);
            { int rk, ni; if (tail_share(NM * 4, G, c, rk, ni)) {
                if (pr == 0) conv_units(p, lds, opaque_tid(wv), CV_NU_PRO, CV_NU_PRO + TAIL_U_SPLIT, rk, ni); else conv_units(p, lds, opaque_tid(wv), CV_NU_PRO + CV_NU_E / 2 + TAIL_U_SPLIT, CV_NU, rk, ni); } } }
        PHM(8) PHASE(pb + 6) DUPK(8) { PMARK(8); SEAM(pb + 6); phase_rowC<false>(pq, wv, le, (const bf16_t*)(ws + OFF_U + U_Y_E), false, DUP_DUMMY(8)); }
        PHM(9) PHASE(pb + 7) DUPK(9) { PMARK(9); SEAM(pb + 7);
            pg8::Gemm g{abuf, ws + OFF_WINO + pr * SZ_WINO, 1024, 1024}; pg8::StaticOrder S; S.init(NM, ODD_INP / 256, G, c);
            pg8::EpiRope<1> E{(bf16_t*)(ws + OFF_U + U_P_O), ODD_INP, (const float*)(ws + OFF_TAB), (const float*)(ws + OFF_FSC), (const float*)(ws + OFF_WSCI) + 2 * EVEN_IN + (size_t)pr * ODD_INP, (float*)(ws + OFF_U + U_SSQ_O)}; pg8::gemm_phase<3>(lds, g, S, E, wv);
            { int rk, ni; if (tail_share(NM * (ODD_INP / 256), G, c, rk, ni)) conv_tiles_run(p, lds, opaque_tid(wv), CV_NT_PRO + pr * (CV_NT_E / 2) + TAIL_T_SPLIT, CV_NT_PRO + (pr + 1) * (CV_NT_E / 2), rk, ni); } }
        PHM(11) PHASE(pb + 8) DUPK(11) { PMARK(11); SEAM(pb + 8);
            pg8::Gemm g{(const bf16_t*)(ws + OFF_U + U_P_O), (const bf16_t*)(ws + OFF_WQUP + pr * SZ_WQUP), ODD_INP, 256}; pg8::StaticOrder S; S.init(NM, 3, G, c);
            pg8::EpiBf16N<8> E{(bf16_t*)(ws + OFF_U + U_QF_O), 768, (const float*)(ws + OFF_U + U_SSQ_O), 1.0f / 256.0f}; pg8::gemm_phase<2>(lds, g, S, E, wv); }
        PHM(19) PHASE(pb + 9) DUPK(19) { PMARK(19);
            pg8::Gemm g{(const bf16_t*)(ws + OFF_U + U_P_O) + 256, (const bf16_t*)(ws + OFF_WKVUP + pr * SZ_WKVUP), ODD_INP, 256}; pg8::StaticOrder S; S.init(NM, 4, G, G - 1 - c);
            pg8::EpiBf16N<4> E{(bf16_t*)(ws + OFF_U + U_KVF_O), 1024, (const float*)(ws + OFF_U + U_SSQ_O) + 8, 1.0f / 128.0f}; pg8::gemm_phase<2>(lds, g, S, E, wv); }
        PHM(12) PHASE(pb + 10) DUPK(12) { PMARK(12); SEAM(pb + 10); phase_attn_odd(pq, wv, lds, lod); }
        PHM(13) PHASE(pb + 11) DUPK(13) { PMARK(13); SEAM(pb + 11);
            pg8::Gemm g{(const bf16_t*)(ws + OFF_U + U_MIX_O), (const bf16_t*)(ws + OFF_WOUTO + pr * SZ_WOUT), 1024, 1024}; pg8::StaticOrder S; S.init(pr == 1 ? MLAT / 256 : NM, 4, G, c);
            pg8::EpiBf16S E{(bf16_t*)(ws + OFF_EOUT), 1024, 4, nullptr, 1.0f}; pg8::gemm_phase<2>(lds, g, S, E, wv);
            { int rk, ni; if (pr == 0 && tail_share(NM * 4, G, c, rk, ni)) conv_units(p, lds, opaque_tid(wv), CV_NU_PRO + TAIL_U_SPLIT, CV_NU_PRO + CV_NU_E / 2, rk, ni); } }
        PHM(14) PHASE(pb + 12) DUPK(14) { PMARK(14); SEAM(pb + 12); phase_rowB<true>(pq, wv, lds, lod, (const bf16_t*)(ws + OFF_EOUT), pr == 1 ? MLAT : MTOT, DUP_DUMMY(14)); }
        PHM(16) PHASE(pb + 13) DUPK(16) { PMARK(16); SEAM(pb + 13);
            const MoeLayout L = moe_layout(pq, lod);
            pg8::Gemm g{ws + OFF_GBUF, ws + OFF_WEGU + (size_t)pr * 8 * (SZ_WEGU / 2), 1024, 1024};
            pg8::MoeOrder S; S.gatherA = true; S.so.init(L.tstart[8], 2 * FFE / 256, G, c);
#pragma unroll
            for (int e = 0; e < 9; ++e) S.ts[e] = L.tstart[e];
            pg8::EpiSwiGLU<FFN_DOWN_FP8 != 0> E{ws + OFF_U, FFE, 2 * FFE / 256, (const float*)(ws + OFF_GWT), (const float*)(ws + OFF_WSCE) + (size_t)pr * 8 * 2 * FFE}; pg8::gemm_phase<3>(lds, g, S, E, wv); }
        PHM(17) PHASE(pb + 14) DUPK(17) { PMARK(17); SEAM(pb + 14);
            const MoeLayout L = moe_layout(pq, lod);
            pg8::Gemm g{ws + OFF_U, ws + OFF_WEDN + (size_t)pr * 8 * (SZ_WEDN / (FFN_DOWN_FP8 ? 2 : 1)), FFE, FFE};
            pg8::MoeOrder S; S.gatherA = false; S.so.init(L.tstart[8], 4, G, c);
#pragma unroll
            for (int e = 0; e < 9; ++e) S.ts[e] = L.tstart[e];
            pg8::EpiBf16S E{(bf16_t*)(ws + OFF_EOUT), 1024, 4, (const float*)(ws + OFF_TWT), FFN_DOWN_FP8 ? 1.0f / W8_SCALE : 1.0f}; pg8::gemm_phase<FFN_DOWN_FP8 ? 1 : 2>(lds, g, S, E, wv);
            { int rk, ni; if (pr == 0 && tail_share(4 * L.tstart[8], G, c, rk, ni)) conv_units(p, lds, opaque_tid(wv), CV_NU_PRO + CV_NU_E / 2, CV_NU_PRO + CV_NU_E / 2 + TAIL_U_SPLIT, rk, ni); } }
        PHM(18) PHASE(pb + 15) DUPK(18) { PMARK(18); SEAM(pb + 15); phase_rowC<true>(pq, wv, lod, nullptr, pr == 1, DUP_DUMMY(18)); }
    }
#undef PHASE
#undef SEAM
}

extern "C" void kernel_launch(void* const* d_in, const int* in_sizes, int n_in, void* d_out, int out_size, void* d_ws, size_t ws_size, hipStream_t stream) {
    static int grid = 0;
    if (grid == 0) {
        if (n_in != 24 || out_size != MLAT * DM || ws_size < WS_END + (DUP_MASK != 0u ? (size_t)MTOT * DM * 6 : (size_t)0)) { fprintf(stderr, "kernel_launch: unexpected shapes (n_in %d, out %d, ws %zu, need %zu)\n", n_in, out_size, ws_size, (size_t)WS_END); grid = -1; return; }
        int dev = 0, cus = 0, per_cu = 0;
        if (hipGetDevice(&dev) != hipSuccess || hipDeviceGetAttribute(&cus, hipDeviceAttributeMultiprocessorCount, dev) != hipSuccess) { grid = -1; return; }
        if (hipFuncSetAttribute((const void*)fwd, hipFuncAttributeMaxDynamicSharedMemorySize, LDS_BYTES) != hipSuccess) { fprintf(stderr, "kernel_launch: hipFuncSetAttribute failed\n"); grid = -1; return; }
        if (hipOccupancyMaxActiveBlocksPerMultiprocessor(&per_cu, (const void*)fwd, NTHREADS, LDS_BYTES) != hipSuccess || per_cu < 1) { fprintf(stderr, "kernel_launch: occupancy query says %d\n", per_cu); grid = -1; return; }
        grid = cus < 256 ? cus : 256;
        if (grid != 256) fprintf(stderr, "kernel_launch: %d CUs; the row-wise phases assume 256 workgroups\n", cus);
    }
    if (grid != 256) return;
    Params p{};
    for (int i = 0; i < 24; ++i) p.in[i] = (const float*)d_in[i];
    p.out = (float*)d_out; p.ws = (unsigned char*)d_ws;
    hipMemsetAsync((char*)d_ws + OFF_CTL, 0, CTL_BYTES, stream);
#if MK_MULTI_LAUNCH
    for (int ph = 0; ph < NPHASES; ++ph) hipLaunchKernelGGL(fwd, dim3(grid), dim3(NTHREADS), LDS_BYTES, stream, p, ph, ph + 1);
#else
    hipLaunchKernelGGL(fwd, dim3(grid), dim3(NTHREADS), LDS_BYTES, stream, p, 0, NPHASES);
#endif
}
```
